# Optimizing an MI355X kernel written in HIP

```python
import math
import jax
import jax.numpy as jnp
from jax import lax
import numpy as np

D_MODEL = 1024
BATCH = 16
SEQ = 2048
DEPTH = 2

GRID_W = 64
CTX_LEN = 256
EPS = 1e-6

W_MIX = 512
N_BRANCH = 3
CHUNK = 128
SGU_HEADS = 4
CONV_WIDTH = 3
S5_GROUP_CH = 16
S5_GROUPS = W_MIX // S5_GROUP_CH
S5_STATE = 64
DT_MIN = 0.01
DT_MAX = 0.1
A_U0 = 0
A_V0 = A_U0 + W_MIX
B_B0 = A_V0 + W_MIX
B_C0 = B_B0 + W_MIX
B_H0 = B_C0 + W_MIX
S5_COL0 = B_H0 + W_MIX
GATE0 = S5_COL0 + W_MIX
D_IN = GATE0 + N_BRANCH * D_MODEL
N_EXPERTS = 16
N_EXPERT_GROUPS = 4
EXPERTS_PER_GROUP = N_EXPERTS // N_EXPERT_GROUPS
TOPK_GROUPS = 1
GROUP_SCORE_TOPK = 2
TOP_K = 2
D_FF_EXPERT = 512

kernel_name = "hybrid_sgu_conv_s5_moe_dit"


def _rmsnorm(x, g):
    xf = x.astype(jnp.float32)
    y = xf * lax.rsqrt(jnp.mean(xf * xf, axis=-1, keepdims=True) + EPS)
    return (y * g.astype(jnp.float32)).astype(x.dtype)


def _layernorm(x, g):
    xf = x.astype(jnp.float32)
    xc = xf - jnp.mean(xf, axis=-1, keepdims=True)
    y = xc * lax.rsqrt(jnp.mean(xc * xc, axis=-1, keepdims=True) + EPS)
    return (y * g.astype(jnp.float32)).astype(x.dtype)


def _adaln(cvec, w, b):
    m = jax.nn.silu(cvec) @ w + b
    return jnp.split(m[..., None, :], 6, axis=-1)


def _modulate(h, shift, scale):
    return h * (1.0 + scale) + shift


def _chunk_sgu(u, v, norm_g, w_s, b_s):
    u = jax.nn.gelu(u)
    v = _layernorm(jax.nn.gelu(v), norm_g)
    bsz, n, w = v.shape
    vc = v.reshape(bsz, n // CHUNK, CHUNK, SGU_HEADS, w // SGU_HEADS)
    mixed = jnp.einsum("hqk,bnkhc->bnqhc", w_s, vc) + b_s.T[:, :, None]
    return u * mixed.reshape(bsz, n, w)


def _conv3_axis(h, w, axis):
    n = h.shape[axis]
    pad = [(0, 0)] * h.ndim
    pad[axis] = (1, 1)
    hp = jnp.pad(h, pad)
    prev = lax.slice_in_dim(hp, 0, n, axis=axis)
    nxt = lax.slice_in_dim(hp, 2, n + 2, axis=axis)
    return w[0] * prev + w[1] * h + w[2] * nxt


def _short_conv(h, w, grid):
    if grid:
        bsz, n, ch = h.shape
        rows = n // GRID_W
        hg = h.reshape(bsz, rows, GRID_W, ch)
        return _conv3_axis(hg, w, 2).reshape(bsz, n, ch)
    return _conv3_axis(h, w, 1)


def _cmul(ar, ai, br, bi):
    return ar * br - ai * bi, ar * bi + ai * br


def _ssm_combine(e1, e2):
    a1r, a1i, b1r, b1i = e1
    a2r, a2i, b2r, b2i = e2
    ar, ai = _cmul(a2r, a2i, a1r, a1i)
    br, bi = _cmul(a2r, a2i, b1r, b1i)
    return ar, ai, br + b2r, bi + b2i


def _s5_discretise(lam_re, lam_im, log_dt, b_re, b_im):
    lam_re = lam_re.astype(jnp.float32)
    lam_im = lam_im.astype(jnp.float32)
    dt = jnp.exp(log_dt.astype(jnp.float32))[:, None]
    mag = jnp.exp(lam_re * dt)
    ab_re = mag * jnp.cos(lam_im * dt)
    ab_im = mag * jnp.sin(lam_im * dt)
    den = lam_re * lam_re + lam_im * lam_im
    nr = ab_re - 1.0
    f_re = (nr * lam_re + ab_im * lam_im) / den
    f_im = (ab_im * lam_re - nr * lam_im) / den
    bb_re, bb_im = _cmul(f_re[..., None], f_im[..., None], b_re.astype(jnp.float32), b_im.astype(jnp.float32))
    return ab_re, ab_im, bb_re, bb_im


def _s5_states(u, p, h0s):
    bsz, n, _ = u.shape
    ug = u.reshape(bsz, n, S5_GROUPS, S5_GROUP_CH).astype(jnp.float32)
    states = []
    for d in range(2):
        reverse = d == 1
        ab_re, ab_im, bb_re, bb_im = _s5_discretise(
            p["s5_lam_re"][d], p["s5_lam_im"][d], p["s5_log_dt"][d], p["s5_b_re"][d], p["s5_b_im"][d])
        bu_re = jnp.einsum("gph,blgh->blgp", bb_re, ug)
        bu_im = jnp.einsum("gph,blgh->blgp", bb_im, ug)
        if h0s is not None:
            i0 = n - 1 if reverse else 0
            c_re, c_im = _cmul(ab_re, ab_im, h0s[d][0], h0s[d][1])
            bu_re = bu_re.at[:, i0].add(c_re)
            bu_im = bu_im.at[:, i0].add(c_im)
        a_re = jnp.broadcast_to(ab_re, (1, n) + ab_re.shape)
        a_im = jnp.broadcast_to(ab_im, (1, n) + ab_im.shape)
        _, _, s_re, s_im = lax.associative_scan(
            _ssm_combine, (a_re, a_im, bu_re, bu_im), reverse=reverse, axis=1)
        states.append((s_re, s_im))
    return states


def _final_states(states):
    (f_re, f_im), (b_re, b_im) = states
    return ((f_re[:, -1], f_im[:, -1]), (b_re[:, 0], b_im[:, 0]))


def _s5_readout(u, states, p):
    bsz, n, w = u.shape
    ug = u.reshape(bsz, n, S5_GROUPS, S5_GROUP_CH).astype(jnp.float32)
    y = ug * p["s5_d"].astype(jnp.float32).reshape(S5_GROUPS, S5_GROUP_CH)
    for d in range(2):
        s_re, s_im = states[d]
        y = (y + jnp.einsum("ghp,blgp->blgh", p["s5_c_re"][d].astype(jnp.float32), s_re)
             - jnp.einsum("ghp,blgp->blgh", p["s5_c_im"][d].astype(jnp.float32), s_im))
    z = jax.nn.gelu(y.reshape(bsz, n, w))
    out = z * jax.nn.sigmoid(z @ p["glu_w"].astype(jnp.float32) + p["glu_b"].astype(jnp.float32))
    return out.astype(u.dtype)


def _token_mix(hn, p, grid, s5_h0):
    proj = hn @ p["w_in"]
    a_u, a_v, b_b, b_c, b_h, c_u, gates = jnp.split(
        proj, [A_V0, B_B0, B_C0, B_H0, S5_COL0, GATE0], axis=-1)
    y_a = _chunk_sgu(a_u, a_v, p["sgu_norm_g"], p["sgu_w"], p["sgu_b"])
    y_b = b_b * _short_conv(b_c * b_h, p["conv_w"], grid)
    states = _s5_states(c_u, p, s5_h0)
    y_c = _s5_readout(c_u, states, p)
    g = jax.nn.sigmoid(gates.astype(jnp.float32)).astype(hn.dtype)
    merged = None
    for i, y in enumerate((y_a, y_b, y_c)):
        term = g[..., i * D_MODEL:(i + 1) * D_MODEL] * (y @ p["w_branch"][i])
        merged = term if merged is None else merged + term
    return merged @ p["w_out"], states


def _moe(h, router_w, router_b, w_gate, w_up, w_down):
    bsz, n, d = h.shape
    t = h.reshape(bsz * n, d)
    scores = jax.nn.sigmoid((t @ router_w).astype(jnp.float32))
    biased = (scores + router_b.astype(jnp.float32)).reshape(-1, N_EXPERT_GROUPS, EXPERTS_PER_GROUP)
    group_score = jnp.sum(lax.top_k(biased, GROUP_SCORE_TOPK)[0], axis=-1)
    _, g_idx = lax.top_k(group_score, TOPK_GROUPS)
    g_mask = jnp.sum(jax.nn.one_hot(g_idx, N_EXPERT_GROUPS, dtype=jnp.float32), axis=1) > 0
    masked = jnp.where(g_mask[:, :, None], biased, -jnp.inf).reshape(-1, N_EXPERTS)
    _, e_idx = lax.top_k(masked, TOP_K)
    w_sel = jnp.take_along_axis(scores, e_idx, axis=1)
    w_sel = w_sel / jnp.sum(w_sel, axis=-1, keepdims=True)
    gates = jnp.sum(jax.nn.one_hot(e_idx, N_EXPERTS, dtype=jnp.float32) * w_sel[..., None], axis=1)
    gates = gates.astype(h.dtype)
    out = jnp.zeros_like(t)
    for e in range(N_EXPERTS):
        he = jax.nn.silu(t @ w_gate[e]) * (t @ w_up[e])
        out = out + gates[:, e:e + 1] * (he @ w_down[e])
    return out.reshape(bsz, n, d)


def setup_inputs(seed: int = 0) -> dict:
    key = jax.random.key(seed)
    ks = jax.random.split(key, 32)
    f32 = jnp.float32

    def nrm(k, shape, scale):
        return jax.random.normal(k, shape, f32) * scale

    G, P, H = S5_GROUPS, S5_STATE, S5_GROUP_CH
    lam_im_base = jnp.pi * jnp.arange(P, dtype=f32)
    return {
        "x": nrm(ks[0], (BATCH, SEQ, D_MODEL), 1.0),
        "c": nrm(ks[1], (BATCH, D_MODEL), 1.0),
        "ctx": nrm(ks[2], (BATCH, CTX_LEN, D_MODEL), 1.0),
        "c_ctx": nrm(ks[3], (D_MODEL,), 1.0),
        "w_mod": nrm(ks[4], (DEPTH, D_MODEL, 6 * D_MODEL), 0.5 * D_MODEL ** -0.5),
        "b_mod": nrm(ks[5], (DEPTH, 6 * D_MODEL), 0.02),
        "norm1_g": 1.0 + nrm(ks[6], (DEPTH, D_MODEL), 0.02),
        "norm2_g": 1.0 + nrm(ks[7], (DEPTH, D_MODEL), 0.02),
        "w_in": nrm(ks[8], (DEPTH, D_MODEL, D_IN), D_MODEL ** -0.5),
        "sgu_norm_g": 1.0 + nrm(ks[9], (DEPTH, W_MIX), 0.02),
        "sgu_w": nrm(ks[10], (DEPTH, SGU_HEADS, CHUNK, CHUNK), CHUNK ** -0.5),
        "sgu_b": nrm(ks[11], (DEPTH, SGU_HEADS, CHUNK), 0.02),
        "conv_w": nrm(ks[12], (DEPTH, CONV_WIDTH, W_MIX), CONV_WIDTH ** -0.5),
        "s5_lam_re": -0.5 + nrm(ks[13], (DEPTH, 2, G, P), 0.01),
        "s5_lam_im": lam_im_base + nrm(ks[14], (DEPTH, 2, G, P), 0.01),
        "s5_log_dt": jax.random.uniform(ks[15], (DEPTH, 2, G), f32, math.log(DT_MIN), math.log(DT_MAX)),
        "s5_b_re": nrm(ks[16], (DEPTH, 2, G, P, H), (2 * H) ** -0.5),
        "s5_b_im": nrm(ks[17], (DEPTH, 2, G, P, H), (2 * H) ** -0.5),
        "s5_c_re": nrm(ks[18], (DEPTH, 2, G, H, P), P ** -0.5),
        "s5_c_im": nrm(ks[19], (DEPTH, 2, G, H, P), P ** -0.5),
        "s5_d": nrm(ks[20], (DEPTH, W_MIX), 1.0),
        "glu_w": nrm(ks[21], (DEPTH, W_MIX, W_MIX), W_MIX ** -0.5),
        "glu_b": nrm(ks[22], (DEPTH, W_MIX), 0.02),
        "w_branch": nrm(ks[23], (DEPTH, N_BRANCH, W_MIX, D_MODEL), W_MIX ** -0.5),
        "w_out": nrm(ks[24], (DEPTH, D_MODEL, D_MODEL), D_MODEL ** -0.5),
        "router_w": nrm(ks[25], (D_MODEL, N_EXPERTS), D_MODEL ** -0.5),
        "router_b": nrm(ks[26], (N_EXPERTS,), 0.01),
        "exp_w_gate": nrm(ks[27], (DEPTH, N_EXPERTS, D_MODEL, D_FF_EXPERT), D_MODEL ** -0.5),
        "exp_w_up": nrm(ks[28], (DEPTH, N_EXPERTS, D_MODEL, D_FF_EXPERT), D_MODEL ** -0.5),
        "exp_w_down": nrm(ks[29], (DEPTH, N_EXPERTS, D_FF_EXPERT, D_MODEL), D_FF_EXPERT ** -0.5),
        "final_norm_g": 1.0 + nrm(ks[30], (D_MODEL,), 0.02),
    }


def reference(x, c, ctx, c_ctx, w_mod, b_mod, norm1_g, norm2_g, w_in, sgu_norm_g, sgu_w, sgu_b,
              conv_w, s5_lam_re, s5_lam_im, s5_log_dt, s5_b_re, s5_b_im, s5_c_re, s5_c_im, s5_d,
              glu_w, glu_b, w_branch, w_out, router_w, router_b, exp_w_gate, exp_w_up, exp_w_down,
              final_norm_g):
    h, hc = x, ctx
    for l in range(DEPTH):
        last = l == DEPTH - 1
        p = {
            "w_in": w_in[l], "sgu_norm_g": sgu_norm_g[l], "sgu_w": sgu_w[l], "sgu_b": sgu_b[l],
            "conv_w": conv_w[l], "s5_lam_re": s5_lam_re[l], "s5_lam_im": s5_lam_im[l],
            "s5_log_dt": s5_log_dt[l], "s5_b_re": s5_b_re[l], "s5_b_im": s5_b_im[l],
            "s5_c_re": s5_c_re[l], "s5_c_im": s5_c_im[l], "s5_d": s5_d[l],
            "glu_w": glu_w[l], "glu_b": glu_b[l], "w_branch": w_branch[l], "w_out": w_out[l],
        }
        sh1, sc1, g1, sh2, sc2, g2 = _adaln(c, w_mod[l], b_mod[l])
        csh1, csc1, cg1, csh2, csc2, cg2 = _adaln(c_ctx, w_mod[l], b_mod[l])
        cn = _modulate(_rmsnorm(hc, norm1_g[l]), csh1, csc1)
        if last:
            ctx_states = _s5_states(cn @ w_in[l][:, S5_COL0:S5_COL0 + W_MIX], p, None)
        else:
            ctx_mix, ctx_states = _token_mix(cn, p, False, None)
        h0 = _final_states(ctx_states)
        xn = _modulate(_rmsnorm(h, norm1_g[l]), sh1, sc1)
        lat_mix, _ = _token_mix(xn, p, True, h0)
        h = h + g1 * lat_mix
        h = h + g2 * _moe(_modulate(_rmsnorm(h, norm2_g[l]), sh2, sc2),
                          router_w, router_b, exp_w_gate[l], exp_w_up[l], exp_w_down[l])
        if not last:
            hc = hc + cg1 * ctx_mix
            hc = hc + cg2 * _moe(_modulate(_rmsnorm(hc, norm2_g[l]), csh2, csc2),
                                 router_w, router_b, exp_w_gate[l], exp_w_up[l], exp_w_down[l])
    return _rmsnorm(h, final_norm_g)
```

```cpp
#include <hip/hip_runtime.h>
#include <cstdio>
#include <cstdint>

#ifndef MK_LAUNCH_PER_PHASE
#define MK_LAUNCH_PER_PHASE 0
#endif

#ifndef PHASE_MASK
#define PHASE_MASK 0xFFFF
#endif
#define PH_ON(k) (((PHASE_MASK) >> (k)) & 1)
#ifndef REPEAT_MASK
#define REPEAT_MASK 0
#endif
#define REP(k) for (int rep_ = 0; rep_ < 1 + ((REPEAT_MASK >> (k)) & 1); ++rep_)
#define LAS __attribute__((address_space(3)))
#define GAS __attribute__((address_space(1)))
typedef unsigned short bf16_t;
typedef short bf16x8 __attribute__((ext_vector_type(8)));
typedef float f32x4 __attribute__((ext_vector_type(4)));
typedef float f32x2 __attribute__((ext_vector_type(2)));
typedef unsigned u32x4 __attribute__((ext_vector_type(4)));
typedef unsigned u32x2 __attribute__((ext_vector_type(2)));
typedef int i32x4 __attribute__((ext_vector_type(4)));

constexpr int D = 1024, TLAT = 32768, TCTX = 4096, TALL = 36864, DEPTH = 2;
constexpr int NBLK = 256, NTHR = 512, NWAVE = 8;
constexpr int NCH = 1152, NCHP = 1280, SQ = 32;
constexpr float EPS = 1e-6f;
constexpr int MAXROWS = 77824;

constexpr size_t MiB = 1u << 20;
constexpr size_t OFF_CTL = 0, CTL_ZERO_BYTES = 65536;
constexpr size_t OFF_CMAXW = OFF_CTL + 16384;
constexpr size_t OFF_SXA = OFF_CTL + 393216;
constexpr size_t OFF_SWIN = OFF_CTL + 655360;
constexpr size_t OFF_SWGU = OFF_CTL + 720896;
constexpr size_t OFF_SX2 = OFF_CTL + 786432;
constexpr size_t OFF_SXS = 21 * MiB + 512 * 1024;
constexpr size_t OFF_SGUW16 = OFF_CTL + 131072;
constexpr size_t OFF_MOD = 1 * MiB;
constexpr size_t OFF_MISC = 2 * MiB;
constexpr size_t OFF_AQ = OFF_MISC;
constexpr size_t OFF_CNT = OFF_MISC + 64 * 1024;
constexpr size_t OFF_SEG = OFF_MISC + 80 * 1024;
constexpr size_t OFF_SEL = OFF_MISC + 128 * 1024;
constexpr size_t OFF_WSEL = OFF_MISC + 448 * 1024;
constexpr size_t OFF_LRANK = OFF_MISC + 768 * 1024;
constexpr size_t OFF_POS = OFF_MISC + 1088 * 1024;
constexpr size_t OFF_ROWL = OFF_MISC + 1408 * 1024;
constexpr size_t OFF_WL = OFF_MISC + 1728 * 1024;
constexpr size_t OFF_WIN = 4 * MiB;
constexpr size_t OFF_WBR = 16 * MiB;
constexpr size_t OFF_WOUT = 19 * MiB;
constexpr size_t OFF_GLU = 21 * MiB;
constexpr size_t OFF_WE = 22 * MiB;
constexpr size_t OFF_TW = 30 * MiB;
constexpr size_t OFF_HB = 54 * MiB;
constexpr size_t OFF_XN = 126 * MiB;
constexpr size_t OFF_U = 198 * MiB;
constexpr size_t OFF_V = 234 * MiB;
constexpr size_t OFF_BB = 270 * MiB;
constexpr size_t OFF_P = 306 * MiB;
constexpr size_t OFF_UX = 342 * MiB;
constexpr size_t OFF_G8 = 402 * MiB;
constexpr size_t WS_END = 510 * MiB;
constexpr size_t OFF_MERGED = OFF_XN;
constexpr size_t OFF_E = OFF_XN;
constexpr size_t OFF_Y = 198 * MiB;
constexpr size_t OFF_HE = 350 * MiB;
constexpr size_t OFF_WGU = 426 * MiB;
constexpr size_t OFF_WD = 458 * MiB;
static_assert(OFF_Y + (size_t)MAXROWS * 1024 * 2 <= OFF_HE && OFF_HE + (size_t)MAXROWS * 512 * 2 <= OFF_WGU && OFF_WD + (size_t)16 * 1024 * 512 * 2 <= WS_END && OFF_G8 + (size_t)TALL * 3072 <= WS_END, "overlay map");

constexpr int RING_BYTES = 131072;
constexpr int LDS_CTL_OFF = 159744;
constexpr int LDS_BYTES = 160768;

__device__ __forceinline__ unsigned cvt_pk_bf16(float lo, float hi) { unsigned r; asm volatile("v_cvt_pk_bf16_f32 %0, %1, %2" : "=v"(r) : "v"(lo), "v"(hi)); return r; }
__device__ __forceinline__ float bf_lo(unsigned w) { return __uint_as_float(w << 16); }
__device__ __forceinline__ float bf_hi(unsigned w) { return __uint_as_float(w & 0xffff0000u); }
__device__ __forceinline__ float bf1(bf16_t b) { return __uint_as_float(((unsigned)b) << 16); }
__device__ __forceinline__ float sigmoidf_(float x) { return __builtin_amdgcn_rcpf(1.0f + __builtin_amdgcn_exp2f(-1.44269504089f * x)); }
__device__ __forceinline__ float siluf_(float x) { return x * sigmoidf_(x); }
__device__ __forceinline__ float geluf_(float x) { return x * sigmoidf_(1.59576912161f * x * (1.0f + 0.044715f * x * x)); }
__device__ __forceinline__ f32x4 gelu4(const f32x4 x) {
    const f32x4 t = x * (x * x * (-0.10294324f) + (-2.30220821f));
    f32x4 e; e[0] = __builtin_amdgcn_exp2f(t[0]); e[1] = __builtin_amdgcn_exp2f(t[1]); e[2] = __builtin_amdgcn_exp2f(t[2]); e[3] = __builtin_amdgcn_exp2f(t[3]);
    e = e + 1.0f;
    f32x4 r; r[0] = __builtin_amdgcn_rcpf(e[0]); r[1] = __builtin_amdgcn_rcpf(e[1]); r[2] = __builtin_amdgcn_rcpf(e[2]); r[3] = __builtin_amdgcn_rcpf(e[3]);
    return x * r;
}
__device__ __forceinline__ unsigned gate4_u8_t(const f32x4 t) {
    f32x4 e; e[0] = __builtin_amdgcn_exp2f(t[0]); e[1] = __builtin_amdgcn_exp2f(t[1]); e[2] = __builtin_amdgcn_exp2f(t[2]); e[3] = __builtin_amdgcn_exp2f(t[3]);
    e = e + 0.0039177277f;
    unsigned w = __builtin_amdgcn_cvt_pk_u8_f32(__builtin_amdgcn_rcpf(e[0]), 0, 0u);
    w = __builtin_amdgcn_cvt_pk_u8_f32(__builtin_amdgcn_rcpf(e[1]), 1, w);
    w = __builtin_amdgcn_cvt_pk_u8_f32(__builtin_amdgcn_rcpf(e[2]), 2, w);
    w = __builtin_amdgcn_cvt_pk_u8_f32(__builtin_amdgcn_rcpf(e[3]), 3, w);
    return w;
}
template <int CTRL> __device__ __forceinline__ float dpp_f(float v) { return __int_as_float(__builtin_amdgcn_update_dpp(0, __float_as_int(v), CTRL, 0xF, 0xF, false)); }
__device__ __forceinline__ float row16_sum(float v) { v += dpp_f<0xB1>(v); v += dpp_f<0x4E>(v); v += dpp_f<0x141>(v); v += dpp_f<0x140>(v); return v; }
__device__ __forceinline__ float wave_sum(float v) {
    v = row16_sum(v);
    const float a = __int_as_float(__builtin_amdgcn_readlane(__float_as_int(v), 0)), b = __int_as_float(__builtin_amdgcn_readlane(__float_as_int(v), 16)),
                c = __int_as_float(__builtin_amdgcn_readlane(__float_as_int(v), 32)), d = __int_as_float(__builtin_amdgcn_readlane(__float_as_int(v), 48));
    return (a + b) + (c + d);
}
__device__ __forceinline__ u32x4 pack8(const f32x4 a, const f32x4 b) { u32x4 w; w.x = cvt_pk_bf16(a[0], a[1]); w.y = cvt_pk_bf16(a[2], a[3]); w.z = cvt_pk_bf16(b[0], b[1]); w.w = cvt_pk_bf16(b[2], b[3]); return w; }
__device__ __forceinline__ void unpack8(const u32x4 w, f32x4& a, f32x4& b) { a = (f32x4){bf_lo(w.x), bf_hi(w.x), bf_lo(w.y), bf_hi(w.y)}; b = (f32x4){bf_lo(w.z), bf_hi(w.z), bf_lo(w.w), bf_hi(w.w)}; }

#define XB_TMO      128
#define XB_XCNT(j)  (256  + 64 * (j))
#define XB_XSUB(j)  (1280 + 64 * (j))
#define XB_XGEN(j)  (2304 + 64 * (j))
#define XB_TOP      3328
#define XB_TOPGEN   3392
#define XCD_BAR_WORDS 3456
#define XB_SPIN_CAP (1u << 18)
__device__ __forceinline__ unsigned xb_ld(unsigned* p)              { return __hip_atomic_load(p, __ATOMIC_RELAXED, __HIP_MEMORY_SCOPE_AGENT); }
__device__ __forceinline__ unsigned xb_add(unsigned* p, unsigned v) { return __hip_atomic_fetch_add(p, v, __ATOMIC_RELAXED, __HIP_MEMORY_SCOPE_AGENT); }
__device__ __forceinline__ unsigned xb_xcc_id() { return (unsigned)__builtin_amdgcn_s_getreg((3 << 11) | 20) & 0xFu; }
#define XB_SPIN(cond, bar) do { unsigned _sp = 0; while (cond) { __builtin_amdgcn_s_sleep(1); \
    if ((++_sp & 255u) == 0u) { if (xb_ld(&(bar)[XB_TMO])) break; if (_sp > XB_SPIN_CAP) { atomicAdd(&(bar)[XB_TMO], 1u); break; } } } } while (0)
struct XcdBarrier { unsigned* bar; unsigned x; volatile LAS unsigned* st; };
__device__ __forceinline__ XcdBarrier xcd_barrier_post(unsigned* bar, volatile LAS unsigned* st) {
    XcdBarrier b; b.bar = bar; b.x = xb_xcc_id(); b.st = st;
    if (threadIdx.x == 0) (void)xb_add(&bar[XB_XCNT(b.x)], 1u);
    return b;
}
__device__ __forceinline__ void xcd_barrier_complete(unsigned* bar, unsigned x, unsigned& nloc, unsigned& nx) {
    const unsigned G = gridDim.x * gridDim.y * gridDim.z;
    unsigned sum, cnt, mine, sp = 0u;
    for (;;) {
        sum = 0u; cnt = 0u; mine = 0u;
#pragma unroll
        for (unsigned j = 0; j < 16; ++j) { const unsigned c = xb_ld(&bar[XB_XCNT(j)]); sum += c; cnt += (c > 0u) ? 1u : 0u; mine = (j == x) ? c : mine; }
        if (sum == G) break;
        __builtin_amdgcn_s_sleep(1);
        if ((++sp & 255u) == 0u) { if (xb_ld(&bar[XB_TMO])) break; if (sp > XB_SPIN_CAP) { atomicAdd(&bar[XB_TMO], 1u); break; } }
    }
    nloc = mine > 0u ? mine : 1u; nx = cnt > 0u ? cnt : 1u;
}
__device__ __forceinline__ void xcd_barrier(const XcdBarrier& b) {
    asm volatile("s_waitcnt vmcnt(0)" ::: "memory");
    __syncthreads();
    if (threadIdx.x == 0) {
        unsigned* bar = b.bar;
        __builtin_amdgcn_s_waitcnt(0);
        unsigned nloc = b.st[0], nx = b.st[1];
        if (nloc == 0u) { xcd_barrier_complete(bar, b.x, nloc, nx); b.st[0] = nloc; b.st[1] = nx; }
        const unsigned old = xb_add(&bar[XB_XSUB(b.x)], 1u);
        const unsigned gen = old / nloc;
        if (old + 1u == (gen + 1u) * nloc) {
            __builtin_amdgcn_fence(__ATOMIC_RELEASE, "agent");
            asm volatile("s_waitcnt vmcnt(0)" ::: "memory");
            const unsigned og = xb_add(&bar[XB_TOP], 1u);
            const unsigned tg = og / nx;
            if (og + 1u == (tg + 1u) * nx) xb_add(&bar[XB_TOPGEN], 1u);
            else XB_SPIN(xb_ld(&bar[XB_TOPGEN]) == tg, bar);
            __builtin_amdgcn_fence(__ATOMIC_ACQUIRE, "agent");
            xb_add(&bar[XB_XGEN(b.x)], 1u);
            asm volatile("s_waitcnt vmcnt(0)" ::: "memory");
        } else {
            XB_SPIN(xb_ld(&bar[XB_XGEN(b.x)]) == gen, bar);
            __builtin_amdgcn_fence(__ATOMIC_ACQUIRE, "agent");
            asm volatile("s_waitcnt vmcnt(0)" ::: "memory");
        }
    }
    __syncthreads();
}

namespace gs {
constexpr int BM = 256, BK = 64, HALF = 128, HTB = HALF * BK * 2, STAGE_BYTES = 8 * HTB;
__device__ __forceinline__ int lds_byte(int r, int c) { const int st = (r >> 4) * 2 + (c >> 5), rr = r & 15, cc = c & 31, ob = rr * 64 + cc * 2; return st * 1024 + (ob ^ (((ob >> 9) & 1) << 5)); }
__device__ __forceinline__ void stage_rc(int b, int& R, int& C) { const int st = b / 1024, sb = b % 1024, swz = sb ^ (((sb >> 9) & 1) << 5); R = (st >> 1) * 16 + swz / 64; C = (st & 1) * 32 + (swz % 64) / 2; }
__device__ __forceinline__ int perm32(int rho) { const int n = rho >> 4, i = rho & 15; return 8 * (i >> 2) + 4 * n + (i & 3); }
__device__ __forceinline__ int xcd_remap(int L, int nwg) { const int q = nwg >> 3, r = nwg & 7, xcd = L & 7, off = L >> 3; return (xcd < r ? xcd * (q + 1) : r * (q + 1) + (xcd - r) * q) + off; }
__device__ __forceinline__ void tile_order(int wgid, int nM, int nN, int& pm, int& pn) { const int nig = 8 * nN, gid = wgid / nig, fm = gid * 8, gsz = (nM - fm) < 8 ? (nM - fm) : 8; pm = fm + ((wgid % nig) % gsz); pn = (wgid % nig) / gsz; }

struct Unit { int pm, pn, kind, aux; };
struct Ops { const char* A; const char* B; unsigned lda, ldb; int nt; const int* rows; };

template <class Epi, class Sched, bool GATHER>
__device__ __forceinline__ void gemm_stream(LAS unsigned char* lds, const int tid, const Sched& S, const Epi& E) {
    const int wid = __builtin_amdgcn_readfirstlane(tid >> 6), lane = tid & 63, wr = wid >> 2, wc = wid & 3, fr = lane & 15, fq = lane >> 4;
    const unsigned ldsw = (unsigned)wid * 1024u;
    const int aoff = lds_byte(wr * 64 + fr, fq * 8), boff = lds_byte(wc * 32 + fr, fq * 8);
    Unit cur, nxt; int ui = 0;
    if (!S.next(0, cur)) return;
    unsigned vA0[2], vA1[2], vB[2];
    const char* cA; const char* cB; size_t hA, hB; int nt;
#define GS_SETOFF(u) do { Ops _o; S.ops((u), _o); cA = _o.A; cB = _o.B; nt = _o.nt; hB = (size_t)HALF * _o.ldb; hA = GATHER ? (size_t)0 : (size_t)HALF * _o.lda; \
        _Pragma("unroll") for (int _i = 0; _i < 2; ++_i) { int _R, _C; stage_rc(tid * 16 + _i * 8192, _R, _C); const int _Rb = (_R & ~31) + perm32(_R & 31); \
        if constexpr (GATHER) { vA0[_i] = (unsigned)_o.rows[_R] * _o.lda + (unsigned)_C * 2u; vA1[_i] = (unsigned)_o.rows[HALF + _R] * _o.lda + (unsigned)_C * 2u; } \
        else { vA0[_i] = (unsigned)_R * _o.lda + (unsigned)_C * 2u; vA1[_i] = 0u; } \
        vB[_i] = (unsigned)_Rb * _o.ldb + (unsigned)_C * 2u; } } while (0)
#define GS_SA(b, h) (((b) * 2 + (h)) * HTB)
#define GS_SB(b, h) ((4 + (b) * 2 + (h)) * HTB)
#define GS_STAGE(bufoff, gbase, voff) do { _Pragma("unroll") for (int _i = 0; _i < 2; ++_i) \
        __builtin_amdgcn_global_load_lds((const unsigned*)((const char*)(gbase) + (voff)[_i]), (LAS unsigned*)(lds + (bufoff) + ldsw + _i * 8192), 16, 0, 0); } while (0)
#define GS_STAGE_A1(bufoff, gbase) do { if constexpr (GATHER) { GS_STAGE(bufoff, gbase, vA1); } else { GS_STAGE(bufoff, (gbase) + hA, vA0); } } while (0)
#define GS_LDA(dst, b, h) do { _Pragma("unroll") for (int m = 0; m < 4; ++m) _Pragma("unroll") for (int k = 0; k < 2; ++k) dst[m][k] = *(const LAS bf16x8*)(lds + GS_SA(b, h) + aoff + m * 2048 + k * 1024); } while (0)
#define GS_LDB(dst, b, h) do { _Pragma("unroll") for (int n = 0; n < 2; ++n) _Pragma("unroll") for (int k = 0; k < 2; ++k) dst[n][k] = *(const LAS bf16x8*)(lds + GS_SB(b, h) + boff + n * 2048 + k * 1024); } while (0)
#define GS_MMA(ai, bj, At, Bt) do { __builtin_amdgcn_s_setprio(1); _Pragma("unroll") for (int m = 0; m < 4; ++m) _Pragma("unroll") for (int n = 0; n < 2; ++n) _Pragma("unroll") for (int k = 0; k < 2; ++k) { \
        if constexpr (Epi::I8) acc[ai][bj][m][n] = __builtin_bit_cast(f32x4, __builtin_amdgcn_mfma_i32_16x16x64_i8(__builtin_bit_cast(i32x4, Bt[n][k]), __builtin_bit_cast(i32x4, At[m][k]), __builtin_bit_cast(i32x4, acc[ai][bj][m][n]), 0, 0, 0)); \
        else acc[ai][bj][m][n] = __builtin_amdgcn_mfma_f32_16x16x32_bf16(Bt[n][k], At[m][k], acc[ai][bj][m][n], 0, 0, 0); } __builtin_amdgcn_s_setprio(0); } while (0)
#define GS_WAIT_V(n) asm volatile("s_waitcnt vmcnt(" #n ")" ::: "memory")
#define GS_WAIT_L(n) asm volatile("s_waitcnt lgkmcnt(" #n ")" ::: "memory")
#define GS_BAR __builtin_amdgcn_s_barrier()
#define GS_SCHED __builtin_amdgcn_sched_barrier(0)
    f32x4 acc[2][2][4][2];
#pragma unroll
    for (int a = 0; a < 2; ++a)
#pragma unroll
        for (int b = 0; b < 2; ++b)
#pragma unroll
            for (int m = 0; m < 4; ++m)
#pragma unroll
                for (int n = 0; n < 2; ++n) acc[a][b][m][n] = (f32x4){0.f, 0.f, 0.f, 0.f};
    bf16x8 At[4][2], B0[2][2], B1[2][2];
    GS_SETOFF(cur);
    const size_t kstep = (size_t)(BK * 2);
    GS_STAGE(GS_SB(0, 0), cB, vB); GS_STAGE(GS_SB(0, 1), cB + hB, vB); GS_STAGE(GS_SA(0, 0), cA, vA0); GS_STAGE_A1(GS_SA(0, 1), cA);
    if (wr == 1) GS_BAR;
    GS_WAIT_V(2); GS_BAR;
    GS_STAGE(GS_SB(1, 0), cB + kstep, vB); GS_STAGE(GS_SA(1, 0), cA + kstep, vA0); GS_STAGE(GS_SB(1, 1), cB + hB + kstep, vB);
    GS_WAIT_V(6); GS_BAR;
    for (;;) {
        const bool has_next = S.next(ui + 1, nxt);
        const int ntc = nt;
        for (int t = 0; t < ntc; t += 2) {
            const bool last = (t == ntc - 2);
            GS_LDB(B0, 0, 0); GS_LDB(B1, 0, 1); GS_SCHED; GS_LDA(At, 0, 0); GS_STAGE_A1(GS_SA(1, 1), cA + (size_t)(t + 1) * kstep);
            const char* a2; const char* b2;
            if (last) { if (has_next) { GS_SETOFF(nxt); } a2 = cA; b2 = cB; }
            else { a2 = cA + (size_t)(t + 2) * kstep; b2 = cB + (size_t)(t + 2) * kstep; }
            const char* a3 = a2 + kstep; const char* b3 = b2 + kstep;
            GS_WAIT_V(8); GS_WAIT_L(0); GS_BAR; GS_MMA(0, 0, At, B0); GS_MMA(0, 1, At, B1); GS_BAR; GS_SCHED;
            GS_LDA(At, 0, 1); GS_STAGE(GS_SB(0, 0), b2, vB); GS_STAGE(GS_SB(0, 1), b2 + hB, vB); GS_STAGE(GS_SA(0, 0), a2, vA0);
            GS_WAIT_V(8); GS_WAIT_L(0); GS_BAR; GS_MMA(1, 0, At, B0); GS_MMA(1, 1, At, B1); GS_BAR; GS_SCHED;
            GS_LDB(B0, 1, 0); GS_LDB(B1, 1, 1); GS_SCHED; GS_LDA(At, 1, 0); GS_STAGE_A1(GS_SA(0, 1), a2);
            GS_WAIT_V(8); GS_WAIT_L(0); GS_BAR; GS_MMA(0, 0, At, B0); GS_MMA(0, 1, At, B1); GS_BAR; GS_SCHED;
            GS_LDA(At, 1, 1); GS_STAGE(GS_SB(1, 0), b3, vB); GS_STAGE(GS_SB(1, 1), b3 + hB, vB); GS_STAGE(GS_SA(1, 0), a3, vA0);
            GS_WAIT_V(8); GS_WAIT_L(0); GS_BAR; GS_MMA(1, 0, At, B0); GS_MMA(1, 1, At, B1); GS_BAR; GS_SCHED;
        }
        if (wr == 0) GS_BAR;
        bool keep = false;
        if constexpr (Epi::KEEPS) keep = E.scale(acc, cur, wr, wc, fr, fq);
        else E(acc, cur, wr, wc, fr, fq);
        if (!has_next) break;
        if (!keep) {
#pragma unroll
        for (int a = 0; a < 2; ++a)
#pragma unroll
            for (int b = 0; b < 2; ++b)
#pragma unroll
                for (int m = 0; m < 4; ++m)
#pragma unroll
                    for (int n = 0; n < 2; ++n) acc[a][b][m][n] = (f32x4){0.f, 0.f, 0.f, 0.f};
        }
        cur = nxt; ++ui;
        if (wr == 1) GS_BAR;
    }
    GS_WAIT_V(0);
    GS_BAR;
#undef GS_SETOFF
#undef GS_SA
#undef GS_SB
#undef GS_STAGE
#undef GS_STAGE_A1
#undef GS_LDA
#undef GS_LDB
#undef GS_MMA
#undef GS_WAIT_V
#undef GS_WAIT_L
#undef GS_BAR
#undef GS_SCHED
}
}

struct Params {
    const float* in[31];
    float* out;
    unsigned char* ws;
    long long ph_lo, ph_hi;
};
enum { I_X = 0, I_C, I_CTX, I_CCTX, I_WMOD, I_BMOD, I_N1G, I_N2G, I_WIN, I_SGUNG, I_SGUW, I_SGUB, I_CONVW, I_LAMRE, I_LAMIM, I_LOGDT, I_BRE, I_BIM, I_CRE, I_CIM, I_S5D,
       I_GLUW, I_GLUB, I_WBR, I_WOUT, I_RW, I_RB, I_EWG, I_EWU, I_EWD, I_FNG };

struct Frame {
    LAS unsigned char* lds;
    int tid, lane, wave, blk;
};

__device__ __forceinline__ float wave_max(float v) {
    v = fmaxf(v, dpp_f<0xB1>(v)); v = fmaxf(v, dpp_f<0x4E>(v)); v = fmaxf(v, dpp_f<0x141>(v)); v = fmaxf(v, dpp_f<0x140>(v));
    const float a = __int_as_float(__builtin_amdgcn_readlane(__float_as_int(v), 0)), b = __int_as_float(__builtin_amdgcn_readlane(__float_as_int(v), 16)),
                c = __int_as_float(__builtin_amdgcn_readlane(__float_as_int(v), 32)), d = __int_as_float(__builtin_amdgcn_readlane(__float_as_int(v), 48));
    return fmaxf(fmaxf(a, b), fmaxf(c, d));
}
__device__ __forceinline__ unsigned q8x4(const f32x4 v, const float inv) {
    const unsigned a = __float_as_uint(__builtin_fmaf(v[0], inv, 12582912.0f)), b = __float_as_uint(__builtin_fmaf(v[1], inv, 12582912.0f));
    const unsigned c = __float_as_uint(__builtin_fmaf(v[2], inv, 12582912.0f)), d = __float_as_uint(__builtin_fmaf(v[3], inv, 12582912.0f));
    return __builtin_amdgcn_perm(__builtin_amdgcn_perm(d, c, 0x0c0c0400u), __builtin_amdgcn_perm(b, a, 0x0c0c0400u), 0x05040100u);
}
__device__ __forceinline__ void tr_item(const float* src, int ld_src, int k0, int c0, bf16_t* dst, int ld_dst, int r0, LAS float* scr, int lane) {
    f32x4 t[8];
#pragma unroll
    for (int i = 0; i < 8; ++i) t[i] = *(const f32x4*)(src + (size_t)(k0 + 8 * i + (lane >> 3)) * ld_src + c0 + 4 * (lane & 7));
#pragma unroll
    for (int i = 0; i < 8; ++i) { LAS float* d = scr + (8 * i + (lane >> 3)) * 33 + 4 * (lane & 7); d[0] = t[i][0]; d[1] = t[i][1]; d[2] = t[i][2]; d[3] = t[i][3]; }
    asm volatile("s_waitcnt lgkmcnt(0)" ::: "memory");
    const int c = lane & 7;
    float sv[4][8];
#pragma unroll
    for (int j = 0; j < 4; ++j) { const LAS float* s = scr + (8 * c) * 33 + (lane >> 3) + 8 * j;
#pragma unroll
        for (int i = 0; i < 8; ++i) sv[j][i] = s[i * 33]; }
#pragma unroll
    for (int j = 0; j < 4; ++j) { const int n = (lane >> 3) + 8 * j;
        u32x4 o; o.x = cvt_pk_bf16(sv[j][0], sv[j][1]); o.y = cvt_pk_bf16(sv[j][2], sv[j][3]); o.z = cvt_pk_bf16(sv[j][4], sv[j][5]); o.w = cvt_pk_bf16(sv[j][6], sv[j][7]);
        *(u32x4*)(dst + (size_t)(r0 + n) * ld_dst + k0 + 8 * c) = o; }
    asm volatile("s_waitcnt lgkmcnt(0)" ::: "memory");
}
__device__ __forceinline__ void tr_item_i8(const float* src, int ld_src, int k0, int c0, signed char* dst, int ld_dst, int r0, const unsigned* cmax_c0, float* scale_out, LAS float* scr, int lane) {
    f32x4 t[8];
#pragma unroll
    for (int i = 0; i < 8; ++i) t[i] = *(const f32x4*)(src + (size_t)(k0 + 8 * i + (lane >> 3)) * ld_src + c0 + 4 * (lane & 7));
#pragma unroll
    for (int i = 0; i < 8; ++i) { LAS float* d = scr + (8 * i + (lane >> 3)) * 33 + 4 * (lane & 7); d[0] = t[i][0]; d[1] = t[i][1]; d[2] = t[i][2]; d[3] = t[i][3]; }
    asm volatile("s_waitcnt lgkmcnt(0)" ::: "memory");
    const int n = lane & 31, hf = lane >> 5;
    const float cm = fmaxf(__uint_as_float(cmax_c0[n]), 1e-30f), inv = 127.0f / cm;
    if (scale_out && hf == 0) scale_out[n] = cm * (1.0f / 127.0f);
    u32x4 o[2];
#pragma unroll
    for (int h = 0; h < 2; ++h) {
        unsigned w[4];
#pragma unroll
        for (int x = 0; x < 4; ++x) { const LAS float* sp = scr + (32 * hf + 16 * h + 4 * x) * 33 + n; w[x] = q8x4((f32x4){sp[0], sp[33], sp[66], sp[99]}, inv); }
        o[h] = (u32x4){w[0], w[1], w[2], w[3]}; }
    *(u32x4*)(dst + (size_t)(r0 + n) * ld_dst + k0 + 32 * hf) = o[0]; *(u32x4*)(dst + (size_t)(r0 + n) * ld_dst + k0 + 32 * hf + 16) = o[1];
    asm volatile("s_waitcnt lgkmcnt(0)" ::: "memory");
}
__device__ __forceinline__ void colmax_win(const Params& p, const Frame& F) {
    unsigned* cmax = (unsigned*)(p.ws + OFF_CMAXW);
    for (int it = F.blk * NWAVE + F.wave; it < 768; it += NBLK * NWAVE) {
        const int l = it / 384, rem = it % 384, kb = rem / 24, cb = rem % 24;
        const float* src = p.in[I_WIN] + ((size_t)l * 1024 + 64 * kb) * 6144 + cb * 256 + 4 * F.lane;
        f32x4 m = (f32x4){0.f, 0.f, 0.f, 0.f};
#pragma unroll 16
        for (int i = 0; i < 64; ++i) { const f32x4 v = *(const f32x4*)(src + (size_t)i * 6144); m[0] = fmaxf(m[0], fabsf(v[0])); m[1] = fmaxf(m[1], fabsf(v[1])); m[2] = fmaxf(m[2], fabsf(v[2])); m[3] = fmaxf(m[3], fabsf(v[3])); }
        unsigned* dst = cmax + l * 6144 + cb * 256 + 4 * F.lane;
        atomicMax(dst + 0, __float_as_uint(m[0])); atomicMax(dst + 1, __float_as_uint(m[1])); atomicMax(dst + 2, __float_as_uint(m[2])); atomicMax(dst + 3, __float_as_uint(m[3]));
    }
}
__device__ __forceinline__ int win_col(int n) {
    if (n < 1536 || n >= 2560) return n;
    const int j = (n - 1536) >> 8, q = (n - 1536) & 255;
    return (q < 128) ? (1536 + 128 * j + q) : (2048 + 128 * j + (q - 128));
}
__device__ __forceinline__ void convert_mix(const Params& p, const Frame& F, int l, int part, int wslot, int nwslots) {
    LAS float* scr = (LAS float*)(F.lds + F.wave * 16384);
    bf16_t* WinT = (bf16_t*)(p.ws + OFF_WIN); bf16_t* WbrT = (bf16_t*)(p.ws + OFF_WBR); bf16_t* WoutT = (bf16_t*)(p.ws + OFF_WOUT); bf16_t* GluT = (bf16_t*)(p.ws + OFF_GLU);
    const int nit = part == 0 ? 3200 : (part == 1 ? 1280 : 4480);
    for (int it0 = wslot; it0 < nit; it0 += nwslots) {
        int r = part == 0 ? (it0 < 3072 ? it0 : it0 + 1280) : (part == 1 ? it0 + 3072 : it0);
        if (r < 3072) { const int kb = r / 192, nb = r % 192, oc = win_col(32 * nb);
            tr_item_i8(p.in[I_WIN] + (size_t)l * 1024 * 6144, 6144, 64 * kb, oc, (signed char*)WinT, 1024, 32 * nb, (const unsigned*)(p.ws + OFF_CMAXW) + l * 6144 + oc, kb == 0 ? (float*)(p.ws + OFF_SWIN) + l * 6144 + 32 * nb : nullptr, scr, F.lane); continue; }
        r -= 3072;
        if (r < 768) { const int br = r / 256, rem = r % 256, kb = rem / 32, nb = rem % 32; tr_item(p.in[I_WBR] + ((size_t)l * 3 + br) * 512 * 1024, 1024, 64 * kb, 32 * nb, WbrT + (size_t)br * 1024 * 512, 512, 32 * nb, scr, F.lane); continue; }
        r -= 768;
        if (r < 512) { const int kb = r / 32, nb = r % 32; tr_item(p.in[I_WOUT] + (size_t)l * 1024 * 1024, 1024, 64 * kb, 32 * nb, WoutT, 1024, 32 * nb, scr, F.lane); continue; }
        r -= 512;
        { const int kb = r / 16, nb = r % 16; tr_item(p.in[I_GLUW] + (size_t)l * 512 * 512, 512, 64 * kb, 32 * nb, GluT, 512, 32 * nb, scr, F.lane); }
    }
}
__device__ __forceinline__ void convert_experts(const Params& p, const Frame& F, int l, int slot, int nslots, int parts) {
    LAS float* scr = (LAS float*)(F.lds + 65536 + F.wave * 8448);
    LAS unsigned* cmx = (LAS unsigned*)(F.lds + 65536 + 8 * 8448);
    signed char* Wgu = (signed char*)(p.ws + OFF_WGU); bf16_t* Wd = (bf16_t*)(p.ws + OFF_WD); float* swgu = (float*)(p.ws + OFF_SWGU);
    const int lane = F.lane;
    if (parts & 1)
    for (int st = slot; st < 512; st += nslots) {
        const int e = st >> 5, nb = st & 31, n0 = 32 * nb, t = n0 >> 8, qq = n0 & 255, c0 = 128 * t + (qq & 127);
        const float* src = (qq < 128 ? p.in[I_EWG] : p.in[I_EWU]) + ((size_t)l * 16 + e) * 1024 * 512;
        __syncthreads();
        if (F.tid < 32) cmx[F.tid] = 0u;
        __syncthreads();
        f32x4 t0[8], t1[8];
#pragma unroll
        for (int i = 0; i < 8; ++i) { t0[i] = *(const f32x4*)(src + (size_t)(128 * F.wave + 8 * i + (lane >> 3)) * 512 + c0 + 4 * (lane & 7)); t1[i] = *(const f32x4*)(src + (size_t)(128 * F.wave + 64 + 8 * i + (lane >> 3)) * 512 + c0 + 4 * (lane & 7)); }
        f32x4 m = (f32x4){0.f, 0.f, 0.f, 0.f};
#pragma unroll
        for (int i = 0; i < 8; ++i) {
#pragma unroll
            for (int j = 0; j < 4; ++j) m[j] = fmaxf(m[j], fmaxf(fabsf(t0[i][j]), fabsf(t1[i][j]))); }
#pragma unroll
        for (int j = 0; j < 4; ++j) __hip_atomic_fetch_max(cmx + 4 * (lane & 7) + j, __float_as_uint(m[j]), __ATOMIC_RELAXED, __HIP_MEMORY_SCOPE_WORKGROUP);
        __syncthreads();
        const int n = lane & 31, hf = lane >> 5;
        const float cm = fmaxf(__uint_as_float(cmx[n]), 1e-30f), inv = 127.0f / cm;
        if (F.wave == 0 && hf == 0) swgu[e * 1024 + n0 + n] = cm * (1.0f / 127.0f);
#pragma unroll
        for (int tt = 0; tt < 2; ++tt) {
#pragma unroll
            for (int i = 0; i < 8; ++i) { LAS float* d = scr + (8 * i + (lane >> 3)) * 33 + 4 * (lane & 7); const f32x4 v = tt == 0 ? t0[i] : t1[i]; d[0] = v[0]; d[1] = v[1]; d[2] = v[2]; d[3] = v[3]; }
            asm volatile("s_waitcnt lgkmcnt(0)" ::: "memory");
            u32x4 o[2];
#pragma unroll
            for (int h = 0; h < 2; ++h) { unsigned w[4];
#pragma unroll
                for (int x = 0; x < 4; ++x) { const LAS float* sp = scr + (32 * hf + 16 * h + 4 * x) * 33 + n; w[x] = q8x4((f32x4){sp[0], sp[33], sp[66], sp[99]}, inv); }
                o[h] = (u32x4){w[0], w[1], w[2], w[3]}; }
            signed char* dp = Wgu + ((size_t)e * 1024 + n0 + n) * 1024 + 128 * F.wave + 64 * tt + 32 * hf;
            *(u32x4*)dp = o[0]; *(u32x4*)(dp + 16) = o[1];
            asm volatile("s_waitcnt lgkmcnt(0)" ::: "memory");
        }
    }
    if (parts & 2)
    for (int it = slot * NWAVE + F.wave; it < 4096; it += nslots * NWAVE) {
        const int e = it / 256, rem = it % 256, kb = rem / 32, nb = rem % 32;
        tr_item(p.in[I_EWD] + ((size_t)l * 16 + e) * 512 * 1024, 1024, 64 * kb, 32 * nb, Wd + (size_t)e * 1024 * 512, 512, 32 * nb, scr, F.lane);
    }
}

__device__ __forceinline__ void mod_items(const Params& p, const Frame& F) {
    LAS float* sc = (LAS float*)F.lds;
    LAS float* red = (LAS float*)(F.lds + 17 * 1024 * 4);
    float* mod = (float*)(p.ws + OFF_MOD);
    bool staged = false;
    __syncthreads();
    for (int it = F.blk; it < 384; it += NBLK) {
        if (!staged) {
            f32x4 tv[9];
#pragma unroll
            for (int x = 0; x < 8; ++x) tv[x] = *(const f32x4*)(p.in[I_C] + (F.tid + x * NTHR) * 4);
            tv[8] = *(const f32x4*)(p.in[I_CCTX] + (F.tid & 255) * 4);
#pragma unroll
            for (int x = 0; x < 9; ++x) { const int i = (x < 8 ? F.tid + x * NTHR : 4096 + (F.tid & 255)) * 4;
                if (x < 8 || F.tid < 256) *(LAS f32x4*)(sc + i) = (f32x4){siluf_(tv[x][0]), siluf_(tv[x][1]), siluf_(tv[x][2]), siluf_(tv[x][3])}; }
            staged = true;
        }
        __syncthreads();
        const int l = it / 192, n0 = (it % 192) * 32, ks = F.tid >> 5, cn = F.tid & 31;
        const float* w = p.in[I_WMOD] + (size_t)l * 1024 * 6144 + n0 + cn;
        float a[17];
#pragma unroll
        for (int mi = 0; mi < 17; ++mi) a[mi] = 0.f;
        for (int k0 = ks * 64; k0 < ks * 64 + 64; k0 += 16) { float wv[16];
#pragma unroll
            for (int x = 0; x < 16; ++x) wv[x] = w[(size_t)(k0 + x) * 6144];
#pragma unroll
            for (int x = 0; x < 16; ++x) {
#pragma unroll
                for (int mi = 0; mi < 17; ++mi) a[mi] += sc[mi * 1024 + k0 + x] * wv[x]; } }
#pragma unroll
        for (int mi = 0; mi < 17; ++mi) red[(ks * 17 + mi) * 32 + cn] = a[mi];
        __syncthreads();
        for (int i = F.tid; i < 17 * 32; i += NTHR) { const int mi = i >> 5, c2 = i & 31; float s = 0.f;
#pragma unroll
            for (int q = 0; q < 16; ++q) s += red[(q * 17 + mi) * 32 + c2];
            mod[((size_t)l * 17 + mi) * 6144 + n0 + c2] = s + p.in[I_BMOD][l * 6144 + n0 + c2]; }
    }
    __syncthreads();
}

__device__ __forceinline__ void s5_build_job(const Params& p, const Frame& F, int l, int job) {
    const int g = job >> 2, q = job & 3, tid = F.tid;
    LAS f32x2* ap = (LAS f32x2*)F.lds;
    LAS f32x2* bb = (LAS f32x2*)(F.lds + 34816);
    LAS f32x2* cc = (LAS f32x2*)(F.lds + 34816 + 16384);
    LAS f32x2* fz = (LAS f32x2*)(F.lds + 34816 + 32768);
    LAS float* kt = (LAS float*)(F.lds + 69632);
    LAS float* dvs = (LAS float*)(F.lds + 34816 + 32768 + 1024);
    __syncthreads();
    {
        const int pp = tid & 63, d = tid >> 8, tq = (tid >> 6) & 3, gi = (l * 2 + d) * 32 + g;
        const float ldt = p.in[I_LOGDT][gi], lr = p.in[I_LAMRE][gi * 64 + pp], li = p.in[I_LAMIM][gi * 64 + pp];
        if (tid < 16) dvs[tid] = p.in[I_S5D][l * 512 + g * 16 + tid];
        const float dt = expf(ldt), t0 = 8.0f * (float)tq;
        float sn, cs; const float m1 = expf(lr * dt); sincosf(li * dt, &sn, &cs); const float a1r = m1 * cs, a1i = m1 * sn;
        const float m0 = expf(lr * dt * t0); sincosf(li * dt * t0, &sn, &cs); float cr = m0 * cs, ci = m0 * sn;
        if (tq == 0) ap[(d * 33) * 64 + pp] = (f32x2){1.0f, 0.0f};
#pragma unroll
        for (int s_ = 1; s_ <= 8; ++s_) { const float nr = cr * a1r - ci * a1i, ni = cr * a1i + ci * a1r; cr = nr; ci = ni; ap[(d * 33 + 8 * tq + s_) * 64 + pp] = (f32x2){cr, ci}; }
    }
    if (tid < 128) {
        const int d = tid >> 6, pp = tid & 63, gi = (l * 2 + d) * 32 + g;
        const float dt = expf(p.in[I_LOGDT][gi]), lr = p.in[I_LAMRE][gi * 64 + pp], li = p.in[I_LAMIM][gi * 64 + pp];
        const float mag = expf(lr * dt); float sn, cs; sincosf(li * dt, &sn, &cs);
        const float abr = mag * cs, abi = mag * sn, den = lr * lr + li * li, nr = abr - 1.0f;
        fz[tid] = (f32x2){(nr * lr + abi * li) / den, (abi * lr - nr * li) / den};
    }
    __syncthreads();
    if (q == 0 && tid < 128) { const int d = tid >> 6, pp = tid & 63; const f32x2 a = ap[(d * 33 + 32) * 64 + pp]; float* aq = (float*)(p.ws + OFF_AQ) + ((((size_t)l * 2 + d) * 32 + g) * 64 + pp) * 2; aq[0] = a.x; aq[1] = a.y; }
#pragma unroll
    for (int it = 0; it < 4; ++it) { const int i = tid + it * NTHR;
        { const int d = i >> 10, pp = (i >> 4) & 63, h = i & 15; const size_t gi = ((((size_t)l * 2 + d) * 32 + g) * 64 + pp) * 16 + h;
          const float br = p.in[I_BRE][gi], bi = p.in[I_BIM][gi]; const f32x2 f = fz[d * 64 + pp]; bb[i] = (f32x2){f.x * br - f.y * bi, f.x * bi + f.y * br}; }
        { const int d = i >> 10, h = (i >> 6) & 15, pp = i & 63; const size_t gi = ((((size_t)l * 2 + d) * 32 + g) * 16 + h) * 64 + pp; cc[i] = (f32x2){p.in[I_CRE][gi], p.in[I_CIM][gi]}; }
    }
    __syncthreads();
    {
        const int hh = F.lane & 15, kg = F.lane >> 4;
        u32x4 bfr[2][4];
#pragma unroll
        for (int d = 0; d < 2; ++d)
#pragma unroll
            for (int ks = 0; ks < 4; ++ks) { unsigned w[4]; f32x2 bq[4];
#pragma unroll
                for (int jp = 0; jp < 4; ++jp) bq[jp] = bb[(d * 64 + 16 * ks + 4 * kg + jp) * 16 + hh];
#pragma unroll
                for (int jp = 0; jp < 4; ++jp) w[jp] = cvt_pk_bf16(bq[jp].x, bq[jp].y);
                bfr[d][ks] = (u32x4){w[0], w[1], w[2], w[3]}; }
        for (int tile = F.wave; tile < 64; tile += NWAVE) {
            const int d = tile >> 5, tau = tile & 31;
            f32x4 o = (f32x4){0.f, 0.f, 0.f, 0.f};
#pragma unroll
            for (int ks = 0; ks < 4; ++ks) { unsigned w[4];
                f32x2 cq[4], aq[4];
#pragma unroll
                for (int jp = 0; jp < 4; ++jp) { const int pp = 16 * ks + 4 * kg + jp; cq[jp] = cc[(d * 16 + hh) * 64 + pp]; aq[jp] = ap[(d * 33 + tau) * 64 + pp]; }
#pragma unroll
                for (int jp = 0; jp < 4; ++jp) { const f32x2 c = cq[jp], av = aq[jp];
                    w[jp] = cvt_pk_bf16(c.x * av.x - c.y * av.y, -(c.x * av.y + c.y * av.x)); }
                const u32x4 af = (u32x4){w[0], w[1], w[2], w[3]};
                o = __builtin_amdgcn_mfma_f32_16x16x32_bf16(__builtin_bit_cast(bf16x8, af), __builtin_bit_cast(bf16x8, d == 0 ? bfr[0][ks] : bfr[1][ks]), o, 0, 0, 0); }
#pragma unroll
            for (int r = 0; r < 4; ++r) kt[((d * 32 + tau) * 16 + 4 * kg + r) * 16 + hh] = o[r];
        }
    }
    __syncthreads();
    {
        bf16_t* WE = (bf16_t*)(p.ws + OFF_WE) + (size_t)g * 256 * 512;
        const int d = q >> 1, c = q & 1;
        for (int pc = tid; pc < 64 * 64; pc += NTHR) {
            const int pp = pc >> 6, col0 = (pc & 63) * 8, j = col0 >> 4, h0 = col0 & 15;
            const f32x2 a = ap[(d * 33 + (d == 0 ? 31 - j : j)) * 64 + pp];
            float v[8];
#pragma unroll
            for (int x = 0; x < 8; ++x) { const f32x2 b = bb[(d * 64 + pp) * 16 + h0 + x]; v[x] = c == 0 ? (a.x * b.x - a.y * b.y) : (a.x * b.y + a.y * b.x); }
            u32x4 o; o.x = cvt_pk_bf16(v[0], v[1]); o.y = cvt_pk_bf16(v[2], v[3]); o.z = cvt_pk_bf16(v[4], v[5]); o.w = cvt_pk_bf16(v[6], v[7]);
            *(u32x4*)(WE + (size_t)(64 * q + pp) * 512 + col0) = o;
        }
    }
    {
        bf16_t* TW = (bf16_t*)(p.ws + OFF_TW) + (size_t)g * 512 * 768;
        for (int pc = tid; pc < 128 * 96; pc += NTHR) {
            const int rl = pc / 96, cp = pc % 96, rr = 128 * q + rl, i = rr >> 4, h = rr & 15, col0 = cp * 8;
            float v[8];
            if (col0 < 512) {
                const int j = col0 >> 4, h0 = col0 & 15;
#pragma unroll
                for (int x = 0; x < 8; ++x) {
                    const int hp = h0 + x; float val;
                    if (i > j) val = kt[((0 * 32 + (i - j)) * 16 + h) * 16 + hp];
                    else if (i < j) val = kt[((1 * 32 + (j - i)) * 16 + h) * 16 + hp];
                    else val = kt[((0 * 32 + 0) * 16 + h) * 16 + hp] + kt[((1 * 32 + 0) * 16 + h) * 16 + hp] + (h == hp ? dvs[h] : 0.f);
                    v[x] = val;
                }
            } else {
                const int n0 = col0 - 512, d = n0 >> 7, c = (n0 >> 6) & 1, p0 = n0 & 63, tau = d == 0 ? i + 1 : 32 - i;
#pragma unroll
                for (int x = 0; x < 8; ++x) { const f32x2 cv = cc[(d * 16 + h) * 64 + p0 + x], a = ap[(d * 33 + tau) * 64 + p0 + x];
                    v[x] = c == 0 ? (cv.x * a.x - cv.y * a.y) : -(cv.x * a.y + cv.y * a.x); }
            }
            u32x4 o; o.x = cvt_pk_bf16(v[0], v[1]); o.y = cvt_pk_bf16(v[2], v[3]); o.z = cvt_pk_bf16(v[4], v[5]); o.w = cvt_pk_bf16(v[6], v[7]);
            *(u32x4*)(TW + (size_t)rr * 768 + col0) = o;
        }
    }
    __syncthreads();
}

__device__ __forceinline__ bf16_t* hrow_ptr(const Params& p, int r) { return (bf16_t*)(p.ws + OFF_HB) + (size_t)r * D; }
__device__ __forceinline__ f32x4 bf4(const u32x2 w) { return (f32x4){bf_lo(w.x), bf_hi(w.x), bf_lo(w.y), bf_hi(w.y)}; }
__device__ __forceinline__ int mod_index(int r) { return r < TLAT ? (r >> 11) : 16; }

__device__ __forceinline__ void phase_norm1(const Params& p, const Frame& F, int l, bool dry = false) {
    const float* mod = (const float*)(p.ws + OFF_MOD);
    signed char* Xq = (signed char*)(p.ws + (dry ? 422 * MiB : OFF_XN)); float* sxa = (float*)(p.ws + (dry ? 460 * MiB : OFF_SXA));
    const bf16_t* Y = (const bf16_t*)(p.ws + OFF_Y);
    const int* pos = (const int*)(p.ws + OFF_POS);
    const int lane = F.lane, row0 = F.blk * 144 + F.wave * 18;
    int mypos = 0; if (l == 1 && lane < 36) mypos = pos[2 * row0 + lane];
    f32x4 ch[4], mg[4], ms[4], m2[4]; u32x2 ca[4], cb[4]; int cmi = -1;
#define N1_LOAD(rr, H, A, B) do { const int r_ = (rr); \
        if (l == 0) { const float* src_ = (r_ < TLAT) ? (p.in[I_X] + (size_t)r_ * D) : (p.in[I_CTX] + (size_t)(r_ - TLAT) * D); \
            _Pragma("unroll") for (int j = 0; j < 4; ++j) { H[j] = *(const f32x4*)(src_ + 4 * lane + 256 * j); A[j] = (u32x2){0u, 0u}; B[j] = (u32x2){0u, 0u}; } } \
        else { const bf16_t* hp_ = hrow_ptr(p, r_); const int q_ = 2 * (r_ - row0); \
            const bf16_t* y0_ = Y + (size_t)__builtin_amdgcn_readlane(mypos, q_) * D; const bf16_t* y1_ = Y + (size_t)__builtin_amdgcn_readlane(mypos, q_ + 1) * D; \
            _Pragma("unroll") for (int j = 0; j < 4; ++j) { const int k_ = 4 * lane + 256 * j; H[j] = bf4(*(const u32x2*)(hp_ + k_)); A[j] = *(const u32x2*)(y0_ + k_); B[j] = *(const u32x2*)(y1_ + k_); } } } while (0)
    N1_LOAD(row0, ch, ca, cb);
    for (int i = 0; i < 18; ++i) {
        const int r = row0 + i, mi = mod_index(r);
        f32x4 nh[4]; u32x2 na[4], nb[4];
        if (i + 1 < 18) N1_LOAD(r + 1, nh, na, nb);
        f32x4 v[4];
        if (mi != cmi) { cmi = mi; const float* gn = p.in[I_N1G] + l * D; const float* sh = mod + ((size_t)l * 17 + mi) * 6144; const float* sc = sh + 1024;
            const float* g2 = mod + ((size_t)(l > 0 ? l - 1 : 0) * 17 + mi) * 6144 + 5120;
#pragma unroll
            for (int j = 0; j < 4; ++j) { const int k = 4 * lane + 256 * j; mg[j] = *(const f32x4*)(gn + k) * (1.0f + *(const f32x4*)(sc + k)); ms[j] = *(const f32x4*)(sh + k); m2[j] = *(const f32x4*)(g2 + k); } }
        if (l == 0) {
#pragma unroll
            for (int j = 0; j < 4; ++j) v[j] = ch[j];
        } else {
            bf16_t* hp = dry ? (bf16_t*)(p.ws + 350 * MiB) + (size_t)r * D : hrow_ptr(p, r);
#pragma unroll
            for (int j = 0; j < 4; ++j) {
                const int k = 4 * lane + 256 * j; const f32x4 gg = m2[j]; const u32x2 a = ca[j], b = cb[j];
                const f32x4 sm = (f32x4){bf_lo(a.x) + bf_lo(b.x), bf_hi(a.x) + bf_hi(b.x), bf_lo(a.y) + bf_lo(b.y), bf_hi(a.y) + bf_hi(b.y)};
                v[j] = ch[j] + gg * sm;
                u32x2 hw; hw.x = cvt_pk_bf16(v[j][0], v[j][1]); hw.y = cvt_pk_bf16(v[j][2], v[j][3]);
                *(u32x2*)(hp + k) = hw;
            }
        }
        float ss = 0.f;
#pragma unroll
        for (int j = 0; j < 4; ++j) ss += (v[j][0] * v[j][0] + v[j][1] * v[j][1]) + (v[j][2] * v[j][2] + v[j][3] * v[j][3]);
        const float rs = __builtin_amdgcn_rsqf(wave_sum(ss) * (1.0f / D) + EPS);
        float am = 0.f;
#pragma unroll
        for (int j = 0; j < 4; ++j) { v[j] = v[j] * rs * mg[j] + ms[j]; am = fmaxf(am, fmaxf(fmaxf(fabsf(v[j][0]), fabsf(v[j][1])), fmaxf(fabsf(v[j][2]), fabsf(v[j][3])))); }
        am = fmaxf(wave_max(am), 1e-30f);
        const float inv = 127.0f * __builtin_amdgcn_rcpf(am);
#pragma unroll
        for (int j = 0; j < 4; ++j) *(unsigned*)(Xq + (size_t)r * D + 4 * lane + 256 * j) = q8x4(v[j], inv);
        if (lane == 0) sxa[r] = am * (1.0f / 127.0f);
#pragma unroll
        for (int j = 0; j < 4; ++j) { ch[j] = nh[j]; ca[j] = na[j]; cb[j] = nb[j]; }
    }
#undef N1_LOAD
}

__device__ __forceinline__ void phase_final(const Params& p, const Frame& F) {
    const float* mod = (const float*)(p.ws + OFF_MOD);
    const bf16_t* Y = (const bf16_t*)(p.ws + OFF_Y);
    const int* pos = (const int*)(p.ws + OFF_POS);
    const int lane = F.lane, row0 = F.blk * 128 + F.wave * 16;
    int mypos = 0; if (lane < 32) mypos = pos[2 * row0 + lane];
    f32x4 ch[4], m2[4], fg[4]; u32x2 ca[4], cb[4]; int cmi = -1;
#pragma unroll
    for (int j = 0; j < 4; ++j) fg[j] = *(const f32x4*)(p.in[I_FNG] + 4 * lane + 256 * j);
#define FN_LOAD(rr, H, A, B) do { const int r_ = (rr); const bf16_t* hp_ = hrow_ptr(p, r_); const int q_ = 2 * (r_ - row0); \
        const bf16_t* y0_ = Y + (size_t)__builtin_amdgcn_readlane(mypos, q_) * D; const bf16_t* y1_ = Y + (size_t)__builtin_amdgcn_readlane(mypos, q_ + 1) * D; \
        _Pragma("unroll") for (int j = 0; j < 4; ++j) { const int k_ = 4 * lane + 256 * j; H[j] = bf4(*(const u32x2*)(hp_ + k_)); A[j] = *(const u32x2*)(y0_ + k_); B[j] = *(const u32x2*)(y1_ + k_); } } while (0)
    FN_LOAD(row0, ch, ca, cb);
    for (int i = 0; i < 16; ++i) {
        const int r = row0 + i, mi = r >> 11;
        f32x4 nh[4]; u32x2 na[4], nb[4];
        if (i + 1 < 16) FN_LOAD(r + 1, nh, na, nb);
        float* hp = p.out + (size_t)r * D;
        if (mi != cmi) { cmi = mi; const float* g2 = mod + ((size_t)1 * 17 + mi) * 6144 + 5120;
#pragma unroll
            for (int j = 0; j < 4; ++j) m2[j] = *(const f32x4*)(g2 + 4 * lane + 256 * j); }
        f32x4 v[4]; float ss = 0.f;
#pragma unroll
        for (int j = 0; j < 4; ++j) {
            const int k = 4 * lane + 256 * j; const f32x4 gg = m2[j]; const u32x2 a = ca[j], b = cb[j];
            const f32x4 sm = (f32x4){bf_lo(a.x) + bf_lo(b.x), bf_hi(a.x) + bf_hi(b.x), bf_lo(a.y) + bf_lo(b.y), bf_hi(a.y) + bf_hi(b.y)};
            v[j] = ch[j] + gg * sm;
            ss += (v[j][0] * v[j][0] + v[j][1] * v[j][1]) + (v[j][2] * v[j][2] + v[j][3] * v[j][3]);
        }
        const float rs = __builtin_amdgcn_rsqf(wave_sum(ss) * (1.0f / D) + EPS);
#pragma unroll
        for (int j = 0; j < 4; ++j) { const int k = 4 * lane + 256 * j; *(f32x4*)(hp + k) = v[j] * rs * fg[j]; }
#pragma unroll
        for (int j = 0; j < 4; ++j) { ch[j] = nh[j]; ca[j] = na[j]; cb[j] = nb[j]; }
    }
#undef FN_LOAD
}

#define EPI_FENCE() asm volatile("" ::: "memory")
#define OPAQUE_S(x) asm volatile("" : "+s"(x))
struct SchedB {
    const char* Xn; const char* W; int l, c;
    __device__ __forceinline__ bool next(int i, gs::Unit& u) const {
        const int L = i * NBLK + c, nmain = (l == 0 ? 144 : 128) * 24, ntot = nmain + (l == 0 ? 0 : 32);
        if (L >= ntot) return false;
        int pm, pn;
        if (L < nmain) { gs::tile_order(gs::xcd_remap(L, nmain), l == 0 ? 144 : 128, 24, pm, pn); }
        else { const int x = L - nmain; pm = 128 + (x >> 1); pn = 10 + (x & 1); }
        u.pm = pm; u.pn = pn; u.kind = 0; u.aux = 0;
        return true;
    }
    __device__ __forceinline__ void ops(const gs::Unit& u, gs::Ops& o) const { o.A = Xn + (size_t)u.pm * 256 * 1024; o.B = W + (size_t)u.pn * 256 * 1024; o.lda = 1024; o.ldb = 1024; o.nt = 8; o.rows = nullptr; }
};
struct EpiB {
    static constexpr bool KEEPS = false, I8 = true;
    bf16_t *U, *V, *Bb, *P, *Ux; unsigned char* G8; const float* sxa; const float* swin;
    __device__ __forceinline__ void operator()(const f32x4 (&acc)[2][2][4][2], const gs::Unit& u, int wr, int wc, int fr, int fq) const {
        const int pn = u.pn, r0 = u.pm * 256 + wr * 64 + fr, c0 = wc * 32 + 8 * fq;
        f32x4 sw[2][2]; float sx[2][4];
#pragma unroll
        for (int bj = 0; bj < 2; ++bj) { sw[bj][0] = *(const f32x4*)(swin + pn * 256 + bj * 128 + c0); sw[bj][1] = *(const f32x4*)(swin + pn * 256 + bj * 128 + c0 + 4); }
#pragma unroll
        for (int ai = 0; ai < 2; ++ai)
#pragma unroll
            for (int m = 0; m < 4; ++m) sx[ai][m] = sxa[r0 + ai * 128 + m * 16];
#define DQ(ai, bj, m, n) (__builtin_convertvector(__builtin_bit_cast(i32x4, acc[ai][bj][m][n]), f32x4) * (sw[bj][n] * sx[ai][m]))
        if (pn < 6) {
            size_t z1 = 0, z2 = 0, z3 = 0; OPAQUE_S(z1); OPAQUE_S(z2); OPAQUE_S(z3); bf16_t *u_ = U + z1, *v_ = V + z2, *b_ = Bb + z3;
            bf16_t* O = pn < 2 ? u_ : (pn < 4 ? v_ : b_); const bool act = pn < 4; const int cb = (pn & 1) * 256 + c0;
#pragma unroll
            for (int ai = 0; ai < 2; ++ai)
#pragma unroll
                for (int m = 0; m < 4; ++m) { bf16_t* rowp = O + (size_t)(r0 + ai * 128 + m * 16) * 512 + cb;
#pragma unroll
                    for (int bj = 0; bj < 2; ++bj) { f32x4 v0 = DQ(ai, bj, m, 0), v1 = DQ(ai, bj, m, 1);
                        if (act) { v0 = gelu4(v0); v1 = gelu4(v1); }
                        *(u32x4*)(rowp + bj * 128) = pack8(v0, v1); }
                    EPI_FENCE(); }
        } else if (pn < 10) {
            const int cb = (pn - 6) * 128 + c0;
#pragma unroll
            for (int ai = 0; ai < 2; ++ai)
#pragma unroll
                for (int m = 0; m < 4; ++m) {
                    *(u32x4*)(P + (size_t)(r0 + ai * 128 + m * 16) * 512 + cb) = pack8(DQ(ai, 0, m, 0) * DQ(ai, 1, m, 0), DQ(ai, 0, m, 1) * DQ(ai, 1, m, 1));
                    EPI_FENCE(); }
        } else if (pn >= 12) {
            const int cb = (pn - 12) * 256 + wc * 64 + fq * 16;
#pragma unroll
            for (int ai = 0; ai < 2; ++ai)
#pragma unroll
                for (int m = 0; m < 4; ++m) { unsigned char* rowp = G8 + (size_t)(r0 + ai * 128 + m * 16) * 3072 + cb; unsigned wq[2][2];
#pragma unroll
                    for (int bj = 0; bj < 2; ++bj)
#pragma unroll
                        for (int n = 0; n < 2; ++n) wq[bj][n] = gate4_u8_t(__builtin_convertvector(__builtin_bit_cast(i32x4, acc[ai][bj][m][n]), f32x4) * (sw[bj][n] * (sx[ai][m] * -1.44269504089f)) + (-8.0f));
                    *(u32x4*)rowp = (u32x4){wq[0][0], wq[0][1], wq[1][0], wq[1][1]};
                    EPI_FENCE(); }
        } else {
#pragma unroll
            for (int ai = 0; ai < 2; ++ai)
#pragma unroll
                for (int m = 0; m < 4; ++m) { const int r = r0 + ai * 128 + m * 16, ch = r >> 5, ii = r & 31;
#pragma unroll
                    for (int bj = 0; bj < 2; ++bj) { const int cch = (pn - 10) * 256 + bj * 128 + c0, g = cch >> 4, h0 = cch & 15;
                        *(u32x4*)(Ux + ((size_t)g * NCHP + ch) * 768 + ii * 16 + h0) = pack8(DQ(ai, bj, m, 0), DQ(ai, bj, m, 1)); }
                    EPI_FENCE(); }
        }
#undef DQ
    }
};
struct SchedE {
    const char* Ux; const char* WE; int c;
    __device__ __forceinline__ bool next(int i, gs::Unit& u) const {
        const int L = i * NBLK + c; if (L >= 160) return false;
        u.pm = L % 5; u.pn = 0; u.kind = 0; u.aux = L / 5;
        return true;
    }
    __device__ __forceinline__ void ops(const gs::Unit& u, gs::Ops& o) const { o.A = Ux + ((size_t)u.aux * NCHP + u.pm * 256) * 1536; o.B = WE + (size_t)u.aux * 256 * 1024; o.lda = 1536; o.ldb = 1024; o.nt = 8; o.rows = nullptr; }
};
struct EpiE {
    static constexpr bool KEEPS = false, I8 = false;
    float* E;
    __device__ __forceinline__ void operator()(const f32x4 (&acc)[2][2][4][2], const gs::Unit& u, int wr, int wc, int fr, int fq) const {
        const int g = u.aux, m0 = u.pm * 256 + wr * 64 + fr, c0 = wc * 32 + 8 * fq;
#pragma unroll
        for (int ai = 0; ai < 2; ++ai)
#pragma unroll
            for (int m = 0; m < 4; ++m) { const int mm = m0 + ai * 128 + m * 16;
                if (mm < NCH) { float* rowp = E + ((size_t)g * NCH + mm) * 256 + c0;
#pragma unroll
                    for (int bj = 0; bj < 2; ++bj) { *(f32x4*)(rowp + bj * 128) = acc[ai][bj][m][0]; *(f32x4*)(rowp + bj * 128 + 4) = acc[ai][bj][m][1]; } }
                EPI_FENCE(); }
    }
};
struct SchedY {
    const char* Ux; const char* TW; int l, c;
    __device__ __forceinline__ bool next(int i, gs::Unit& u) const {
        const int npm = l == 0 ? 5 : 4, ntot = 32 * npm * 2, L = i * NBLK + c; if (L >= ntot) return false;
        const int g = L / (npm * 2), rem = L % (npm * 2);
        u.pm = rem >> 1; u.pn = rem & 1; u.kind = 0; u.aux = g;
        return true;
    }
    __device__ __forceinline__ void ops(const gs::Unit& u, gs::Ops& o) const { o.A = Ux + ((size_t)u.aux * NCHP + u.pm * 256) * 1536; o.B = TW + ((size_t)u.aux * 512 + u.pn * 256) * 1536; o.lda = 1536; o.ldb = 1536; o.nt = 12; o.rows = nullptr; }
};
struct EpiY {
    static constexpr bool KEEPS = false, I8 = false;
    bf16_t* Z;
    __device__ __forceinline__ void operator()(const f32x4 (&acc)[2][2][4][2], const gs::Unit& u, int wr, int wc, int fr, int fq) const {
        const int g = u.aux, m0 = u.pm * 256 + wr * 64 + fr, c0 = u.pn * 256 + wc * 32 + 8 * fq;
#pragma unroll
        for (int ai = 0; ai < 2; ++ai)
#pragma unroll
            for (int m = 0; m < 4; ++m) { const int mm = m0 + ai * 128 + m * 16;
                if (mm < NCH) {
#pragma unroll
                    for (int bj = 0; bj < 2; ++bj) { const int cn = c0 + bj * 128, ii = cn >> 4, h0 = cn & 15; const f32x4 v0 = gelu4(acc[ai][bj][m][0]), v1 = gelu4(acc[ai][bj][m][1]);
                        *(u32x4*)(Z + ((size_t)mm * 32 + ii) * 512 + g * 16 + h0) = pack8(v0, v1); } }
                EPI_FENCE(); }
    }
};
struct SchedF {
    const char* Z; const char* W; int l, c;
    __device__ __forceinline__ bool next(int i, gs::Unit& u) const {
        const int nM = l == 0 ? 144 : 128, ntot = nM * 2, L = i * NBLK + c; if (L >= ntot) return false;
        int pm, pn; gs::tile_order(gs::xcd_remap(L, ntot), nM, 2, pm, pn);
        u.pm = pm; u.pn = pn; u.kind = 0; u.aux = 0;
        return true;
    }
    __device__ __forceinline__ void ops(const gs::Unit& u, gs::Ops& o) const { o.A = Z + (size_t)u.pm * 256 * 1024; o.B = W + (size_t)u.pn * 256 * 1024; o.lda = 1024; o.ldb = 1024; o.nt = 8; o.rows = nullptr; }
};
struct EpiF {
    static constexpr bool KEEPS = false, I8 = false;
    const bf16_t* Z; bf16_t* Yc; const float* gb;
    __device__ __forceinline__ void operator()(const f32x4 (&acc)[2][2][4][2], const gs::Unit& u, int wr, int wc, int fr, int fq) const {
        const int r0 = u.pm * 256 + wr * 64 + fr, c0 = u.pn * 256 + wc * 32 + 8 * fq;
        f32x4 gbv[2][2];
#pragma unroll
        for (int bj = 0; bj < 2; ++bj) { gbv[bj][0] = *(const f32x4*)(gb + c0 + bj * 128); gbv[bj][1] = *(const f32x4*)(gb + c0 + bj * 128 + 4); }
#pragma unroll
        for (int ai = 0; ai < 2; ++ai)
#pragma unroll
            for (int mh = 0; mh < 2; ++mh) {
                u32x4 zw[4];
#pragma unroll
                for (int x = 0; x < 4; ++x) zw[x] = *(const u32x4*)(Z + (size_t)(r0 + ai * 128 + (mh * 2 + (x >> 1)) * 16) * 512 + c0 + (x & 1) * 128);
#pragma unroll
                for (int x = 0; x < 4; ++x) { const int m = mh * 2 + (x >> 1), bj = x & 1; const size_t ro = (size_t)(r0 + ai * 128 + m * 16) * 512 + c0;
                    f32x4 z0, z1; unpack8(zw[x], z0, z1);
                    f32x4 v0 = acc[ai][bj][m][0] + gbv[bj][0], v1 = acc[ai][bj][m][1] + gbv[bj][1];
#pragma unroll
                    for (int j = 0; j < 4; ++j) { v0[j] = z0[j] * sigmoidf_(v0[j]); v1[j] = z1[j] * sigmoidf_(v1[j]); }
                    *(u32x4*)(Yc + ro + bj * 128) = pack8(v0, v1); }
                EPI_FENCE(); }
    }
};
struct SchedG {
    const char* Y0; const char* Y1; const char* Y2; const char* Wbr; int l, c;
    __device__ __forceinline__ bool next(int i, gs::Unit& u) const {
        const int nM = l == 0 ? 144 : 128, ntile = nM * 4, tl = i / 3, s = i % 3, L = tl * NBLK + c; if (L >= ntile) return false;
        int pm, pn; gs::tile_order(gs::xcd_remap(L, ntile), nM, 4, pm, pn);
        u.pm = pm; u.pn = pn; u.kind = s; u.aux = 0;
        return true;
    }
    __device__ __forceinline__ void ops(const gs::Unit& u, gs::Ops& o) const {
        const int br = u.kind;
        size_t z1 = 0, z2 = 0, z3 = 0; OPAQUE_S(z1); OPAQUE_S(z2); OPAQUE_S(z3); const char *y0_ = Y0 + z1, *y1_ = Y1 + z2, *y2_ = Y2 + z3; const char* y = br == 0 ? y0_ : (br == 1 ? y1_ : y2_);
        o.A = y + (size_t)u.pm * 256 * 1024; o.B = Wbr + ((size_t)br * 1024 + u.pn * 256) * 1024; o.lda = 1024; o.ldb = 1024; o.nt = 8; o.rows = nullptr;
    }
};
__device__ __forceinline__ void u8x8_to_f32(const u32x2 w, f32x4& a, f32x4& b) {
    a = (f32x4){(float)(w.x & 255u), (float)((w.x >> 8) & 255u), (float)((w.x >> 16) & 255u), (float)(w.x >> 24)};
    b = (f32x4){(float)(w.y & 255u), (float)((w.y >> 8) & 255u), (float)((w.y >> 16) & 255u), (float)(w.y >> 24)};
    a = a + 0.5f; b = b + 0.5f;
}
struct EpiG {
    static constexpr bool KEEPS = true, I8 = false;
    const unsigned char* G8; bf16_t* merged;
    __device__ __forceinline__ bool scale(f32x4 (&acc)[2][2][4][2], const gs::Unit& u, int wr, int wc, int fr, int fq) const {
        const int s = u.kind, r0 = u.pm * 256 + wr * 64 + fr, c0 = u.pn * 256 + wc * 32 + 8 * fq;
        const unsigned char* gp = G8 + (size_t)r0 * 3072 + s * 1024 + u.pn * 256 + wc * 64 + fq * 16;
#pragma unroll
        for (int ai = 0; ai < 2; ++ai) {
            u32x4 ga4[4], gb4[4];
#pragma unroll
            for (int m = 0; m < 4; ++m) { const size_t o = (size_t)(ai * 128 + m * 16) * 3072; ga4[m] = *(const u32x4*)(gp + o); if (s < 2) gb4[m] = *(const u32x4*)(gp + o + 1024); }
#pragma unroll
            for (int x = 0; x < 8; ++x) { const int m = x >> 1, bj = x & 1;
                const u32x2 gax = bj == 0 ? (u32x2){ga4[m].x, ga4[m].y} : (u32x2){ga4[m].z, ga4[m].w};
                f32x4 n0, n1; u8x8_to_f32(gax, n0, n1);
                if (s < 2) { const u32x2 gbx = bj == 0 ? (u32x2){gb4[m].x, gb4[m].y} : (u32x2){gb4[m].z, gb4[m].w}; f32x4 d0, d1; u8x8_to_f32(gbx, d0, d1);
#pragma unroll
                    for (int j = 0; j < 4; ++j) { n0[j] *= __builtin_amdgcn_rcpf(d0[j]); n1[j] *= __builtin_amdgcn_rcpf(d1[j]); } }
                if (s == 2) { n0 = n0 * (1.0f / 256.0f); n1 = n1 * (1.0f / 256.0f); }
                acc[ai][bj][m][0] *= n0; acc[ai][bj][m][1] *= n1;
                if (s == 2) *(u32x4*)(merged + (size_t)(r0 + ai * 128 + m * 16) * 1024 + c0 + bj * 128) = pack8(acc[ai][bj][m][0], acc[ai][bj][m][1]); }
            EPI_FENCE(); }
        return s < 2;
    }
};
struct SchedH {
    const char* A; const char* W; int l, c;
    __device__ __forceinline__ bool next(int i, gs::Unit& u) const {
        const int nM = l == 0 ? 144 : 128, ntot = nM * 4, L = i * NBLK + c; if (L >= ntot) return false;
        int pm, pn; gs::tile_order(gs::xcd_remap(L, ntot), nM, 4, pm, pn);
        u.pm = pm; u.pn = pn; u.kind = 0; u.aux = 0;
        return true;
    }
    __device__ __forceinline__ void ops(const gs::Unit& u, gs::Ops& o) const { o.A = A + (size_t)u.pm * 256 * 2048; o.B = W + (size_t)u.pn * 256 * 2048; o.lda = 2048; o.ldb = 2048; o.nt = 16; o.rows = nullptr; }
};
template <int LZ> struct EpiH {
    static constexpr bool KEEPS = false, I8 = false;
    const float* xin; const float* cin; bf16_t* Hb; const float* mod;
    __device__ __forceinline__ void operator()(const f32x4 (&acc)[2][2][4][2], const gs::Unit& u, int wr, int wc, int fr, int fq) const {
        const int rt = u.pm * 256, c0 = u.pn * 256 + wc * 32 + 8 * fq;
        const bool lat = rt < TLAT; const int mi = lat ? (rt >> 11) : 16;
        size_t z1 = 0, z2 = 0; OPAQUE_S(z1); OPAQUE_S(z2);
        const float* base = lat ? (xin + z1 + (size_t)rt * D) : (cin + z2 + (size_t)(rt - TLAT) * D);
        bf16_t* hb = Hb + (size_t)rt * D;
        const float* g1 = mod + (size_t)mi * 6144 + 2048 + c0;
        f32x4 g1v[2][2];
#pragma unroll
        for (int bj = 0; bj < 2; ++bj) { g1v[bj][0] = *(const f32x4*)(g1 + bj * 128); g1v[bj][1] = *(const f32x4*)(g1 + bj * 128 + 4); }
#pragma unroll
        for (int ai = 0; ai < 2; ++ai)
#pragma unroll
            for (int m = 0; m < 4; ++m) {
                f32x4 hv[2][2]; const size_t rb_ = (size_t)(wr * 64 + fr + ai * 128 + m * 16) * D + c0;
#pragma unroll
                for (int bj = 0; bj < 2; ++bj) { const size_t ro = rb_ + bj * 128;
                    if constexpr (LZ == 1) { hv[bj][0] = *(const f32x4*)(base + ro); hv[bj][1] = *(const f32x4*)(base + ro + 4); }
                    else unpack8(*(const u32x4*)(hb + ro), hv[bj][0], hv[bj][1]); }
#pragma unroll
                for (int bj = 0; bj < 2; ++bj) { const size_t ro = rb_ + bj * 128;
                    *(u32x4*)(hb + ro) = pack8(hv[bj][0] + g1v[bj][0] * acc[ai][bj][m][0], hv[bj][1] + g1v[bj][1] * acc[ai][bj][m][1]); }
                EPI_FENCE(); }
    }
};
struct SchedK {
    const char* Xn2; const char* Wgu; const int* rowl; const LAS int* toff; int c;
    __device__ __forceinline__ bool next(int i, gs::Unit& u) const {
        const int nt_ = __builtin_amdgcn_readfirstlane(toff[16]), ntot = nt_ * 4, L = i * NBLK + c; if (L >= ntot) return false;
        const int w = gs::xcd_remap(L, ntot), mt = w >> 2; int e = 0;
        { const int ln = (int)__builtin_amdgcn_mbcnt_hi(~0u, __builtin_amdgcn_mbcnt_lo(~0u, 0u)), tv = toff[ln < 16 ? ln : 16];
          e = __builtin_popcountll(__ballot(ln >= 1 && ln < 16 && tv <= mt)); }
        u.pm = mt; u.pn = w & 3; u.kind = 0; u.aux = e;
        return true;
    }
    __device__ __forceinline__ void ops(const gs::Unit& u, gs::Ops& o) const { o.A = Xn2; o.B = Wgu + ((size_t)u.aux * 1024 + u.pn * 256) * 1024; o.lda = 1024; o.ldb = 1024; o.nt = 8; o.rows = rowl + u.pm * 256; }
};
struct EpiK {
    static constexpr bool KEEPS = false, I8 = true;
    bf16_t* He; const float* sxs; const float* swgu;
    __device__ __forceinline__ void operator()(const f32x4 (&acc)[2][2][4][2], const gs::Unit& u, int wr, int wc, int fr, int fq) const {
        const int r0 = u.pm * 256 + wr * 64 + fr, c0 = u.pn * 128 + wc * 32 + 8 * fq, t0 = u.aux * 1024 + u.pn * 256 + wc * 32 + 8 * fq;
        f32x4 sw[2][2]; float sx[2][4];
#pragma unroll
        for (int bj = 0; bj < 2; ++bj) { sw[bj][0] = *(const f32x4*)(swgu + t0 + bj * 128); sw[bj][1] = *(const f32x4*)(swgu + t0 + bj * 128 + 4); }
#pragma unroll
        for (int ai = 0; ai < 2; ++ai)
#pragma unroll
            for (int m = 0; m < 4; ++m) sx[ai][m] = sxs[r0 + ai * 128 + m * 16];
#define DQ(ai, bj, m, n) (__builtin_convertvector(__builtin_bit_cast(i32x4, acc[ai][bj][m][n]), f32x4) * (sw[bj][n] * sx[ai][m]))
#pragma unroll
        for (int ai = 0; ai < 2; ++ai)
#pragma unroll
            for (int m = 0; m < 4; ++m) { f32x4 v0 = DQ(ai, 0, m, 0), v1 = DQ(ai, 0, m, 1); const f32x4 u0 = DQ(ai, 1, m, 0), u1 = DQ(ai, 1, m, 1);
#pragma unroll
                for (int j = 0; j < 4; ++j) { v0[j] = siluf_(v0[j]) * u0[j]; v1[j] = siluf_(v1[j]) * u1[j]; }
                *(u32x4*)(He + (size_t)(r0 + ai * 128 + m * 16) * 512 + c0) = pack8(v0, v1);
                EPI_FENCE(); }
#undef DQ
    }
};
struct SchedL {
    const char* He; const char* Wd; const LAS int* toff; int c;
    __device__ __forceinline__ bool next(int i, gs::Unit& u) const {
        const int nt_ = __builtin_amdgcn_readfirstlane(toff[16]), ntot = nt_ * 4, L = i * NBLK + c; if (L >= ntot) return false;
        const int w = gs::xcd_remap(L, ntot), mt = w >> 2; int e = 0;
        { const int ln = (int)__builtin_amdgcn_mbcnt_hi(~0u, __builtin_amdgcn_mbcnt_lo(~0u, 0u)), tv = toff[ln < 16 ? ln : 16];
          e = __builtin_popcountll(__ballot(ln >= 1 && ln < 16 && tv <= mt)); }
        u.pm = mt; u.pn = w & 3; u.kind = 0; u.aux = e;
        return true;
    }
    __device__ __forceinline__ void ops(const gs::Unit& u, gs::Ops& o) const { o.A = He + (size_t)u.pm * 256 * 1024; o.B = Wd + ((size_t)u.aux * 1024 + u.pn * 256) * 1024; o.lda = 1024; o.ldb = 1024; o.nt = 8; o.rows = nullptr; }
};
struct EpiL {
    static constexpr bool KEEPS = false, I8 = false;
    bf16_t* Y; const float* wl;
    __device__ __forceinline__ void operator()(const f32x4 (&acc)[2][2][4][2], const gs::Unit& u, int wr, int wc, int fr, int fq) const {
        const int r0 = u.pm * 256 + wr * 64 + fr, c0 = u.pn * 256 + wc * 32 + 8 * fq;
        float wv[2][4];
#pragma unroll
        for (int ai = 0; ai < 2; ++ai)
#pragma unroll
            for (int m = 0; m < 4; ++m) wv[ai][m] = wl[r0 + ai * 128 + m * 16];
#pragma unroll
        for (int ai = 0; ai < 2; ++ai)
#pragma unroll
            for (int m = 0; m < 4; ++m) { const int r = r0 + ai * 128 + m * 16; const float w = wv[ai][m];
#pragma unroll
                for (int bj = 0; bj < 2; ++bj) *(u32x4*)(Y + (size_t)r * 1024 + c0 + bj * 128) = pack8(acc[ai][bj][m][0] * w, acc[ai][bj][m][1] * w);
                EPI_FENCE(); }
    }
};

__device__ __forceinline__ void phase_sgu(const Params& p, const Frame& F, int l) {
    bf16_t* U = (bf16_t*)(p.ws + OFF_U); const bf16_t* V = (const bf16_t*)(p.ws + OFF_V);
    const bf16_t* W16 = (const bf16_t*)(p.ws + OFF_SGUW16) + (size_t)l * 4 * 128 * 128;
    LAS float* mu = (LAS float*)F.lds; LAS float* rsd = mu + 128;
    LAS unsigned char* Vn = F.lds + 1024;
    LAS unsigned char* Wl = F.lds + 1024 + 128 * 264;
    const int nchunk = l == 0 ? 288 : 256, tid = F.tid, lane = F.lane, wave = F.wave;
    const float* gam = p.in[I_SGUNG] + l * 512;
    const int vk = tid >> 2, vpart = tid & 3;
    for (int un = 0; un < 2; ++un) {
        int cu, hd0, hd1;
        if (un == 0) { cu = F.blk; hd0 = 0; hd1 = 4; if (cu >= nchunk) continue; }
        else { const int x = F.blk - 128; if (x < 0 || 256 + (x >> 2) >= nchunk) continue; cu = 256 + (x >> 2); hd0 = x & 3; hd1 = hd0 + 1; }
        const int r0 = cu * 128;
        __syncthreads();
        {
            u32x4 w16[16];
#pragma unroll
            for (int x = 0; x < 16; ++x) w16[x] = *(const u32x4*)(V + (size_t)(r0 + wave * 16 + x) * 512 + lane * 8);
#pragma unroll
            for (int x = 0; x < 16; ++x) { const int k = wave * 16 + x; f32x4 a, b; unpack8(w16[x], a, b);
                const float sm = wave_sum((a[0] + a[1]) + (a[2] + a[3]) + (b[0] + b[1]) + (b[2] + b[3])), mean = sm * (1.0f / 512.0f);
                a = a - mean; b = b - mean;
                const float q = wave_sum((a[0] * a[0] + a[1] * a[1]) + (a[2] * a[2] + a[3] * a[3]) + (b[0] * b[0] + b[1] * b[1]) + (b[2] * b[2] + b[3] * b[3]));
                if (lane == 0) { mu[k] = mean; rsd[k] = 1.0f / sqrtf(q * (1.0f / 512.0f) + EPS); } }
        }
        u32x4 pv[4], pw[4]; f32x4 pg[4][2];
#define SGU_PREFETCH(hd_) do { _Pragma("unroll") for (int x = 0; x < 4; ++x) { pv[x] = *(const u32x4*)(V + (size_t)(r0 + vk) * 512 + (hd_) * 128 + vpart * 32 + x * 8); \
            pw[x] = *(const u32x4*)(W16 + (size_t)(hd_) * 16384 + (tid + x * 512) * 8); \
            pg[x][0] = *(const f32x4*)(gam + (hd_) * 128 + vpart * 32 + x * 8); pg[x][1] = *(const f32x4*)(gam + (hd_) * 128 + vpart * 32 + x * 8 + 4); } } while (0)
        SGU_PREFETCH(hd0);
        for (int hd = hd0; hd < hd1; ++hd) {
            __syncthreads();
            { const float m_ = mu[vk], r_ = rsd[vk];
#pragma unroll
              for (int x = 0; x < 4; ++x) { const int c = vpart * 32 + x * 8;
                  f32x4 a, b; unpack8(pv[x], a, b); const f32x4 ga = pg[x][0], gb = pg[x][1];
                  a = (a - m_) * r_ * ga; b = (b - m_) * r_ * gb;
                  u32x2 o0, o1; o0.x = cvt_pk_bf16(a[0], a[1]); o0.y = cvt_pk_bf16(a[2], a[3]); o1.x = cvt_pk_bf16(b[0], b[1]); o1.y = cvt_pk_bf16(b[2], b[3]);
                  *(LAS u32x2*)(Vn + vk * 264 + c * 2) = o0; *(LAS u32x2*)(Vn + vk * 264 + c * 2 + 8) = o1;
                  const int e8 = (tid + x * 512) * 8, qq = e8 >> 7, kk = e8 & 127; *(LAS u32x4*)(Wl + qq * 272 + kk * 2) = pw[x]; } }
            if (hd + 1 < hd1) SGU_PREFETCH(hd + 1);
            const int kg = lane >> 4, cl = wave * 16 + (lane & 15);
            u32x2 uu[8];
#pragma unroll
            for (int qt = 0; qt < 8; ++qt) uu[qt] = *(const u32x2*)(U + (size_t)(r0 + qt * 16 + (lane & 15)) * 512 + hd * 128 + wave * 16 + 4 * kg);
            const float* bs = p.in[I_SGUB] + ((size_t)l * 4 + hd) * 128;
            float bqv[8];
#pragma unroll
            for (int qt = 0; qt < 8; ++qt) bqv[qt] = bs[qt * 16 + (lane & 15)];
            __syncthreads();
            f32x4 o[8];
#pragma unroll
            for (int qt = 0; qt < 8; ++qt) o[qt] = (f32x4){0.f, 0.f, 0.f, 0.f};
#pragma unroll
            for (int ks = 0; ks < 4; ++ks) {
                bf16x8 af, bfv[8];
#pragma unroll
                for (int j = 0; j < 8; ++j) af[j] = (short)*(const LAS bf16_t*)(Vn + (ks * 32 + kg * 8 + j) * 264 + cl * 2);
#pragma unroll
                for (int qt = 0; qt < 8; ++qt) bfv[qt] = *(const LAS bf16x8*)(Wl + (qt * 16 + (lane & 15)) * 272 + (ks * 32 + kg * 8) * 2);
                __builtin_amdgcn_sched_barrier(0);
#pragma unroll
                for (int qt = 0; qt < 8; ++qt) o[qt] = __builtin_amdgcn_mfma_f32_16x16x32_bf16(af, bfv[qt], o[qt], 0, 0, 0);
                __builtin_amdgcn_sched_barrier(0);
            }
#pragma unroll
            for (int qt = 0; qt < 8; ++qt) { const int qq = qt * 16 + (lane & 15); const float bq = bqv[qt]; const u32x2 uw = uu[qt];
                u32x2 ow; ow.x = cvt_pk_bf16(bf_lo(uw.x) * (o[qt][0] + bq), bf_hi(uw.x) * (o[qt][1] + bq)); ow.y = cvt_pk_bf16(bf_lo(uw.y) * (o[qt][2] + bq), bf_hi(uw.y) * (o[qt][3] + bq));
                *(u32x2*)(U + (size_t)(r0 + qq) * 512 + hd * 128 + wave * 16 + 4 * kg) = ow; }
        }
#undef SGU_PREFETCH
    }
    __syncthreads();
}
__device__ __forceinline__ void phase_conv(const Params& p, const Frame& F, int l) {
    bf16_t* Bb = (bf16_t*)(p.ws + OFF_BB); const bf16_t* P = (const bf16_t*)(p.ws + OFF_P);
    const float* cw = p.in[I_CONVW] + l * 3 * 512;
    const int nrows = l == 0 ? TALL : TLAT, npc = nrows * 64;
    const int c = (F.tid & 63) * 8;
    const f32x4 w0a = *(const f32x4*)(cw + c), w0b = *(const f32x4*)(cw + c + 4), w1a = *(const f32x4*)(cw + 512 + c), w1b = *(const f32x4*)(cw + 512 + c + 4), w2a = *(const f32x4*)(cw + 1024 + c), w2b = *(const f32x4*)(cw + 1024 + c + 4);
    const int nv = 352, vb0 = F.blk < 160 ? F.blk : 160 + 2 * (F.blk - 160), nvb = F.blk < 160 ? 1 : 2;
    for (int vb = vb0; vb < vb0 + nvb; ++vb)
    for (int it = vb * NTHR + F.tid; it < npc; it += 2 * nv * NTHR) {
        const int it2 = it + nv * NTHR; const bool two = it2 < npc;
        const int r = it >> 6, r2 = two ? (it2 >> 6) : r;
        const int s = r < TLAT ? (r & 63) : ((r - TLAT) & 255), smax = r < TLAT ? 63 : 255, s2 = r2 < TLAT ? (r2 & 63) : ((r2 - TLAT) & 255), smax2 = r2 < TLAT ? 63 : 255;
        const u32x4 zero = (u32x4){0u, 0u, 0u, 0u};
        const u32x4 xc = *(const u32x4*)(P + (size_t)r * 512 + c), xp = s > 0 ? *(const u32x4*)(P + (size_t)(r - 1) * 512 + c) : zero, xn = s < smax ? *(const u32x4*)(P + (size_t)(r + 1) * 512 + c) : zero, xb = *(const u32x4*)(Bb + (size_t)r * 512 + c);
        const u32x4 yc = *(const u32x4*)(P + (size_t)r2 * 512 + c), yp = s2 > 0 ? *(const u32x4*)(P + (size_t)(r2 - 1) * 512 + c) : zero, yn = s2 < smax2 ? *(const u32x4*)(P + (size_t)(r2 + 1) * 512 + c) : zero, yb = *(const u32x4*)(Bb + (size_t)r2 * 512 + c);
        { f32x4 x0, x1, pa, pb, na, nb, b0, b1; unpack8(xc, x0, x1); unpack8(xp, pa, pb); unpack8(xn, na, nb); unpack8(xb, b0, b1);
          *(u32x4*)(Bb + (size_t)r * 512 + c) = pack8(b0 * (w0a * pa + w1a * x0 + w2a * na), b1 * (w0b * pb + w1b * x1 + w2b * nb)); }
        if (two) { f32x4 x0, x1, pa, pb, na, nb, b0, b1; unpack8(yc, x0, x1); unpack8(yp, pa, pb); unpack8(yn, na, nb); unpack8(yb, b0, b1);
          *(u32x4*)(Bb + (size_t)r2 * 512 + c) = pack8(b0 * (w0a * pa + w1a * x0 + w2a * na), b1 * (w0b * pb + w1b * x1 + w2b * nb)); }
    }
}
__device__ __forceinline__ void phase_scan(const Params& p, const Frame& F, int l) {
    if (F.blk >= 128) return;
    const int T = F.blk * NTHR + F.tid, pp = T & 63, g = (T >> 6) & 31, b = (T >> 11) & 15, dir = T >> 15;
    const float* E = (const float*)(p.ws + OFF_E) + (size_t)g * NCH * 256 + dir * 128 + pp;
    bf16_t* Ux = (bf16_t*)(p.ws + OFF_UX) + (size_t)g * NCHP * 768 + 512 + dir * 128 + pp;
    const float* aq = (const float*)(p.ws + OFF_AQ) + ((((size_t)l * 2 + dir) * 32 + g) * 64 + pp) * 2;
    const float ar = aq[0], ai = aq[1];
    float sr = 0.f, si = 0.f;
#pragma unroll 8
    for (int st = 0; st < 72; ++st) {
        int m;
        if (dir == 0) m = st < 8 ? (1024 + b * 8 + st) : (b * 64 + (st - 8));
        else m = st < 8 ? (1024 + b * 8 + (7 - st)) : (b * 64 + (71 - st));
        const float er = E[(size_t)m * 256], ei = E[(size_t)m * 256 + 64];
        Ux[(size_t)m * 768] = (bf16_t)(cvt_pk_bf16(sr, 0.f) & 0xffffu); Ux[(size_t)m * 768 + 64] = (bf16_t)(cvt_pk_bf16(si, 0.f) & 0xffffu);
        const float nr = ar * sr - ai * si + er, ni = ar * si + ai * sr + ei; sr = nr; si = ni;
    }
}
__device__ __forceinline__ void phase_router(const Params& p, const Frame& F, int l) {
    const float* mod = (const float*)(p.ws + OFF_MOD);
    signed char* Xq2 = (signed char*)(p.ws + OFF_XN); float* sx2 = (float*)(p.ws + OFF_SX2);
    LAS float* rw = (LAS float*)F.lds;
    LAS int* lsel = (LAS int*)(F.lds + 133632);
    LAS int* lrk = lsel + 288;
    LAS float* lgs = (LAS float*)(lrk + 288);
    int* sel = (int*)(p.ws + OFF_SEL); float* wsel = (float*)(p.ws + OFF_WSEL); int* lrank = (int*)(p.ws + OFF_LRANK); int* cnt = (int*)(p.ws + OFF_CNT);
    const int NR = l == 0 ? 144 : 128, RW = NR / 8, lane = F.lane;
    __syncthreads();
    { f32x4 wt[8];
#pragma unroll
      for (int x = 0; x < 8; ++x) wt[x] = *(const f32x4*)(p.in[I_RW] + (F.tid + x * NTHR) * 4);
#pragma unroll
      for (int x = 0; x < 8; ++x) { const int i = (F.tid + x * NTHR) * 4, kk = i >> 4, e = i & 15;
          const int k = 4 * ((kk & 511) >> 3) + 256 * (2 * (kk >> 9) + ((kk >> 2) & 1)) + (kk & 3);
          rw[e * 1024 + k] = wt[x][0]; rw[(e + 1) * 1024 + k] = wt[x][1]; rw[(e + 2) * 1024 + k] = wt[x][2]; rw[(e + 3) * 1024 + k] = wt[x][3]; } }
    __syncthreads();
    float rb[16];
#pragma unroll
    for (int e = 0; e < 16; ++e) rb[e] = p.in[I_RB][e];
    const int row0 = F.blk * NR + F.wave * RW;
    f32x4 chA[4], chB[4], mg[4], ms[4]; int cmi = -1;
#define RT_K(j) (8 * lane + 512 * ((j) >> 1) + 4 * ((j) & 1))
#define RT_LOAD(rr, H) do { const bf16_t* hp_ = hrow_ptr(p, (rr)); _Pragma("unroll") for (int jj = 0; jj < 2; ++jj) { const u32x4 w_ = *(const u32x4*)(hp_ + 8 * lane + 512 * jj); \
            H[2 * jj] = bf4((u32x2){w_.x, w_.y}); H[2 * jj + 1] = bf4((u32x2){w_.z, w_.w}); } } while (0)
#define RT_NORM(rr, V) do { const int r_ = (rr), mi_ = mod_index(r_); float ss_ = 0.f; \
        _Pragma("unroll") for (int j = 0; j < 4; ++j) ss_ += (V[j][0] * V[j][0] + V[j][1] * V[j][1]) + (V[j][2] * V[j][2] + V[j][3] * V[j][3]); \
        const float rs_ = __builtin_amdgcn_rsqf(wave_sum(ss_) * (1.0f / D) + EPS); \
        if (mi_ != cmi) { cmi = mi_; const float* gn_ = p.in[I_N2G] + l * D; const float* sh_ = mod + ((size_t)l * 17 + mi_) * 6144 + 3072; const float* sc_ = sh_ + 1024; \
            _Pragma("unroll") for (int j = 0; j < 4; ++j) { const int k_ = RT_K(j); mg[j] = *(const f32x4*)(gn_ + k_) * (1.0f + *(const f32x4*)(sc_ + k_)); ms[j] = *(const f32x4*)(sh_ + k_); } } \
        float am_ = 0.f; \
        _Pragma("unroll") for (int j = 0; j < 4; ++j) { V[j] = V[j] * rs_ * mg[j] + ms[j]; am_ = fmaxf(am_, fmaxf(fmaxf(fabsf(V[j][0]), fabsf(V[j][1])), fmaxf(fabsf(V[j][2]), fabsf(V[j][3])))); } \
        am_ = fmaxf(wave_max(am_), 1e-30f); const float inv_ = 127.0f * __builtin_amdgcn_rcpf(am_); \
        _Pragma("unroll") for (int jj = 0; jj < 2; ++jj) *(u32x2*)(Xq2 + (size_t)r_ * D + 8 * lane + 512 * jj) = (u32x2){q8x4(V[2 * jj], inv_), q8x4(V[2 * jj + 1], inv_)}; \
        if (lane == 0) sx2[r_] = am_ * (1.0f / 127.0f); } while (0)
#define RT_REDUCE(SX, LX) do { float k8_[8], k4_[4], k2_[2]; \
        _Pragma("unroll") for (int q = 0; q < 8; ++q) { const float keep = b3 ? SX[q + 8] : SX[q], send = b3 ? SX[q] : SX[q + 8]; k8_[q] = keep + dpp_f<0x128>(send); } \
        _Pragma("unroll") for (int q = 0; q < 4; ++q) { const float keep = b2 ? k8_[q + 4] : k8_[q], send = b2 ? k8_[q] : k8_[q + 4]; k4_[q] = keep + dpp_f<0x141>(send); } \
        _Pragma("unroll") for (int q = 0; q < 2; ++q) { const float keep = b1 ? k4_[q + 2] : k4_[q], send = b1 ? k4_[q] : k4_[q + 2]; k2_[q] = keep + dpp_f<0x4E>(send); } \
        { const float keep = b0 ? k2_[1] : k2_[0], send = b0 ? k2_[0] : k2_[1]; LX = keep + dpp_f<0xB1>(send); } } while (0)
    const bool b3 = (lane & 8) != 0, b2 = (lane & 4) != 0, b1 = (lane & 2) != 0, b0 = (lane & 1) != 0;
    RT_LOAD(row0, chA); RT_LOAD(row0 + 1, chB);
    for (int i = 0; i < RW; i += 2) {
        const int lr_ = F.wave * RW + i, r = row0 + i;
        f32x4 nA[4], nB[4];
        if (i + 2 < RW) { RT_LOAD(r + 2, nA); RT_LOAD(r + 3, nB); }
        RT_NORM(r, chA); RT_NORM(r + 1, chB);
        float sxA[16], sxB[16]; f32x4 wq[2][4];
#pragma unroll
        for (int j = 0; j < 4; ++j) wq[0][j] = *(const LAS f32x4*)(rw + 4 * lane + 256 * j);
#pragma unroll
        for (int e = 0; e < 16; ++e) { f32x4 a4 = (f32x4){0.f, 0.f, 0.f, 0.f}, c4 = (f32x4){0.f, 0.f, 0.f, 0.f};
            if (e < 15) {
#pragma unroll
                for (int j = 0; j < 4; ++j) wq[(e + 1) & 1][j] = *(const LAS f32x4*)(rw + (e + 1) * 1024 + 4 * lane + 256 * j); }
            __builtin_amdgcn_sched_barrier(0);
#pragma unroll
            for (int j = 0; j < 4; ++j) { a4 += chA[j] * wq[e & 1][j]; c4 += chB[j] * wq[e & 1][j]; }
            sxA[e] = (a4[0] + a4[1]) + (a4[2] + a4[3]); sxB[e] = (c4[0] + c4[1]) + (c4[2] + c4[3]);
            __builtin_amdgcn_sched_barrier(0); }
        float lxA, lxB; RT_REDUCE(sxA, lxA); RT_REDUCE(sxB, lxB);
        lxA += __shfl_xor(lxA, 16); lxB += __shfl_xor(lxB, 16); lxA += __shfl_xor(lxA, 32); lxB += __shfl_xor(lxB, 32);
        if (lane < 16) { lgs[lr_ * 16 + lane] = lxA; lgs[(lr_ + 1) * 16 + lane] = lxB; }
#pragma unroll
        for (int j = 0; j < 4; ++j) { chA[j] = nA[j]; chB[j] = nB[j]; }
    }
#undef RT_LOAD
#undef RT_K
#undef RT_NORM
#undef RT_REDUCE
    asm volatile("s_waitcnt lgkmcnt(0)" ::: "memory");
    if (lane < RW) {
        const int lr_ = F.wave * RW + lane, r = row0 + lane;
        float sc_[16], bi[16];
#pragma unroll
        for (int e = 0; e < 16; ++e) { sc_[e] = 1.0f / (1.0f + expf(-lgs[lr_ * 16 + e])); bi[e] = sc_[e] + rb[e]; }
        int bg = 0; float bgs = -1e30f;
#pragma unroll
        for (int gq = 0; gq < 4; ++gq) { float m1 = -1e30f, m2 = -1e30f;
#pragma unroll
            for (int j = 0; j < 4; ++j) { const float x = bi[gq * 4 + j]; if (x > m1) { m2 = m1; m1 = x; } else if (x > m2) m2 = x; }
            const float gsum = m1 + m2; if (gsum > bgs) { bgs = gsum; bg = gq; } }
        float c4[4], s4[4];
#pragma unroll
        for (int j = 0; j < 4; ++j) { c4[j] = bg == 0 ? bi[j] : (bg == 1 ? bi[4 + j] : (bg == 2 ? bi[8 + j] : bi[12 + j])); s4[j] = bg == 0 ? sc_[j] : (bg == 1 ? sc_[4 + j] : (bg == 2 ? sc_[8 + j] : sc_[12 + j])); }
        int i1 = 0; float b1v = c4[0], w1 = s4[0];
#pragma unroll
        for (int j = 1; j < 4; ++j) if (c4[j] > b1v) { i1 = j; b1v = c4[j]; w1 = s4[j]; }
        int i2 = -1; float b2v = -1e30f, w2 = 0.f;
#pragma unroll
        for (int j = 0; j < 4; ++j) if (j != i1 && (i2 < 0 || c4[j] > b2v)) { i2 = j; b2v = c4[j]; w2 = s4[j]; }
        const float inv = 1.0f / (w1 + w2);
        const int e0 = bg * 4 + i1, e1 = bg * 4 + i2; sel[2 * r] = e0; sel[2 * r + 1] = e1; wsel[2 * r] = w1 * inv; wsel[2 * r + 1] = w2 * inv; lsel[2 * lr_] = e0; lsel[2 * lr_ + 1] = e1;
    }
    __syncthreads();
    int me = -1, myrank = 0;
    if (F.tid < 320) {
        me = F.tid < 2 * NR ? lsel[F.tid] : -1; int wc = 0;
        const unsigned long long below = (1ull << lane) - 1ull;
#pragma unroll
        for (int e = 0; e < 16; ++e) { const unsigned long long m = __ballot(me == e); if (me == e) myrank = __builtin_popcountll(m & below); if (lane == e) wc = __builtin_popcountll(m); }
        if (lane < 16) lrk[F.wave * 16 + lane] = wc;
    }
    __syncthreads();
    if (F.tid < 2 * NR) { int c = myrank;
#pragma unroll
        for (int w = 0; w < 4; ++w) c += (w < F.wave) ? lrk[w * 16 + me] : 0;
        lrank[2 * (F.blk * NR) + F.tid] = c; }
    if (F.tid >= 496) { const int e = F.tid - 496; cnt[F.blk * 16 + e] = (lrk[e] + lrk[16 + e]) + (lrk[32 + e] + lrk[48 + e]) + lrk[64 + e]; }
}
__device__ __forceinline__ void phase_lists(const Params& p, const Frame& F, int l) {
    LAS int* part = (LAS int*)F.lds;
    LAS int* tot = part + 512;
    LAS int* base = tot + 16;
    LAS int* toff = base + 16;
    const int* cnt = (const int*)(p.ws + OFF_CNT); const int* sel = (const int*)(p.ws + OFF_SEL); const float* wsel = (const float*)(p.ws + OFF_WSEL); const int* lrank = (const int*)(p.ws + OFF_LRANK);
    int* pos = (int*)(p.ws + OFF_POS); int* rowl = (int*)(p.ws + OFF_ROWL); float* wl = (float*)(p.ws + OFF_WL); int* seg = (int*)(p.ws + OFF_SEG);
    float* sxs = (float*)(p.ws + OFF_SXS); const float* sx2 = (const float*)(p.ws + OFF_SX2);
    const int NR = l == 0 ? 144 : 128;
    __syncthreads();
    { const int e = F.tid & 15, pt = F.tid >> 4; int s = 0, sb = 0;
      int cv[8];
#pragma unroll
      for (int j = 0; j < 8; ++j) cv[j] = cnt[(pt * 8 + j) * 16 + e];
#pragma unroll
      for (int j = 0; j < 8; ++j) { s += cv[j]; if (pt * 8 + j < F.blk) sb += cv[j]; }
      part[pt * 16 + e] = s; part[512 + 64 + pt * 16 + e] = sb; }
    __syncthreads();
    if (F.tid < 16) { int s = 0, sb = 0;
#pragma unroll
        for (int pt = 0; pt < 32; ++pt) { s += part[pt * 16 + F.tid]; sb += part[576 + pt * 16 + F.tid]; }
        tot[F.tid] = s; base[F.tid] = sb; }
    __syncthreads();
    if (F.tid == 0) { int o = 0, tv[16];
#pragma unroll
        for (int e = 0; e < 16; ++e) tv[e] = tot[e];
#pragma unroll
        for (int e = 0; e < 16; ++e) { toff[e] = o; o += (tv[e] + 255) >> 8; }
        toff[16] = o; }
    __syncthreads();
    if (F.blk == 0 && F.tid < 17) seg[F.tid] = toff[F.tid];
    for (int i = F.tid; i < 2 * NR; i += NTHR) { const int idx = 2 * (F.blk * NR) + i, e = sel[idx], ps = toff[e] * 256 + base[e] + lrank[idx]; pos[idx] = ps; rowl[ps] = idx >> 1; wl[ps] = wsel[idx]; sxs[ps] = sx2[idx >> 1]; }
    if (F.blk < 16) { const int e = F.blk, lo = toff[e] * 256 + tot[e], hi = toff[e + 1] * 256; for (int i = lo + F.tid; i < hi; i += NTHR) { rowl[i] = 0; wl[i] = 0.f; sxs[i] = 0.f; } }
    __syncthreads();
}
__device__ __forceinline__ void load_toff(const Params& p, const Frame& F) {
    LAS int* toff = (LAS int*)(F.lds + LDS_CTL_OFF + 64);
    __syncthreads();
    if (F.tid < 17) toff[F.tid] = ((const int*)(p.ws + OFF_SEG))[F.tid];
    __syncthreads();
}

#define OPAQUE_V(x) asm volatile("" : "+v"(x))
#define PHASE_ENTER() Frame F; { int t_ = threadIdx.x; OPAQUE_V(t_); F.tid = t_; F.lane = t_ & 63; F.wave = __builtin_amdgcn_readfirstlane(t_ >> 6); int b_ = blockIdx.x; OPAQUE_S(b_); F.blk = b_; F.lds = (LAS unsigned char*)lds_raw; } \
    size_t wz_ = 0; OPAQUE_S(wz_); unsigned char* ws = p.ws + wz_; int l = l0; OPAQUE_S(l); (void)l; (void)ws
__global__ void __launch_bounds__(NTHR, 2) fwd_kernel(Params p) {
    extern __shared__ __attribute__((aligned(16))) unsigned char lds_raw[];
    for (int u = threadIdx.x; u < (LDS_BYTES - LDS_CTL_OFF) / 4; u += NTHR) ((LAS unsigned*)((LAS unsigned char*)lds_raw + LDS_CTL_OFF))[u] = 0u;
    __syncthreads();
#if !MK_LAUNCH_PER_PHASE
    XcdBarrier bar = xcd_barrier_post((unsigned*)(p.ws + OFF_CTL), (volatile LAS unsigned*)((LAS unsigned char*)lds_raw + LDS_CTL_OFF));
#define GRID_BAR() xcd_barrier(bar)
#else
#define GRID_BAR() do { } while (0)
#endif
    const int lo = (int)p.ph_lo, hi = (int)p.ph_hi;
#define IN(k) (lo <= (k) && (k) < hi)
#define SEAM(k) do { if (IN(k) && IN((k) + 1)) { GRID_BAR(); if ((REPEAT_MASK >> 16) & 1) GRID_BAR(); } } while (0)
#ifndef NPASS
#define NPASS 1
#endif
    for (int pass_ = 0; pass_ < NPASS; ++pass_) {
    if (pass_ > 0) GRID_BAR();
    if (PH_ON(0) && IN(0)) {
        const int l0 = 0;
        REP(0) { PHASE_ENTER();
        { bf16_t* w16 = (bf16_t*)(ws + OFF_SGUW16); const int i8 = (F.blk * NTHR + F.tid) * 8;
          for (int i = i8; i < 262144; i += NBLK * NTHR * 8) { const f32x4 a = *(const f32x4*)(p.in[I_SGUW] + i), b = *(const f32x4*)(p.in[I_SGUW] + i + 4); *(u32x4*)(w16 + i) = pack8(a, b); } }
        mod_items(p, F);
        if (F.blk >= 128) s5_build_job(p, F, 0, 255 - F.blk);
        __syncthreads();
        if (F.blk < 128) { colmax_win(p, F); convert_mix(p, F, 0, 1, F.blk * NWAVE + F.wave, 128 * NWAVE); } }
    }
    SEAM(0);
    for (int l0 = 0; l0 < DEPTH; ++l0) {
        const int pb = 1 + 12 * l0;
        if (PH_ON(1) && IN(pb + 0)) {
            for (int rep_ = 0; rep_ < 1 + (((REPEAT_MASK >> 1) & 1) && l0 == 0 ? 1 : 0); ++rep_) { PHASE_ENTER();
            if (l == 1) convert_mix(p, F, 1, 1, F.blk * NWAVE + F.wave, NBLK * NWAVE);
            else convert_mix(p, F, 0, 0, F.blk * NWAVE + F.wave, NBLK * NWAVE);
            if (((REPEAT_MASK >> 18) & 1) && l == 1) phase_norm1(p, F, l, true);
            phase_norm1(p, F, l); }
        }
        SEAM(pb + 0);
        if (PH_ON(2) && IN(pb + 1)) {
            REP(2) { PHASE_ENTER();
            SchedB S{(const char*)(ws + OFF_XN), (const char*)(ws + OFF_WIN), l, F.blk};
            EpiB E{(bf16_t*)(ws + OFF_U), (bf16_t*)(ws + OFF_V), (bf16_t*)(ws + OFF_BB), (bf16_t*)(ws + OFF_P), (bf16_t*)(ws + OFF_UX), ws + OFF_G8, (const float*)(ws + OFF_SXA), (const float*)(ws + OFF_SWIN) + (size_t)l * 6144};
            gs::gemm_stream<EpiB, SchedB, false>(F.lds, F.tid, S, E); }
        }
        SEAM(pb + 1);
        if (PH_ON(3) && IN(pb + 2)) {
            REP(3) { PHASE_ENTER(); SchedE S{(const char*)(ws + OFF_UX), (const char*)(ws + OFF_WE), F.blk}; EpiE E{(float*)(ws + OFF_E)}; gs::gemm_stream<EpiE, SchedE, false>(F.lds, F.tid, S, E); }
            { PHASE_ENTER(); phase_conv(p, F, l); }
        }
        SEAM(pb + 2);
        if (PH_ON(4) && IN(pb + 3)) { REP(4) { PHASE_ENTER(); phase_scan(p, F, l); } { PHASE_ENTER(); phase_sgu(p, F, l); } }
        SEAM(pb + 3);
        if (PH_ON(5) && IN(pb + 4)) REP(5) { PHASE_ENTER(); SchedY S{(const char*)(ws + OFF_UX), (const char*)(ws + OFF_TW), l, F.blk}; EpiY E{(bf16_t*)(ws + OFF_V)}; gs::gemm_stream<EpiY, SchedY, false>(F.lds, F.tid, S, E); }
        SEAM(pb + 4);
        if (PH_ON(6) && IN(pb + 5)) REP(6) { PHASE_ENTER(); SchedF S{(const char*)(ws + OFF_V), (const char*)(ws + OFF_GLU), l, F.blk}; EpiF E{(const bf16_t*)(ws + OFF_V), (bf16_t*)(ws + OFF_P), p.in[I_GLUB] + l * 512}; gs::gemm_stream<EpiF, SchedF, false>(F.lds, F.tid, S, E); }
        SEAM(pb + 5);
        if (PH_ON(7) && IN(pb + 6)) {
            REP(7) { PHASE_ENTER();
            SchedG S{(const char*)(ws + OFF_U), (const char*)(ws + OFF_BB), (const char*)(ws + OFF_P), (const char*)(ws + OFF_WBR), l, F.blk};
            EpiG E{ws + OFF_G8, (bf16_t*)(ws + OFF_MERGED)};
            gs::gemm_stream<EpiG, SchedG, false>(F.lds, F.tid, S, E); }
            if (l0 == 0) {
                PHASE_ENTER();
                if (F.blk >= 64 && F.blk < 192) s5_build_job(p, F, 1, F.blk - 64);
                __syncthreads();
                if (F.blk >= 64) convert_mix(p, F, 1, 0, (F.blk - 64) * NWAVE + F.wave, 192 * NWAVE);
            }
        }
        SEAM(pb + 6);
        if (PH_ON(8) && IN(pb + 7)) {
            for (int rep_ = 0; rep_ < 1 + (((REPEAT_MASK >> 8) & 1) && l0 == 0 ? 1 : 0); ++rep_) { PHASE_ENTER();
            SchedH S{(const char*)(ws + OFF_MERGED), (const char*)(ws + OFF_WOUT), l, F.blk};
            if (l == 0) { EpiH<1> E{p.in[I_X], p.in[I_CTX], (bf16_t*)(ws + OFF_HB), (const float*)(ws + OFF_MOD) + (size_t)l * 17 * 6144}; gs::gemm_stream<EpiH<1>, SchedH, false>(F.lds, F.tid, S, E); }
            else { EpiH<0> E{p.in[I_X], p.in[I_CTX], (bf16_t*)(ws + OFF_HB), (const float*)(ws + OFF_MOD) + (size_t)l * 17 * 6144}; gs::gemm_stream<EpiH<0>, SchedH, false>(F.lds, F.tid, S, E); } }
            { PHASE_ENTER(); if (l == 0 && F.blk >= 64) convert_experts(p, F, 0, F.blk - 64, NBLK - 64, 3); }
        }
        SEAM(pb + 7);
        if (PH_ON(9) && IN(pb + 8)) { REP(9) { PHASE_ENTER(); phase_router(p, F, l); } REP(10) { PHASE_ENTER(); if (l == 1) convert_experts(p, F, l, F.blk, NBLK, 1); } }
        SEAM(pb + 8);
        if (PH_ON(10) && IN(pb + 9)) REP(13) { PHASE_ENTER(); phase_lists(p, F, l); }
        SEAM(pb + 9);
        if (PH_ON(11) && IN(pb + 10)) {
            REP(11) { PHASE_ENTER();
            load_toff(p, F);
            SchedK S{(const char*)(ws + OFF_XN), (const char*)(ws + OFF_WGU), (const int*)(ws + OFF_ROWL), (const LAS int*)(F.lds + LDS_CTL_OFF + 64), F.blk};
            EpiK E{(bf16_t*)(ws + OFF_HE), (const float*)(ws + OFF_SXS), (const float*)(ws + OFF_SWGU)};
            gs::gemm_stream<EpiK, SchedK, true>(F.lds, F.tid, S, E); }
            { PHASE_ENTER(); if (l == 1) { const int r = (__builtin_amdgcn_readfirstlane(((const LAS int*)(F.lds + LDS_CTL_OFF + 64))[16]) * 4) & 255;
                if (r == 0 || r > 128) convert_experts(p, F, 1, F.blk, NBLK, 2); else if (F.blk >= r) convert_experts(p, F, 1, F.blk - r, NBLK - r, 2); } }
        }
        SEAM(pb + 10);
        if (PH_ON(12) && IN(pb + 11)) {
            REP(12) { PHASE_ENTER();
            load_toff(p, F);
            SchedL S{(const char*)(ws + OFF_HE), (const char*)(ws + OFF_WD), (const LAS int*)(F.lds + LDS_CTL_OFF + 64), F.blk};
            EpiL E{(bf16_t*)(ws + OFF_Y), (const float*)(ws + OFF_WL)};
            gs::gemm_stream<EpiL, SchedL, false>(F.lds, F.tid, S, E); }
        }
        SEAM(pb + 11);
    }
    if (PH_ON(13) && IN(25)) { const int l0 = 1; REP(17) { PHASE_ENTER(); phase_final(p, F); } }
    }
#undef IN
#undef SEAM
}


extern "C" void kernel_launch(void* const* d_in, const int* in_sizes, int n_in, void* d_out, int out_size, void* d_ws, size_t ws_size, hipStream_t stream) {
    static int ready = 0;
    if (ready == 0) {
        if (n_in != 31 || out_size != TLAT * D || ws_size < WS_END) { fprintf(stderr, "kernel_launch: unexpected shapes (n_in %d out %d ws %zu)\n", n_in, out_size, ws_size); ready = -1; return; }
        if (hipFuncSetAttribute((const void*)fwd_kernel, hipFuncAttributeMaxDynamicSharedMemorySize, LDS_BYTES) != hipSuccess) { fprintf(stderr, "kernel_launch: hipFuncSetAttribute failed\n"); ready = -1; return; }
        int per_cu = 0;
        if (hipOccupancyMaxActiveBlocksPerMultiprocessor(&per_cu, (const void*)fwd_kernel, NTHR, LDS_BYTES) != hipSuccess || per_cu < 1) fprintf(stderr, "kernel_launch: occupancy query says %d\n", per_cu);
        (void)hipGetLastError();
        ready = 1;
    }
    if (ready < 0) return;
    (void)hipMemsetAsync((char*)d_ws + OFF_CTL, 0, CTL_ZERO_BYTES, stream);
    Params p{};
    for (int i = 0; i < 31; ++i) p.in[i] = (const float*)d_in[i];
    p.out = (float*)d_out; p.ws = (unsigned char*)d_ws;
#if MK_LAUNCH_PER_PHASE
    for (int ph = 0; ph < 26; ++ph) { p.ph_lo = ph; p.ph_hi = ph + 1; hipLaunchKernelGGL(fwd_kernel, dim3(NBLK), dim3(NTHR), LDS_BYTES, stream, p); }
#else
    p.ph_lo = 0; p.ph_hi = 26;
    hipLaunchKernelGGL(fwd_kernel, dim3(NBLK), dim3(NTHR), LDS_BYTES, stream, p);
#endif
}
```

```cpp
#include <hip/hip_runtime.h>
#include <cstdio>
#include <cstdint>

#ifndef MK_LAUNCH_PER_PHASE
#define MK_LAUNCH_PER_PHASE 0
#endif

#ifndef PHASE_MASK
#define PHASE_MASK 0xFFFF
#endif
#define PH_ON(k) (((PHASE_MASK) >> (k)) & 1)
#ifndef REPEAT_MASK
#define REPEAT_MASK 0
#endif
#define REP(k) for (int rep_ = 0; rep_ < 1 + ((REPEAT_MASK >> (k)) & 1); ++rep_)
#define LAS __attribute__((address_space(3)))
#define GAS __attribute__((address_space(1)))
typedef unsigned short bf16_t;
typedef short bf16x8 __attribute__((ext_vector_type(8)));
typedef float f32x4 __attribute__((ext_vector_type(4)));
typedef float f32x2 __attribute__((ext_vector_type(2)));
typedef unsigned u32x4 __attribute__((ext_vector_type(4)));
typedef unsigned u32x2 __attribute__((ext_vector_type(2)));
typedef int i32x4 __attribute__((ext_vector_type(4)));

constexpr int D = 1024, TLAT = 32768, TCTX = 4096, TALL = 36864, DEPTH = 2;
constexpr int NBLK = 256, NTHR = 512, NWAVE = 8;
constexpr int NCH = 1152, NCHP = 1280, SQ = 32;
constexpr float EPS = 1e-6f;
constexpr int MAXROWS = 77824;

constexpr size_t MiB = 1u << 20;
constexpr size_t OFF_CTL = 0, CTL_ZERO_BYTES = 65536;
constexpr size_t OFF_CMAXW = OFF_CTL + 16384;
constexpr size_t OFF_SXA = OFF_CTL + 393216;
constexpr size_t OFF_SWIN = OFF_CTL + 655360;
constexpr size_t OFF_SWGU = OFF_CTL + 720896;
constexpr size_t OFF_SX2 = OFF_CTL + 786432;
constexpr size_t OFF_SXS = 21 * MiB + 512 * 1024;
constexpr size_t OFF_SGUW16 = OFF_CTL + 131072;
constexpr size_t OFF_MOD = 1 * MiB;
constexpr size_t OFF_MISC = 2 * MiB;
constexpr size_t OFF_AQ = OFF_MISC;
constexpr size_t OFF_CNT = OFF_MISC + 64 * 1024;
constexpr size_t OFF_SEG = OFF_MISC + 80 * 1024;
constexpr size_t OFF_SEL = OFF_MISC + 128 * 1024;
constexpr size_t OFF_WSEL = OFF_MISC + 448 * 1024;
constexpr size_t OFF_LRANK = OFF_MISC + 768 * 1024;
constexpr size_t OFF_POS = OFF_MISC + 1088 * 1024;
constexpr size_t OFF_ROWL = OFF_MISC + 1408 * 1024;
constexpr size_t OFF_WL = OFF_MISC + 1728 * 1024;
constexpr size_t OFF_WIN = 4 * MiB;
constexpr size_t OFF_WBR = 16 * MiB;
constexpr size_t OFF_WOUT = 19 * MiB;
constexpr size_t OFF_GLU = 21 * MiB;
constexpr size_t OFF_WE = 22 * MiB;
constexpr size_t OFF_TW = 30 * MiB;
constexpr size_t OFF_HB = 54 * MiB;
constexpr size_t OFF_XN = 126 * MiB;
constexpr size_t OFF_U = 198 * MiB;
constexpr size_t OFF_V = 234 * MiB;
constexpr size_t OFF_BB = 270 * MiB;
constexpr size_t OFF_P = 306 * MiB;
constexpr size_t OFF_UX = 342 * MiB;
constexpr size_t OFF_G8 = 402 * MiB;
constexpr size_t WS_END = 510 * MiB;
constexpr size_t OFF_MERGED = OFF_XN;
constexpr size_t OFF_E = OFF_XN;
constexpr size_t OFF_Y = 198 * MiB;
constexpr size_t OFF_HE = 350 * MiB;
constexpr size_t OFF_WGU = 426 * MiB;
constexpr size_t OFF_WD = 458 * MiB;
static_assert(OFF_Y + (size_t)MAXROWS * 1024 * 2 <= OFF_HE && OFF_HE + (size_t)MAXROWS * 512 * 2 <= OFF_WGU && OFF_WD + (size_t)16 * 1024 * 512 * 2 <= WS_END && OFF_G8 + (size_t)TALL * 3072 <= WS_END, "overlay map");

constexpr int RING_BYTES = 131072;
constexpr int LDS_CTL_OFF = 159744;
constexpr int LDS_BYTES = 160768;

__device__ __forceinline__ unsigned cvt_pk_bf16(float lo, float hi) { unsigned r; asm volatile("v_cvt_pk_bf16_f32 %0, %1, %2" : "=v"(r) : "v"(lo), "v"(hi)); return r; }
__device__ __forceinline__ float bf_lo(unsigned w) { return __uint_as_float(w << 16); }
__device__ __forceinline__ float bf_hi(unsigned w) { return __uint_as_float(w & 0xffff0000u); }
__device__ __forceinline__ float bf1(bf16_t b) { return __uint_as_float(((unsigned)b) << 16); }
__device__ __forceinline__ float sigmoidf_(float x) { return __builtin_amdgcn_rcpf(1.0f + __builtin_amdgcn_exp2f(-1.44269504089f * x)); }
__device__ __forceinline__ float siluf_(float x) { return x * sigmoidf_(x); }
__device__ __forceinline__ float geluf_(float x) { return x * sigmoidf_(1.59576912161f * x * (1.0f + 0.044715f * x * x)); }
__device__ __forceinline__ f32x4 gelu4(const f32x4 x) {
    const f32x4 t = x * (x * x * (-0.10294324f) + (-2.30220821f));
    f32x4 e; e[0] = __builtin_amdgcn_exp2f(t[0]); e[1] = __builtin_amdgcn_exp2f(t[1]); e[2] = __builtin_amdgcn_exp2f(t[2]); e[3] = __builtin_amdgcn_exp2f(t[3]);
    e = e + 1.0f;
    f32x4 r; r[0] = __builtin_amdgcn_rcpf(e[0]); r[1] = __builtin_amdgcn_rcpf(e[1]); r[2] = __builtin_amdgcn_rcpf(e[2]); r[3] = __builtin_amdgcn_rcpf(e[3]);
    return x * r;
}
__device__ __forceinline__ unsigned gate4_u8_t(const f32x4 t) {
    f32x4 e; e[0] = __builtin_amdgcn_exp2f(t[0]); e[1] = __builtin_amdgcn_exp2f(t[1]); e[2] = __builtin_amdgcn_exp2f(t[2]); e[3] = __builtin_amdgcn_exp2f(t[3]);
    e = e + 0.0039177277f;
    unsigned w = __builtin_amdgcn_cvt_pk_u8_f32(__builtin_amdgcn_rcpf(e[0]), 0, 0u);
    w = __builtin_amdgcn_cvt_pk_u8_f32(__builtin_amdgcn_rcpf(e[1]), 1, w);
    w = __builtin_amdgcn_cvt_pk_u8_f32(__builtin_amdgcn_rcpf(e[2]), 2, w);
    w = __builtin_amdgcn_cvt_pk_u8_f32(__builtin_amdgcn_rcpf(e[3]), 3, w);
    return w;
}
template <int CTRL> __device__ __forceinline__ float dpp_f(float v) { return __int_as_float(__builtin_amdgcn_update_dpp(0, __float_as_int(v), CTRL, 0xF, 0xF, false)); }
__device__ __forceinline__ float row16_sum(float v) { v += dpp_f<0xB1>(v); v += dpp_f<0x4E>(v); v += dpp_f<0x141>(v); v += dpp_f<0x140>(v); return v; }
__device__ __forceinline__ float wave_sum(float v) {
    v = row16_sum(v);
    const float a = __int_as_float(__builtin_amdgcn_readlane(__float_as_int(v), 0)), b = __int_as_float(__builtin_amdgcn_readlane(__float_as_int(v), 16)),
                c = __int_as_float(__builtin_amdgcn_readlane(__float_as_int(v), 32)), d = __int_as_float(__builtin_amdgcn_readlane(__float_as_int(v), 48));
    return (a + b) + (c + d);
}
__device__ __forceinline__ u32x4 pack8(const f32x4 a, const f32x4 b) { u32x4 w; w.x = cvt_pk_bf16(a[0], a[1]); w.y = cvt_pk_bf16(a[2], a[3]); w.z = cvt_pk_bf16(b[0], b[1]); w.w = cvt_pk_bf16(b[2], b[3]); return w; }
__device__ __forceinline__ void unpack8(const u32x4 w, f32x4& a, f32x4& b) { a = (f32x4){bf_lo(w.x), bf_hi(w.x), bf_lo(w.y), bf_hi(w.y)}; b = (f32x4){bf_lo(w.z), bf_hi(w.z), bf_lo(w.w), bf_hi(w.w)}; }

#define XB_TMO      128
#define XB_XCNT(j)  (256  + 64 * (j))
#define XB_XSUB(j)  (1280 + 64 * (j))
#define XB_XGEN(j)  (2304 + 64 * (j))
#define XB_TOP      3328
#define XB_TOPGEN   3392
#define XCD_BAR_WORDS 3456
#define XB_SPIN_CAP (1u << 18)
__device__ __forceinline__ unsigned xb_ld(unsigned* p)              { return __hip_atomic_load(p, __ATOMIC_RELAXED, __HIP_MEMORY_SCOPE_AGENT); }
__device__ __forceinline__ unsigned xb_add(unsigned* p, unsigned v) { return __hip_atomic_fetch_add(p, v, __ATOMIC_RELAXED, __HIP_MEMORY_SCOPE_AGENT); }
__device__ __forceinline__ unsigned xb_xcc_id() { return (unsigned)__builtin_amdgcn_s_getreg((3 << 11) | 20) & 0xFu; }
#define XB_SPIN(cond, bar) do { unsigned _sp = 0; while (cond) { __builtin_amdgcn_s_sleep(1); \
    if ((++_sp & 255u) == 0u) { if (xb_ld(&(bar)[XB_TMO])) break; if (_sp > XB_SPIN_CAP) { atomicAdd(&(bar)[XB_TMO], 1u); break; } } } } while (0)
struct XcdBarrier { unsigned* bar; unsigned x; volatile LAS unsigned* st; };
__device__ __forceinline__ XcdBarrier xcd_barrier_post(unsigned* bar, volatile LAS unsigned* st) {
    XcdBarrier b; b.bar = bar; b.x = xb_xcc_id(); b.st = st;
    if (threadIdx.x == 0) (void)xb_add(&bar[XB_XCNT(b.x)], 1u);
    return b;
}
__device__ __forceinline__ void xcd_barrier_complete(unsigned* bar, unsigned x, unsigned& nloc, unsigned& nx) {
    const unsigned G = gridDim.x * gridDim.y * gridDim.z;
    unsigned sum, cnt, mine, sp = 0u;
    for (;;) {
        sum = 0u; cnt = 0u; mine = 0u;
#pragma unroll
        for (unsigned j = 0; j < 16; ++j) { const unsigned c = xb_ld(&bar[XB_XCNT(j)]); sum += c; cnt += (c > 0u) ? 1u : 0u; mine = (j == x) ? c : mine; }
        if (sum == G) break;
        __builtin_amdgcn_s_sleep(1);
        if ((++sp & 255u) == 0u) { if (xb_ld(&bar[XB_TMO])) break; if (sp > XB_SPIN_CAP) { atomicAdd(&bar[XB_TMO], 1u); break; } }
    }
    nloc = mine > 0u ? mine : 1u; nx = cnt > 0u ? cnt : 1u;
}
__device__ __forceinline__ void xcd_barrier(const XcdBarrier& b) {
    asm volatile("s_waitcnt vmcnt(0)" ::: "memory");
    __syncthreads();
    if (threadIdx.x == 0) {
        unsigned* bar = b.bar;
        __builtin_amdgcn_s_waitcnt(0);
        unsigned nloc = b.st[0], nx = b.st[1];
        if (nloc == 0u) { xcd_barrier_complete(bar, b.x, nloc, nx); b.st[0] = nloc; b.st[1] = nx; }
        const unsigned old = xb_add(&bar[XB_XSUB(b.x)], 1u);
        const unsigned gen = old / nloc;
        if (old + 1u == (gen + 1u) * nloc) {
            __builtin_amdgcn_fence(__ATOMIC_RELEASE, "agent");
            asm volatile("s_waitcnt vmcnt(0)" ::: "memory");
            const unsigned og = xb_add(&bar[XB_TOP], 1u);
            const unsigned tg = og / nx;
            if (og + 1u == (tg + 1u) * nx) xb_add(&bar[XB_TOPGEN], 1u);
            else XB_SPIN(xb_ld(&bar[XB_TOPGEN]) == tg, bar);
            __builtin_amdgcn_fence(__ATOMIC_ACQUIRE, "agent");
            xb_add(&bar[XB_XGEN(b.x)], 1u);
            asm volatile("s_waitcnt vmcnt(0)" ::: "memory");
        } else {
            XB_SPIN(xb_ld(&bar[XB_XGEN(b.x)]) == gen, bar);
            __builtin_amdgcn_fence(__ATOMIC_ACQUIRE, "agent");
            asm volatile("s_waitcnt vmcnt(0)" ::: "memory");
        }
    }
    __syncthreads();
}

namespace gs {
constexpr int BM = 256, BK = 64, HALF = 128, HTB = HALF * BK * 2, STAGE_BYTES = 8 * HTB;
__device__ __forceinline__ int lds_byte(int r, int c) { const int st = (r >> 4) * 2 + (c >> 5), rr = r & 15, cc = c & 31, ob = rr * 64 + cc * 2; return st * 1024 + (ob ^ (((ob >> 9) & 1) << 5)); }
__device__ __forceinline__ void stage_rc(int b, int& R, int& C) { const int st = b / 1024, sb = b % 1024, swz = sb ^ (((sb >> 9) & 1) << 5); R = (st >> 1) * 16 + swz / 64; C = (st & 1) * 32 + (swz % 64) / 2; }
__device__ __forceinline__ int perm32(int rho) { const int n = rho >> 4, i = rho & 15; return 8 * (i >> 2) + 4 * n + (i & 3); }
__device__ __forceinline__ int xcd_remap(int L, int nwg) { const int q = nwg >> 3, r = nwg & 7, xcd = L & 7, off = L >> 3; return (xcd < r ? xcd * (q + 1) : r * (q + 1) + (xcd - r) * q) + off; }
__device__ __forceinline__ void tile_order(int wgid, int nM, int nN, int& pm, int& pn) { const int nig = 8 * nN, gid = wgid / nig, fm = gid * 8, gsz = (nM - fm) < 8 ? (nM - fm) : 8; pm = fm + ((wgid % nig) % gsz); pn = (wgid % nig) / gsz; }

struct Unit { int pm, pn, kind, aux; };
struct Ops { const char* A; const char* B; unsigned lda, ldb; int nt; const int* rows; };

template <class Epi, class Sched, bool GATHER>
__device__ __forceinline__ void gemm_stream(LAS unsigned char* lds, const int tid, const Sched& S, const Epi& E) {
    const int wid = __builtin_amdgcn_readfirstlane(tid >> 6), lane = tid & 63, wr = wid >> 2, wc = wid & 3, fr = lane & 15, fq = lane >> 4;
    const unsigned ldsw = (unsigned)wid * 1024u;
    const int aoff = lds_byte(wr * 64 + fr, fq * 8), boff = lds_byte(wc * 32 + fr, fq * 8);
    Unit cur, nxt; int ui = 0;
    if (!S.next(0, cur)) return;
    unsigned vA0[2], vA1[2], vB[2];
    const char* cA; const char* cB; size_t hA, hB; int nt;
#define GS_SETOFF(u) do { Ops _o; S.ops((u), _o); cA = _o.A; cB = _o.B; nt = _o.nt; hB = (size_t)HALF * _o.ldb; hA = GATHER ? (size_t)0 : (size_t)HALF * _o.lda; \
        _Pragma("unroll") for (int _i = 0; _i < 2; ++_i) { int _R, _C; stage_rc(tid * 16 + _i * 8192, _R, _C); const int _Rb = (_R & ~31) + perm32(_R & 31); \
        if constexpr (GATHER) { vA0[_i] = (unsigned)_o.rows[_R] * _o.lda + (unsigned)_C * 2u; vA1[_i] = (unsigned)_o.rows[HALF + _R] * _o.lda + (unsigned)_C * 2u; } \
        else { vA0[_i] = (unsigned)_R * _o.lda + (unsigned)_C * 2u; vA1[_i] = 0u; } \
        vB[_i] = (unsigned)_Rb * _o.ldb + (unsigned)_C * 2u; } } while (0)
#define GS_SA(b, h) (((b) * 2 + (h)) * HTB)
#define GS_SB(b, h) ((4 + (b) * 2 + (h)) * HTB)
#define GS_STAGE(bufoff, gbase, voff) do { _Pragma("unroll") for (int _i = 0; _i < 2; ++_i) \
        __builtin_amdgcn_global_load_lds((const unsigned*)((const char*)(gbase) + (voff)[_i]), (LAS unsigned*)(lds + (bufoff) + ldsw + _i * 8192), 16, 0, 0); } while (0)
#define GS_STAGE_A1(bufoff, gbase) do { if constexpr (GATHER) { GS_STAGE(bufoff, gbase, vA1); } else { GS_STAGE(bufoff, (gbase) + hA, vA0); } } while (0)
#define GS_LDA(dst, b, h) do { _Pragma("unroll") for (int m = 0; m < 4; ++m) _Pragma("unroll") for (int k = 0; k < 2; ++k) dst[m][k] = *(const LAS bf16x8*)(lds + GS_SA(b, h) + aoff + m * 2048 + k * 1024); } while (0)
#define GS_LDB(dst, b, h) do { _Pragma("unroll") for (int n = 0; n < 2; ++n) _Pragma("unroll") for (int k = 0; k < 2; ++k) dst[n][k] = *(const LAS bf16x8*)(lds + GS_SB(b, h) + boff + n * 2048 + k * 1024); } while (0)
#define GS_MMA(ai, bj, At, Bt) do { __builtin_amdgcn_s_setprio(1); _Pragma("unroll") for (int m = 0; m < 4; ++m) _Pragma("unroll") for (int n = 0; n < 2; ++n) _Pragma("unroll") for (int k = 0; k < 2; ++k) { \
        if constexpr (Epi::I8) acc[ai][bj][m][n] = __builtin_bit_cast(f32x4, __builtin_amdgcn_mfma_i32_16x16x64_i8(__builtin_bit_cast(i32x4, Bt[n][k]), __builtin_bit_cast(i32x4, At[m][k]), __builtin_bit_cast(i32x4, acc[ai][bj][m][n]), 0, 0, 0)); \
        else acc[ai][bj][m][n] = __builtin_amdgcn_mfma_f32_16x16x32_bf16(Bt[n][k], At[m][k], acc[ai][bj][m][n], 0, 0, 0); } __builtin_amdgcn_s_setprio(0); } while (0)
#define GS_WAIT_V(n) asm volatile("s_waitcnt vmcnt(" #n ")" ::: "memory")
#define GS_WAIT_L(n) asm volatile("s_waitcnt lgkmcnt(" #n ")" ::: "memory")
#define GS_BAR __builtin_amdgcn_s_barrier()
#define GS_SCHED __builtin_amdgcn_sched_barrier(0)
    f32x4 acc[2][2][4][2];
#pragma unroll
    for (int a = 0; a < 2; ++a)
#pragma unroll
        for (int b = 0; b < 2; ++b)
#pragma unroll
            for (int m = 0; m < 4; ++m)
#pragma unroll
                for (int n = 0; n < 2; ++n) acc[a][b][m][n] = (f32x4){0.f, 0.f, 0.f, 0.f};
    bf16x8 At[4][2], B0[2][2], B1[2][2];
    GS_SETOFF(cur);
    const size_t kstep = (size_t)(BK * 2);
    GS_STAGE(GS_SB(0, 0), cB, vB); GS_STAGE(GS_SB(0, 1), cB + hB, vB); GS_STAGE(GS_SA(0, 0), cA, vA0); GS_STAGE_A1(GS_SA(0, 1), cA);
    if (wr == 1) GS_BAR;
    GS_WAIT_V(2); GS_BAR;
    GS_STAGE(GS_SB(1, 0), cB + kstep, vB); GS_STAGE(GS_SA(1, 0), cA + kstep, vA0); GS_STAGE(GS_SB(1, 1), cB + hB + kstep, vB);
    GS_WAIT_V(6); GS_BAR;
    for (;;) {
        const bool has_next = S.next(ui + 1, nxt);
        const int ntc = nt;
        for (int t = 0; t < ntc; t += 2) {
            const bool last = (t == ntc - 2);
            GS_LDB(B0, 0, 0); GS_LDB(B1, 0, 1); GS_SCHED; GS_LDA(At, 0, 0); GS_STAGE_A1(GS_SA(1, 1), cA + (size_t)(t + 1) * kstep);
            const char* a2; const char* b2;
            if (last) { if (has_next) { GS_SETOFF(nxt); } a2 = cA; b2 = cB; }
            else { a2 = cA + (size_t)(t + 2) * kstep; b2 = cB + (size_t)(t + 2) * kstep; }
            const char* a3 = a2 + kstep; const char* b3 = b2 + kstep;
            GS_WAIT_V(8); GS_WAIT_L(0); GS_BAR; GS_MMA(0, 0, At, B0); GS_MMA(0, 1, At, B1); GS_BAR; GS_SCHED;
            GS_LDA(At, 0, 1); GS_STAGE(GS_SB(0, 0), b2, vB); GS_STAGE(GS_SB(0, 1), b2 + hB, vB); GS_STAGE(GS_SA(0, 0), a2, vA0);
            GS_WAIT_V(8); GS_WAIT_L(0); GS_BAR; GS_MMA(1, 0, At, B0); GS_MMA(1, 1, At, B1); GS_BAR; GS_SCHED;
            GS_LDB(B0, 1, 0); GS_LDB(B1, 1, 1); GS_SCHED; GS_LDA(At, 1, 0); GS_STAGE_A1(GS_SA(0, 1), a2);
            GS_WAIT_V(8); GS_WAIT_L(0); GS_BAR; GS_MMA(0, 0, At, B0); GS_MMA(0, 1, At, B1); GS_BAR; GS_SCHED;
            GS_LDA(At, 1, 1); GS_STAGE(GS_SB(1, 0), b3, vB); GS_STAGE(GS_SB(1, 1), b3 + hB, vB); GS_STAGE(GS_SA(1, 0), a3, vA0);
            GS_WAIT_V(8); GS_WAIT_L(0); GS_BAR; GS_MMA(1, 0, At, B0); GS_MMA(1, 1, At, B1); GS_BAR; GS_SCHED;
        }
        if (wr == 0) GS_BAR;
        bool keep = false;
        if constexpr (Epi::KEEPS) keep = E.scale(acc, cur, wr, wc, fr, fq);
        else E(acc, cur, wr, wc, fr, fq);
        if (!has_next) break;
        if (!keep) {
#pragma unroll
        for (int a = 0; a < 2; ++a)
#pragma unroll
            for (int b = 0; b < 2; ++b)
#pragma unroll
                for (int m = 0; m < 4; ++m)
#pragma unroll
                    for (int n = 0; n < 2; ++n) acc[a][b][m][n] = (f32x4){0.f, 0.f, 0.f, 0.f};
        }
        cur = nxt; ++ui;
        if (wr == 1) GS_BAR;
    }
    GS_WAIT_V(0);
    GS_BAR;
#undef GS_SETOFF
#undef GS_SA
#undef GS_SB
#undef GS_STAGE
#undef GS_STAGE_A1
#undef GS_LDA
#undef GS_LDB
#undef GS_MMA
#undef GS_WAIT_V
#undef GS_WAIT_L
#undef GS_BAR
#undef GS_SCHED
}
}

struct Params {
    const float* in[31];
    float* out;
    unsigned char* ws;
    long long ph_lo, ph_hi;
};
enum { I_X = 0, I_C, I_CTX, I_CCTX, I_WMOD, I_BMOD, I_N1G, I_N2G, I_WIN, I_SGUNG, I_SGUW, I_SGUB, I_CONVW, I_LAMRE, I_LAMIM, I_LOGDT, I_BRE, I_BIM, I_CRE, I_CIM, I_S5D,
       I_GLUW, I_GLUB, I_WBR, I_WOUT, I_RW, I_RB, I_EWG, I_EWU, I_EWD, I_FNG };

struct Frame {
    LAS unsigned char* lds;
    int tid, lane, wave, blk;
};

__device__ __forceinline__ float wave_max(float v) {
    v = fmaxf(v, dpp_f<0xB1>(v)); v = fmaxf(v, dpp_f<0x4E>(v)); v = fmaxf(v, dpp_f<0x141>(v)); v = fmaxf(v, dpp_f<0x140>(v));
    const float a = __int_as_float(__builtin_amdgcn_readlane(__float_as_int(v), 0)), b = __int_as_float(__builtin_amdgcn_readlane(__float_as_int(v), 16)),
                c = __int_as_float(__builtin_amdgcn_readlane(__float_as_int(v), 32)), d = __int_as_float(__builtin_amdgcn_readlane(__float_as_int(v), 48));
    return fmaxf(fmaxf(a, b), fmaxf(c, d));
}
__device__ __forceinline__ unsigned q8x4(const f32x4 v, const float inv) {
    const unsigned a = __float_as_uint(__builtin_fmaf(v[0], inv, 12582912.0f)), b = __float_as_uint(__builtin_fmaf(v[1], inv, 12582912.0f));
    const unsigned c = __float_as_uint(__builtin_fmaf(v[2], inv, 12582912.0f)), d = __float_as_uint(__builtin_fmaf(v[3], inv, 12582912.0f));
    return __builtin_amdgcn_perm(__builtin_amdgcn_perm(d, c, 0x0c0c0400u), __builtin_amdgcn_perm(b, a, 0x0c0c0400u), 0x05040100u);
}
__device__ __forceinline__ void tr_item(const float* src, int ld_src, int k0, int c0, bf16_t* dst, int ld_dst, int r0, LAS float* scr, int lane) {
    f32x4 t[8];
#pragma unroll
    for (int i = 0; i < 8; ++i) t[i] = *(const f32x4*)(src + (size_t)(k0 + 8 * i + (lane >> 3)) * ld_src + c0 + 4 * (lane & 7));
#pragma unroll
    for (int i = 0; i < 8; ++i) { LAS float* d = scr + (8 * i + (lane >> 3)) * 33 + 4 * (lane & 7); d[0] = t[i][0]; d[1] = t[i][1]; d[2] = t[i][2]; d[3] = t[i][3]; }
    asm volatile("s_waitcnt lgkmcnt(0)" ::: "memory");
    const int c = lane & 7;
    float sv[4][8];
#pragma unroll
    for (int j = 0; j < 4; ++j) { const LAS float* s = scr + (8 * c) * 33 + (lane >> 3) + 8 * j;
#pragma unroll
        for (int i = 0; i < 8; ++i) sv[j][i] = s[i * 33]; }
#pragma unroll
    for (int j = 0; j < 4; ++j) { const int n = (lane >> 3) + 8 * j;
        u32x4 o; o.x = cvt_pk_bf16(sv[j][0], sv[j][1]); o.y = cvt_pk_bf16(sv[j][2], sv[j][3]); o.z = cvt_pk_bf16(sv[j][4], sv[j][5]); o.w = cvt_pk_bf16(sv[j][6], sv[j][7]);
        *(u32x4*)(dst + (size_t)(r0 + n) * ld_dst + k0 + 8 * c) = o; }
    asm volatile("s_waitcnt lgkmcnt(0)" ::: "memory");
}
__device__ __forceinline__ void tr_item_i8(const float* src, int ld_src, int k0, int c0, signed char* dst, int ld_dst, int r0, const unsigned* cmax_c0, float* scale_out, LAS float* scr, int lane) {
    f32x4 t[8];
#pragma unroll
    for (int i = 0; i < 8; ++i) t[i] = *(const f32x4*)(src + (size_t)(k0 + 8 * i + (lane >> 3)) * ld_src + c0 + 4 * (lane & 7));
#pragma unroll
    for (int i = 0; i < 8; ++i) { LAS float* d = scr + (8 * i + (lane >> 3)) * 33 + 4 * (lane & 7); d[0] = t[i][0]; d[1] = t[i][1]; d[2] = t[i][2]; d[3] = t[i][3]; }
    asm volatile("s_waitcnt lgkmcnt(0)" ::: "memory");
    const int n = lane & 31, hf = lane >> 5;
    const float cm = fmaxf(__uint_as_float(cmax_c0[n]), 1e-30f), inv = 127.0f / cm;
    if (scale_out && hf == 0) scale_out[n] = cm * (1.0f / 127.0f);
    u32x4 o[2];
#pragma unroll
    for (int h = 0; h < 2; ++h) {
        unsigned w[4];
#pragma unroll
        for (int x = 0; x < 4; ++x) { const LAS float* sp = scr + (32 * hf + 16 * h + 4 * x) * 33 + n; w[x] = q8x4((f32x4){sp[0], sp[33], sp[66], sp[99]}, inv); }
        o[h] = (u32x4){w[0], w[1], w[2], w[3]}; }
    *(u32x4*)(dst + (size_t)(r0 + n) * ld_dst + k0 + 32 * hf) = o[0]; *(u32x4*)(dst + (size_t)(r0 + n) * ld_dst + k0 + 32 * hf + 16) = o[1];
    asm volatile("s_waitcnt lgkmcnt(0)" ::: "memory");
}
__device__ __forceinline__ void colmax_win(const Params& p, const Frame& F) {
    unsigned* cmax = (unsigned*)(p.ws + OFF_CMAXW);
    for (int it = F.blk * NWAVE + F.wave; it < 768; it += NBLK * NWAVE) {
        const int l = it / 384, rem = it % 384, kb = rem / 24, cb = rem % 24;
        const float* src = p.in[I_WIN] + ((size_t)l * 1024 + 64 * kb) * 6144 + cb * 256 + 4 * F.lane;
        f32x4 m = (f32x4){0.f, 0.f, 0.f, 0.f};
#pragma unroll 16
        for (int i = 0; i < 64; ++i) { const f32x4 v = *(const f32x4*)(src + (size_t)i * 6144); m[0] = fmaxf(m[0], fabsf(v[0])); m[1] = fmaxf(m[1], fabsf(v[1])); m[2] = fmaxf(m[2], fabsf(v[2])); m[3] = fmaxf(m[3], fabsf(v[3])); }
        unsigned* dst = cmax + l * 6144 + cb * 256 + 4 * F.lane;
        atomicMax(dst + 0, __float_as_uint(m[0])); atomicMax(dst + 1, __float_as_uint(m[1])); atomicMax(dst + 2, __float_as_uint(m[2])); atomicMax(dst + 3, __float_as_uint(m[3]));
    }
}
__device__ __forceinline__ int win_col(int n) {
    if (n < 1536 || n >= 2560) return n;
    const int j = (n - 1536) >> 8, q = (n - 1536) & 255;
    return (q < 128) ? (1536 + 128 * j + q) : (2048 + 128 * j + (q - 128));
}
__device__ __forceinline__ void convert_mix(const Params& p, const Frame& F, int l, int part, int wslot, int nwslots) {
    LAS float* scr = (LAS float*)(F.lds + F.wave * 16384);
    bf16_t* WinT = (bf16_t*)(p.ws + OFF_WIN); bf16_t* WbrT = (bf16_t*)(p.ws + OFF_WBR); bf16_t* WoutT = (bf16_t*)(p.ws + OFF_WOUT); bf16_t* GluT = (bf16_t*)(p.ws + OFF_GLU);
    const int nit = part == 0 ? 3200 : (part == 1 ? 1280 : 4480);
    for (int it0 = wslot; it0 < nit; it0 += nwslots) {
        int r = part == 0 ? (it0 < 3072 ? it0 : it0 + 1280) : (part == 1 ? it0 + 3072 : it0);
        if (r < 3072) { const int kb = r / 192, nb = r % 192, oc = win_col(32 * nb);
            tr_item_i8(p.in[I_WIN] + (size_t)l * 1024 * 6144, 6144, 64 * kb, oc, (signed char*)WinT, 1024, 32 * nb, (const unsigned*)(p.ws + OFF_CMAXW) + l * 6144 + oc, kb == 0 ? (float*)(p.ws + OFF_SWIN) + l * 6144 + 32 * nb : nullptr, scr, F.lane); continue; }
        r -= 3072;
        if (r < 768) { const int br = r / 256, rem = r % 256, kb = rem / 32, nb = rem % 32; tr_item(p.in[I_WBR] + ((size_t)l * 3 + br) * 512 * 1024, 1024, 64 * kb, 32 * nb, WbrT + (size_t)br * 1024 * 512, 512, 32 * nb, scr, F.lane); continue; }
        r -= 768;
        if (r < 512) { const int kb = r / 32, nb = r % 32; tr_item(p.in[I_WOUT] + (size_t)l * 1024 * 1024, 1024, 64 * kb, 32 * nb, WoutT, 1024, 32 * nb, scr, F.lane); continue; }
        r -= 512;
        { const int kb = r / 16, nb = r % 16; tr_item(p.in[I_GLUW] + (size_t)l * 512 * 512, 512, 64 * kb, 32 * nb, GluT, 512, 32 * nb, scr, F.lane); }
    }
}
__device__ __forceinline__ void convert_experts(const Params& p, const Frame& F, int l, int slot, int nslots, int parts) {
    LAS float* scr = (LAS float*)(F.lds + 65536 + F.wave * 8448);
    LAS unsigned* cmx = (LAS unsigned*)(F.lds + 65536 + 8 * 8448);
    signed char* Wgu = (signed char*)(p.ws + OFF_WGU); bf16_t* Wd = (bf16_t*)(p.ws + OFF_WD); float* swgu = (float*)(p.ws + OFF_SWGU);
    const int lane = F.lane;
    if (parts & 1)
    for (int st = slot; st < 512; st += nslots) {
        const int e = st >> 5, nb = st & 31, n0 = 32 * nb, t = n0 >> 8, qq = n0 & 255, c0 = 128 * t + (qq & 127);
        const float* src = (qq < 128 ? p.in[I_EWG] : p.in[I_EWU]) + ((size_t)l * 16 + e) * 1024 * 512;
        __syncthreads();
        if (F.tid < 32) cmx[F.tid] = 0u;
        __syncthreads();
        f32x4 t0[8], t1[8];
#pragma unroll
        for (int i = 0; i < 8; ++i) { t0[i] = *(const f32x4*)(src + (size_t)(128 * F.wave + 8 * i + (lane >> 3)) * 512 + c0 + 4 * (lane & 7)); t1[i] = *(const f32x4*)(src + (size_t)(128 * F.wave + 64 + 8 * i + (lane >> 3)) * 512 + c0 + 4 * (lane & 7)); }
        f32x4 m = (f32x4){0.f, 0.f, 0.f, 0.f};
#pragma unroll
        for (int i = 0; i < 8; ++i) {
#pragma unroll
            for (int j = 0; j < 4; ++j) m[j] = fmaxf(m[j], fmaxf(fabsf(t0[i][j]), fabsf(t1[i][j]))); }
#pragma unroll
        for (int j = 0; j < 4; ++j) __hip_atomic_fetch_max(cmx + 4 * (lane & 7) + j, __float_as_uint(m[j]), __ATOMIC_RELAXED, __HIP_MEMORY_SCOPE_WORKGROUP);
        __syncthreads();
        const int n = lane & 31, hf = lane >> 5;
        const float cm = fmaxf(__uint_as_float(cmx[n]), 1e-30f), inv = 127.0f / cm;
        if (F.wave == 0 && hf == 0) swgu[e * 1024 + n0 + n] = cm * (1.0f / 127.0f);
#pragma unroll
        for (int tt = 0; tt < 2; ++tt) {
#pragma unroll
            for (int i = 0; i < 8; ++i) { LAS float* d = scr + (8 * i + (lane >> 3)) * 33 + 4 * (lane & 7); const f32x4 v = tt == 0 ? t0[i] : t1[i]; d[0] = v[0]; d[1] = v[1]; d[2] = v[2]; d[3] = v[3]; }
            asm volatile("s_waitcnt lgkmcnt(0)" ::: "memory");
            u32x4 o[2];
#pragma unroll
            for (int h = 0; h < 2; ++h) { unsigned w[4];
#pragma unroll
                for (int x = 0; x < 4; ++x) { const LAS float* sp = scr + (32 * hf + 16 * h + 4 * x) * 33 + n; w[x] = q8x4((f32x4){sp[0], sp[33], sp[66], sp[99]}, inv); }
                o[h] = (u32x4){w[0], w[1], w[2], w[3]}; }
            signed char* dp = Wgu + ((size_t)e * 1024 + n0 + n) * 1024 + 128 * F.wave + 64 * tt + 32 * hf;
            *(u32x4*)dp = o[0]; *(u32x4*)(dp + 16) = o[1];
            asm volatile("s_waitcnt lgkmcnt(0)" ::: "memory");
        }
    }
    if (parts & 2)
    for (int it = slot * NWAVE + F.wave; it < 4096; it += nslots * NWAVE) {
        const int e = it / 256, rem = it % 256, kb = rem / 32, nb = rem % 32;
        tr_item(p.in[I_EWD] + ((size_t)l * 16 + e) * 512 * 1024, 1024, 64 * kb, 32 * nb, Wd + (size_t)e * 1024 * 512, 512, 32 * nb, scr, F.lane);
    }
}

__device__ __forceinline__ void mod_items(const Params& p, const Frame& F) {
    LAS float* sc = (LAS float*)F.lds;
    LAS float* red = (LAS float*)(F.lds + 17 * 1024 * 4);
    float* mod = (float*)(p.ws + OFF_MOD);
    bool staged = false;
    __syncthreads();
    for (int it = F.blk; it < 384; it += NBLK) {
        if (!staged) {
            f32x4 tv[9];
#pragma unroll
            for (int x = 0; x < 8; ++x) tv[x] = *(const f32x4*)(p.in[I_C] + (F.tid + x * NTHR) * 4);
            tv[8] = *(const f32x4*)(p.in[I_CCTX] + (F.tid & 255) * 4);
#pragma unroll
            for (int x = 0; x < 9; ++x) { const int i = (x < 8 ? F.tid + x * NTHR : 4096 + (F.tid & 255)) * 4;
                if (x < 8 || F.tid < 256) *(LAS f32x4*)(sc + i) = (f32x4){siluf_(tv[x][0]), siluf_(tv[x][1]), siluf_(tv[x][2]), siluf_(tv[x][3])}; }
            staged = true;
        }
        __syncthreads();
        const int l = it / 192, n0 = (it % 192) * 32, ks = F.tid >> 5, cn = F.tid & 31;
        const float* w = p.in[I_WMOD] + (size_t)l * 1024 * 6144 + n0 + cn;
        float a[17];
#pragma unroll
        for (int mi = 0; mi < 17; ++mi) a[mi] = 0.f;
        for (int k0 = ks * 64; k0 < ks * 64 + 64; k0 += 16) { float wv[16];
#pragma unroll
            for (int x = 0; x < 16; ++x) wv[x] = w[(size_t)(k0 + x) * 6144];
#pragma unroll
            for (int x = 0; x < 16; ++x) {
#pragma unroll
                for (int mi = 0; mi < 17; ++mi) a[mi] += sc[mi * 1024 + k0 + x] * wv[x]; } }
#pragma unroll
        for (int mi = 0; mi < 17; ++mi) red[(ks * 17 + mi) * 32 + cn] = a[mi];
        __syncthreads();
        for (int i = F.tid; i < 17 * 32; i += NTHR) { const int mi = i >> 5, c2 = i & 31; float s = 0.f;
#pragma unroll
            for (int q = 0; q < 16; ++q) s += red[(q * 17 + mi) * 32 + c2];
            mod[((size_t)l * 17 + mi) * 6144 + n0 + c2] = s + p.in[I_BMOD][l * 6144 + n0 + c2]; }
    }
    __syncthreads();
}

__device__ __forceinline__ void s5_build_job(const Params& p, const Frame& F, int l, int job) {
    const int g = job >> 2, q = job & 3, tid = F.tid;
    LAS f32x2* ap = (LAS f32x2*)F.lds;
    LAS f32x2* bb = (LAS f32x2*)(F.lds + 34816);
    LAS f32x2* cc = (LAS f32x2*)(F.lds + 34816 + 16384);
    LAS f32x2* fz = (LAS f32x2*)(F.lds + 34816 + 32768);
    LAS float* kt = (LAS float*)(F.lds + 69632);
    LAS float* dvs = (LAS float*)(F.lds + 34816 + 32768 + 1024);
    __syncthreads();
    {
        const int pp = tid & 63, d = tid >> 8, tq = (tid >> 6) & 3, gi = (l * 2 + d) * 32 + g;
        const float ldt = p.in[I_LOGDT][gi], lr = p.in[I_LAMRE][gi * 64 + pp], li = p.in[I_LAMIM][gi * 64 + pp];
        if (tid < 16) dvs[tid] = p.in[I_S5D][l * 512 + g * 16 + tid];
        const float dt = expf(ldt), t0 = 8.0f * (float)tq;
        float sn, cs; const float m1 = expf(lr * dt); sincosf(li * dt, &sn, &cs); const float a1r = m1 * cs, a1i = m1 * sn;
        const float m0 = expf(lr * dt * t0); sincosf(li * dt * t0, &sn, &cs); float cr = m0 * cs, ci = m0 * sn;
        if (tq == 0) ap[(d * 33) * 64 + pp] = (f32x2){1.0f, 0.0f};
#pragma unroll
        for (int s_ = 1; s_ <= 8; ++s_) { const float nr = cr * a1r - ci * a1i, ni = cr * a1i + ci * a1r; cr = nr; ci = ni; ap[(d * 33 + 8 * tq + s_) * 64 + pp] = (f32x2){cr, ci}; }
    }
    if (tid < 128) {
        const int d = tid >> 6, pp = tid & 63, gi = (l * 2 + d) * 32 + g;
        const float dt = expf(p.in[I_LOGDT][gi]), lr = p.in[I_LAMRE][gi * 64 + pp], li = p.in[I_LAMIM][gi * 64 + pp];
        const float mag = expf(lr * dt); float sn, cs; sincosf(li * dt, &sn, &cs);
        const float abr = mag * cs, abi = mag * sn, den = lr * lr + li * li, nr = abr - 1.0f;
        fz[tid] = (f32x2){(nr * lr + abi * li) / den, (abi * lr - nr * li) / den};
    }
    __syncthreads();
    if (q == 0 && tid < 128) { const int d = tid >> 6, pp = tid & 63; const f32x2 a = ap[(d * 33 + 32) * 64 + pp]; float* aq = (float*)(p.ws + OFF_AQ) + ((((size_t)l * 2 + d) * 32 + g) * 64 + pp) * 2; aq[0] = a.x; aq[1] = a.y; }
#pragma unroll
    for (int it = 0; it < 4; ++it) { const int i = tid + it * NTHR;
        { const int d = i >> 10, pp = (i >> 4) & 63, h = i & 15; const size_t gi = ((((size_t)l * 2 + d) * 32 + g) * 64 + pp) * 16 + h;
          const float br = p.in[I_BRE][gi], bi = p.in[I_BIM][gi]; const f32x2 f = fz[d * 64 + pp]; bb[i] = (f32x2){f.x * br - f.y * bi, f.x * bi + f.y * br}; }
        { const int d = i >> 10, h = (i >> 6) & 15, pp = i & 63; const size_t gi = ((((size_t)l * 2 + d) * 32 + g) * 16 + h) * 64 + pp; cc[i] = (f32x2){p.in[I_CRE][gi], p.in[I_CIM][gi]}; }
    }
    __syncthreads();
    {
        const int hh = F.lane & 15, kg = F.lane >> 4;
        u32x4 bfr[2][4];
#pragma unroll
        for (int d = 0; d < 2; ++d)
#pragma unroll
            for (int ks = 0; ks < 4; ++ks) { unsigned w[4]; f32x2 bq[4];
#pragma unroll
                for (int jp = 0; jp < 4; ++jp) bq[jp] = bb[(d * 64 + 16 * ks + 4 * kg + jp) * 16 + hh];
#pragma unroll
                for (int jp = 0; jp < 4; ++jp) w[jp] = cvt_pk_bf16(bq[jp].x, bq[jp].y);
                bfr[d][ks] = (u32x4){w[0], w[1], w[2], w[3]}; }
        for (int tile = F.wave; tile < 64; tile += NWAVE) {
            const int d = tile >> 5, tau = tile & 31;
            f32x4 o = (f32x4){0.f, 0.f, 0.f, 0.f};
#pragma unroll
            for (int ks = 0; ks < 4; ++ks) { unsigned w[4];
                f32x2 cq[4], aq[4];
#pragma unroll
                for (int jp = 0; jp < 4; ++jp) { const int pp = 16 * ks + 4 * kg + jp; cq[jp] = cc[(d * 16 + hh) * 64 + pp]; aq[jp] = ap[(d * 33 + tau) * 64 + pp]; }
#pragma unroll
                for (int jp = 0; jp < 4; ++jp) { const f32x2 c = cq[jp], av = aq[jp];
                    w[jp] = cvt_pk_bf16(c.x * av.x - c.y * av.y, -(c.x * av.y + c.y * av.x)); }
                const u32x4 af = (u32x4){w[0], w[1], w[2], w[3]};
                o = __builtin_amdgcn_mfma_f32_16x16x32_bf16(__builtin_bit_cast(bf16x8, af), __builtin_bit_cast(bf16x8, d == 0 ? bfr[0][ks] : bfr[1][ks]), o, 0, 0, 0); }
#pragma unroll
            for (int r = 0; r < 4; ++r) kt[((d * 32 + tau) * 16 + 4 * kg + r) * 16 + hh] = o[r];
        }
    }
    __syncthreads();
    {
        bf16_t* WE = (bf16_t*)(p.ws + OFF_WE) + (size_t)g * 256 * 512;
        const int d = q >> 1, c = q & 1;
        for (int pc = tid; pc < 64 * 64; pc += NTHR) {
            const int pp = pc >> 6, col0 = (pc & 63) * 8, j = col0 >> 4, h0 = col0 & 15;
            const f32x2 a = ap[(d * 33 + (d == 0 ? 31 - j : j)) * 64 + pp];
            float v[8];
#pragma unroll
            for (int x = 0; x < 8; ++x) { const f32x2 b = bb[(d * 64 + pp) * 16 + h0 + x]; v[x] = c == 0 ? (a.x * b.x - a.y * b.y) : (a.x * b.y + a.y * b.x); }
            u32x4 o; o.x = cvt_pk_bf16(v[0], v[1]); o.y = cvt_pk_bf16(v[2], v[3]); o.z = cvt_pk_bf16(v[4], v[5]); o.w = cvt_pk_bf16(v[6], v[7]);
            *(u32x4*)(WE + (size_t)(64 * q + pp) * 512 + col0) = o;
        }
    }
    {
        bf16_t* TW = (bf16_t*)(p.ws + OFF_TW) + (size_t)g * 512 * 768;
        for (int pc = tid; pc < 128 * 96; pc += NTHR) {
            const int rl = pc / 96, cp = pc % 96, rr = 128 * q + rl, i = rr >> 4, h = rr & 15, col0 = cp * 8;
            float v[8];
            if (col0 < 512) {
                const int j = col0 >> 4, h0 = col0 & 15;
#pragma unroll
                for (int x = 0; x < 8; ++x) {
                    const int hp = h0 + x; float val;
                    if (i > j) val = kt[((0 * 32 + (i - j)) * 16 + h) * 16 + hp];
                    else if (i < j) val = kt[((1 * 32 + (j - i)) * 16 + h) * 16 + hp];
                    else val = kt[((0 * 32 + 0) * 16 + h) * 16 + hp] + kt[((1 * 32 + 0) * 16 + h) * 16 + hp] + (h == hp ? dvs[h] : 0.f);
                    v[x] = val;
                }
            } else {
                const int n0 = col0 - 512, d = n0 >> 7, c = (n0 >> 6) & 1, p0 = n0 & 63, tau = d == 0 ? i + 1 : 32 - i;
#pragma unroll
                for (int x = 0; x < 8; ++x) { const f32x2 cv = cc[(d * 16 + h) * 64 + p0 + x], a = ap[(d * 33 + tau) * 64 + p0 + x];
                    v[x] = c == 0 ? (cv.x * a.x - cv.y * a.y) : -(cv.x * a.y + cv.y * a.x); }
            }
            u32x4 o; o.x = cvt_pk_bf16(v[0], v[1]); o.y = cvt_pk_bf16(v[2], v[3]); o.z = cvt_pk_bf16(v[4], v[5]); o.w = cvt_pk_bf16(v[6], v[7]);
            *(u32x4*)(TW + (size_t)rr * 768 + col0) = o;
        }
    }
    __syncthreads();
}

__device__ __forceinline__ bf16_t* hrow_ptr(const Params& p, int r) { return (bf16_t*)(p.ws + OFF_HB) + (size_t)r * D; }
__device__ __forceinline__ f32x4 bf4(const u32x2 w) { return (f32x4){bf_lo(w.x), bf_hi(w.x), bf_lo(w.y), bf_hi(w.y)}; }
__device__ __forceinline__ int mod_index(int r) { return r < TLAT ? (r >> 11) : 16; }

__device__ __forceinline__ void phase_norm1(const Params& p, const Frame& F, int l, bool dry = false) {
    const float* mod = (const float*)(p.ws + OFF_MOD);
    signed char* Xq = (signed char*)(p.ws + (dry ? 422 * MiB : OFF_XN)); float* sxa = (float*)(p.ws + (dry ? 460 * MiB : OFF_SXA));
    const bf16_t* Y = (const bf16_t*)(p.ws + OFF_Y);
    const int* pos = (const int*)(p.ws + OFF_POS);
    const int lane = F.lane, row0 = F.blk * 144 + F.wave * 18;
    int mypos = 0; if (l == 1 && lane < 36) mypos = pos[2 * row0 + lane];
    f32x4 ch[4], mg[4], ms[4], m2[4]; u32x2 ca[4], cb[4]; int cmi = -1;
#define N1_LOAD(rr, H, A, B) do { const int r_ = (rr); \
        if (l == 0) { const float* src_ = (r_ < TLAT) ? (p.in[I_X] + (size_t)r_ * D) : (p.in[I_CTX] + (size_t)(r_ - TLAT) * D); \
            _Pragma("unroll") for (int j = 0; j < 4; ++j) { H[j] = *(const f32x4*)(src_ + 4 * lane + 256 * j); A[j] = (u32x2){0u, 0u}; B[j] = (u32x2){0u, 0u}; } } \
        else { const bf16_t* hp_ = hrow_ptr(p, r_); const int q_ = 2 * (r_ - row0); \
            const bf16_t* y0_ = Y + (size_t)__builtin_amdgcn_readlane(mypos, q_) * D; const bf16_t* y1_ = Y + (size_t)__builtin_amdgcn_readlane(mypos, q_ + 1) * D; \
            _Pragma("unroll") for (int jj = 0; jj < 2; ++jj) { const int k_ = 8 * lane + 512 * jj; const u32x4 h_ = *(const u32x4*)(hp_ + k_), a_ = *(const u32x4*)(y0_ + k_), b_ = *(const u32x4*)(y1_ + k_); \
                H[2 * jj] = bf4((u32x2){h_.x, h_.y}); H[2 * jj + 1] = bf4((u32x2){h_.z, h_.w}); A[2 * jj] = (u32x2){a_.x, a_.y}; A[2 * jj + 1] = (u32x2){a_.z, a_.w}; B[2 * jj] = (u32x2){b_.x, b_.y}; B[2 * jj + 1] = (u32x2){b_.z, b_.w}; } } } while (0)
#define N1_K(j) (l == 0 ? 4 * lane + 256 * (j) : 8 * lane + 512 * ((j) >> 1) + 4 * ((j) & 1))
    N1_LOAD(row0, ch, ca, cb);
    for (int i = 0; i < 18; ++i) {
        const int r = row0 + i, mi = mod_index(r);
        f32x4 nh[4]; u32x2 na[4], nb[4];
        if (i + 1 < 18) N1_LOAD(r + 1, nh, na, nb);
        f32x4 v[4];
        if (mi != cmi) { cmi = mi; const float* gn = p.in[I_N1G] + l * D; const float* sh = mod + ((size_t)l * 17 + mi) * 6144; const float* sc = sh + 1024;
            const float* g2 = mod + ((size_t)(l > 0 ? l - 1 : 0) * 17 + mi) * 6144 + 5120;
#pragma unroll
            for (int j = 0; j < 4; ++j) { const int k = N1_K(j); mg[j] = *(const f32x4*)(gn + k) * (1.0f + *(const f32x4*)(sc + k)); ms[j] = *(const f32x4*)(sh + k); m2[j] = *(const f32x4*)(g2 + k); } }
        if (l == 0) {
#pragma unroll
            for (int j = 0; j < 4; ++j) v[j] = ch[j];
        } else {
            bf16_t* hp = dry ? (bf16_t*)(p.ws + 350 * MiB) + (size_t)r * D : hrow_ptr(p, r);
#pragma unroll
            for (int j = 0; j < 4; ++j) {
                const f32x4 gg = m2[j]; const u32x2 a = ca[j], b = cb[j];
                const f32x4 sm = (f32x4){bf_lo(a.x) + bf_lo(b.x), bf_hi(a.x) + bf_hi(b.x), bf_lo(a.y) + bf_lo(b.y), bf_hi(a.y) + bf_hi(b.y)};
                v[j] = ch[j] + gg * sm;
            }
#pragma unroll
            for (int jj = 0; jj < 2; ++jj) *(u32x4*)(hp + 8 * lane + 512 * jj) = pack8(v[2 * jj], v[2 * jj + 1]);
        }
        float ss = 0.f;
#pragma unroll
        for (int j = 0; j < 4; ++j) ss += (v[j][0] * v[j][0] + v[j][1] * v[j][1]) + (v[j][2] * v[j][2] + v[j][3] * v[j][3]);
        const float rs = __builtin_amdgcn_rsqf(wave_sum(ss) * (1.0f / D) + EPS);
        float am = 0.f;
#pragma unroll
        for (int j = 0; j < 4; ++j) { v[j] = v[j] * rs * mg[j] + ms[j]; am = fmaxf(am, fmaxf(fmaxf(fabsf(v[j][0]), fabsf(v[j][1])), fmaxf(fabsf(v[j][2]), fabsf(v[j][3])))); }
        am = fmaxf(wave_max(am), 1e-30f);
        const float inv = 127.0f * __builtin_amdgcn_rcpf(am);
#pragma unroll
        for (int jj = 0; jj < 2; ++jj) { const unsigned q0 = q8x4(v[2 * jj], inv), q1 = q8x4(v[2 * jj + 1], inv);
            if (l == 0) { *(unsigned*)(Xq + (size_t)r * D + 4 * lane + 512 * jj) = q0; *(unsigned*)(Xq + (size_t)r * D + 4 * lane + 512 * jj + 256) = q1; }
            else *(u32x2*)(Xq + (size_t)r * D + 8 * lane + 512 * jj) = (u32x2){q0, q1}; }
        if (lane == 0) sxa[r] = am * (1.0f / 127.0f);
#pragma unroll
        for (int j = 0; j < 4; ++j) { ch[j] = nh[j]; ca[j] = na[j]; cb[j] = nb[j]; }
    }
#undef N1_LOAD
#undef N1_K
}

__device__ __forceinline__ void phase_final(const Params& p, const Frame& F) {
    const float* mod = (const float*)(p.ws + OFF_MOD);
    const bf16_t* Y = (const bf16_t*)(p.ws + OFF_Y);
    const int* pos = (const int*)(p.ws + OFF_POS);
    const int lane = F.lane, row0 = F.blk * 128 + F.wave * 16;
    int mypos = 0; if (lane < 32) mypos = pos[2 * row0 + lane];
    f32x4 ch[4], m2[4], fg[4]; u32x2 ca[4], cb[4]; int cmi = -1;
#pragma unroll
    for (int j = 0; j < 4; ++j) fg[j] = *(const f32x4*)(p.in[I_FNG] + 4 * lane + 256 * j);
#define FN_LOAD(rr, H, A, B) do { const int r_ = (rr); const bf16_t* hp_ = hrow_ptr(p, r_); const int q_ = 2 * (r_ - row0); \
        const bf16_t* y0_ = Y + (size_t)__builtin_amdgcn_readlane(mypos, q_) * D; const bf16_t* y1_ = Y + (size_t)__builtin_amdgcn_readlane(mypos, q_ + 1) * D; \
        _Pragma("unroll") for (int j = 0; j < 4; ++j) { const int k_ = 4 * lane + 256 * j; H[j] = bf4(*(const u32x2*)(hp_ + k_)); A[j] = *(const u32x2*)(y0_ + k_); B[j] = *(const u32x2*)(y1_ + k_); } } while (0)
    FN_LOAD(row0, ch, ca, cb);
    for (int i = 0; i < 16; ++i) {
        const int r = row0 + i, mi = r >> 11;
        f32x4 nh[4]; u32x2 na[4], nb[4];
        if (i + 1 < 16) FN_LOAD(r + 1, nh, na, nb);
        float* hp = p.out + (size_t)r * D;
        if (mi != cmi) { cmi = mi; const float* g2 = mod + ((size_t)1 * 17 + mi) * 6144 + 5120;
#pragma unroll
            for (int j = 0; j < 4; ++j) m2[j] = *(const f32x4*)(g2 + 4 * lane + 256 * j); }
        f32x4 v[4]; float ss = 0.f;
#pragma unroll
        for (int j = 0; j < 4; ++j) {
            const int k = 4 * lane + 256 * j; const f32x4 gg = m2[j]; const u32x2 a = ca[j], b = cb[j];
            const f32x4 sm = (f32x4){bf_lo(a.x) + bf_lo(b.x), bf_hi(a.x) + bf_hi(b.x), bf_lo(a.y) + bf_lo(b.y), bf_hi(a.y) + bf_hi(b.y)};
            v[j] = ch[j] + gg * sm;
            ss += (v[j][0] * v[j][0] + v[j][1] * v[j][1]) + (v[j][2] * v[j][2] + v[j][3] * v[j][3]);
        }
        const float rs = __builtin_amdgcn_rsqf(wave_sum(ss) * (1.0f / D) + EPS);
#pragma unroll
        for (int j = 0; j < 4; ++j) { const int k = 4 * lane + 256 * j; *(f32x4*)(hp + k) = v[j] * rs * fg[j]; }
#pragma unroll
        for (int j = 0; j < 4; ++j) { ch[j] = nh[j]; ca[j] = na[j]; cb[j] = nb[j]; }
    }
#undef FN_LOAD
}

#define EPI_FENCE() asm volatile("" ::: "memory")
#define OPAQUE_S(x) asm volatile("" : "+s"(x))
struct SchedB {
    const char* Xn; const char* W; int l, c;
    __device__ __forceinline__ bool next(int i, gs::Unit& u) const {
        const int L = i * NBLK + c, nmain = (l == 0 ? 144 : 128) * 24, ntot = nmain + (l == 0 ? 0 : 32);
        if (L >= ntot) return false;
        int pm, pn;
        if (L < nmain) { gs::tile_order(gs::xcd_remap(L, nmain), l == 0 ? 144 : 128, 24, pm, pn); }
        else { const int x = L - nmain; pm = 128 + (x >> 1); pn = 10 + (x & 1); }
        u.pm = pm; u.pn = pn; u.kind = 0; u.aux = 0;
        return true;
    }
    __device__ __forceinline__ void ops(const gs::Unit& u, gs::Ops& o) const { o.A = Xn + (size_t)u.pm * 256 * 1024; o.B = W + (size_t)u.pn * 256 * 1024; o.lda = 1024; o.ldb = 1024; o.nt = 8; o.rows = nullptr; }
};
struct EpiB {
    static constexpr bool KEEPS = false, I8 = true;
    bf16_t *U, *V, *Bb, *P, *Ux; unsigned char* G8; const float* sxa; const float* swin;
    __device__ __forceinline__ void operator()(const f32x4 (&acc)[2][2][4][2], const gs::Unit& u, int wr, int wc, int fr, int fq) const {
        const int pn = u.pn, r0 = u.pm * 256 + wr * 64 + fr, c0 = wc * 32 + 8 * fq;
        f32x4 sw[2][2]; float sx[2][4];
#pragma unroll
        for (int bj = 0; bj < 2; ++bj) { sw[bj][0] = *(const f32x4*)(swin + pn * 256 + bj * 128 + c0); sw[bj][1] = *(const f32x4*)(swin + pn * 256 + bj * 128 + c0 + 4); }
#pragma unroll
        for (int ai = 0; ai < 2; ++ai)
#pragma unroll
            for (int m = 0; m < 4; ++m) sx[ai][m] = sxa[r0 + ai * 128 + m * 16];
#define DQ(ai, bj, m, n) (__builtin_convertvector(__builtin_bit_cast(i32x4, acc[ai][bj][m][n]), f32x4) * (sw[bj][n] * sx[ai][m]))
        if (pn < 6) {
            size_t z1 = 0, z2 = 0, z3 = 0; OPAQUE_S(z1); OPAQUE_S(z2); OPAQUE_S(z3); bf16_t *u_ = U + z1, *v_ = V + z2, *b_ = Bb + z3;
            bf16_t* O = pn < 2 ? u_ : (pn < 4 ? v_ : b_); const bool act = pn < 4; const int cb = (pn & 1) * 256 + c0;
#pragma unroll
            for (int ai = 0; ai < 2; ++ai)
#pragma unroll
                for (int m = 0; m < 4; ++m) { bf16_t* rowp = O + (size_t)(r0 + ai * 128 + m * 16) * 512 + cb;
#pragma unroll
                    for (int bj = 0; bj < 2; ++bj) { f32x4 v0 = DQ(ai, bj, m, 0), v1 = DQ(ai, bj, m, 1);
                        if (act) { v0 = gelu4(v0); v1 = gelu4(v1); }
                        *(u32x4*)(rowp + bj * 128) = pack8(v0, v1); }
                    EPI_FENCE(); }
        } else if (pn < 10) {
            const int cb = (pn - 6) * 128 + c0;
#pragma unroll
            for (int ai = 0; ai < 2; ++ai)
#pragma unroll
                for (int m = 0; m < 4; ++m) {
                    *(u32x4*)(P + (size_t)(r0 + ai * 128 + m * 16) * 512 + cb) = pack8(DQ(ai, 0, m, 0) * DQ(ai, 1, m, 0), DQ(ai, 0, m, 1) * DQ(ai, 1, m, 1));
                    EPI_FENCE(); }
        } else if (pn >= 12) {
            const int cb = (pn - 12) * 256 + wc * 64 + fq * 16;
#pragma unroll
            for (int ai = 0; ai < 2; ++ai)
#pragma unroll
                for (int m = 0; m < 4; ++m) { unsigned char* rowp = G8 + (size_t)(r0 + ai * 128 + m * 16) * 3072 + cb; unsigned wq[2][2];
#pragma unroll
                    for (int bj = 0; bj < 2; ++bj)
#pragma unroll
                        for (int n = 0; n < 2; ++n) wq[bj][n] = gate4_u8_t(__builtin_convertvector(__builtin_bit_cast(i32x4, acc[ai][bj][m][n]), f32x4) * (sw[bj][n] * (sx[ai][m] * -1.44269504089f)) + (-8.0f));
                    *(u32x4*)rowp = (u32x4){wq[0][0], wq[0][1], wq[1][0], wq[1][1]};
                    EPI_FENCE(); }
        } else {
#pragma unroll
            for (int ai = 0; ai < 2; ++ai)
#pragma unroll
                for (int m = 0; m < 4; ++m) { const int r = r0 + ai * 128 + m * 16, ch = r >> 5, ii = r & 31;
#pragma unroll
                    for (int bj = 0; bj < 2; ++bj) { const int cch = (pn - 10) * 256 + bj * 128 + c0, g = cch >> 4, h0 = cch & 15;
                        *(u32x4*)(Ux + ((size_t)g * NCHP + ch) * 768 + ii * 16 + h0) = pack8(DQ(ai, bj, m, 0), DQ(ai, bj, m, 1)); }
                    EPI_FENCE(); }
        }
#undef DQ
    }
};
struct SchedE {
    const char* Ux; const char* WE; int c;
    __device__ __forceinline__ bool next(int i, gs::Unit& u) const {
        const int L = i * NBLK + c; if (L >= 160) return false;
        u.pm = L % 5; u.pn = 0; u.kind = 0; u.aux = L / 5;
        return true;
    }
    __device__ __forceinline__ void ops(const gs::Unit& u, gs::Ops& o) const { o.A = Ux + ((size_t)u.aux * NCHP + u.pm * 256) * 1536; o.B = WE + (size_t)u.aux * 256 * 1024; o.lda = 1536; o.ldb = 1024; o.nt = 8; o.rows = nullptr; }
};
struct EpiE {
    static constexpr bool KEEPS = false, I8 = false;
    float* E;
    __device__ __forceinline__ void operator()(const f32x4 (&acc)[2][2][4][2], const gs::Unit& u, int wr, int wc, int fr, int fq) const {
        const int g = u.aux, m0 = u.pm * 256 + wr * 64 + fr, c0 = wc * 32 + 8 * fq;
#pragma unroll
        for (int ai = 0; ai < 2; ++ai)
#pragma unroll
            for (int m = 0; m < 4; ++m) { const int mm = m0 + ai * 128 + m * 16;
                if (mm < NCH) { float* rowp = E + ((size_t)g * NCH + mm) * 256 + c0;
#pragma unroll
                    for (int bj = 0; bj < 2; ++bj) { *(f32x4*)(rowp + bj * 128) = acc[ai][bj][m][0]; *(f32x4*)(rowp + bj * 128 + 4) = acc[ai][bj][m][1]; } }
                EPI_FENCE(); }
    }
};
struct SchedY {
    const char* Ux; const char* TW; int l, c;
    __device__ __forceinline__ bool next(int i, gs::Unit& u) const {
        const int npm = l == 0 ? 5 : 4, ntot = 32 * npm * 2, L = i * NBLK + c; if (L >= ntot) return false;
        const int g = L / (npm * 2), rem = L % (npm * 2);
        u.pm = rem >> 1; u.pn = rem & 1; u.kind = 0; u.aux = g;
        return true;
    }
    __device__ __forceinline__ void ops(const gs::Unit& u, gs::Ops& o) const { o.A = Ux + ((size_t)u.aux * NCHP + u.pm * 256) * 1536; o.B = TW + ((size_t)u.aux * 512 + u.pn * 256) * 1536; o.lda = 1536; o.ldb = 1536; o.nt = 12; o.rows = nullptr; }
};
struct EpiY {
    static constexpr bool KEEPS = false, I8 = false;
    bf16_t* Z;
    __device__ __forceinline__ void operator()(const f32x4 (&acc)[2][2][4][2], const gs::Unit& u, int wr, int wc, int fr, int fq) const {
        const int g = u.aux, m0 = u.pm * 256 + wr * 64 + fr, c0 = u.pn * 256 + wc * 32 + 8 * fq;
#pragma unroll
        for (int ai = 0; ai < 2; ++ai)
#pragma unroll
            for (int m = 0; m < 4; ++m) { const int mm = m0 + ai * 128 + m * 16;
                if (mm < NCH) {
#pragma unroll
                    for (int bj = 0; bj < 2; ++bj) { const int cn = c0 + bj * 128, ii = cn >> 4, h0 = cn & 15; const f32x4 v0 = gelu4(acc[ai][bj][m][0]), v1 = gelu4(acc[ai][bj][m][1]);
                        *(u32x4*)(Z + ((size_t)mm * 32 + ii) * 512 + g * 16 + h0) = pack8(v0, v1); } }
                EPI_FENCE(); }
    }
};
struct SchedF {
    const char* Z; const char* W; int l, c;
    __device__ __forceinline__ bool next(int i, gs::Unit& u) const {
        const int nM = l == 0 ? 144 : 128, ntot = nM * 2, L = i * NBLK + c; if (L >= ntot) return false;
        int pm, pn; gs::tile_order(gs::xcd_remap(L, ntot), nM, 2, pm, pn);
        u.pm = pm; u.pn = pn; u.kind = 0; u.aux = 0;
        return true;
    }
    __device__ __forceinline__ void ops(const gs::Unit& u, gs::Ops& o) const { o.A = Z + (size_t)u.pm * 256 * 1024; o.B = W + (size_t)u.pn * 256 * 1024; o.lda = 1024; o.ldb = 1024; o.nt = 8; o.rows = nullptr; }
};
struct EpiF {
    static constexpr bool KEEPS = false, I8 = false;
    const bf16_t* Z; bf16_t* Yc; const float* gb;
    __device__ __forceinline__ void operator()(const f32x4 (&acc)[2][2][4][2], const gs::Unit& u, int wr, int wc, int fr, int fq) const {
        const int r0 = u.pm * 256 + wr * 64 + fr, c0 = u.pn * 256 + wc * 32 + 8 * fq;
        f32x4 gbv[2][2];
#pragma unroll
        for (int bj = 0; bj < 2; ++bj) { gbv[bj][0] = *(const f32x4*)(gb + c0 + bj * 128); gbv[bj][1] = *(const f32x4*)(gb + c0 + bj * 128 + 4); }
#pragma unroll
        for (int ai = 0; ai < 2; ++ai)
#pragma unroll
            for (int mh = 0; mh < 2; ++mh) {
                u32x4 zw[4];
#pragma unroll
                for (int x = 0; x < 4; ++x) zw[x] = *(const u32x4*)(Z + (size_t)(r0 + ai * 128 + (mh * 2 + (x >> 1)) * 16) * 512 + c0 + (x & 1) * 128);
#pragma unroll
                for (int x = 0; x < 4; ++x) { const int m = mh * 2 + (x >> 1), bj = x & 1; const size_t ro = (size_t)(r0 + ai * 128 + m * 16) * 512 + c0;
                    f32x4 z0, z1; unpack8(zw[x], z0, z1);
                    f32x4 v0 = acc[ai][bj][m][0] + gbv[bj][0], v1 = acc[ai][bj][m][1] + gbv[bj][1];
#pragma unroll
                    for (int j = 0; j < 4; ++j) { v0[j] = z0[j] * sigmoidf_(v0[j]); v1[j] = z1[j] * sigmoidf_(v1[j]); }
                    *(u32x4*)(Yc + ro + bj * 128) = pack8(v0, v1); }
                EPI_FENCE(); }
    }
};
struct SchedG {
    const char* Y0; const char* Y1; const char* Y2; const char* Wbr; int l, c;
    __device__ __forceinline__ bool next(int i, gs::Unit& u) const {
        const int nM = l == 0 ? 144 : 128, ntile = nM * 4, tl = i / 3, s = i % 3, L = tl * NBLK + c; if (L >= ntile) return false;
        int pm, pn; gs::tile_order(gs::xcd_remap(L, ntile), nM, 4, pm, pn);
        u.pm = pm; u.pn = pn; u.kind = s; u.aux = 0;
        return true;
    }
    __device__ __forceinline__ void ops(const gs::Unit& u, gs::Ops& o) const {
        const int br = u.kind;
        size_t z1 = 0, z2 = 0, z3 = 0; OPAQUE_S(z1); OPAQUE_S(z2); OPAQUE_S(z3); const char *y0_ = Y0 + z1, *y1_ = Y1 + z2, *y2_ = Y2 + z3; const char* y = br == 0 ? y0_ : (br == 1 ? y1_ : y2_);
        o.A = y + (size_t)u.pm * 256 * 1024; o.B = Wbr + ((size_t)br * 1024 + u.pn * 256) * 1024; o.lda = 1024; o.ldb = 1024; o.nt = 8; o.rows = nullptr;
    }
};
__device__ __forceinline__ void u8x8_to_f32(const u32x2 w, f32x4& a, f32x4& b) {
    a = (f32x4){(float)(w.x & 255u), (float)((w.x >> 8) & 255u), (float)((w.x >> 16) & 255u), (float)(w.x >> 24)};
    b = (f32x4){(float)(w.y & 255u), (float)((w.y >> 8) & 255u), (float)((w.y >> 16) & 255u), (float)(w.y >> 24)};
    a = a + 0.5f; b = b + 0.5f;
}
struct EpiG {
    static constexpr bool KEEPS = true, I8 = false;
    const unsigned char* G8; bf16_t* merged;
    __device__ __forceinline__ bool scale(f32x4 (&acc)[2][2][4][2], const gs::Unit& u, int wr, int wc, int fr, int fq) const {
        const int s = u.kind, r0 = u.pm * 256 + wr * 64 + fr, c0 = u.pn * 256 + wc * 32 + 8 * fq;
        const unsigned char* gp = G8 + (size_t)r0 * 3072 + s * 1024 + u.pn * 256 + wc * 64 + fq * 16;
#pragma unroll
        for (int ai = 0; ai < 2; ++ai) {
            u32x4 ga4[4], gb4[4];
#pragma unroll
            for (int m = 0; m < 4; ++m) { const size_t o = (size_t)(ai * 128 + m * 16) * 3072; ga4[m] = *(const u32x4*)(gp + o); if (s < 2) gb4[m] = *(const u32x4*)(gp + o + 1024); }
#pragma unroll
            for (int x = 0; x < 8; ++x) { const int m = x >> 1, bj = x & 1;
                const u32x2 gax = bj == 0 ? (u32x2){ga4[m].x, ga4[m].y} : (u32x2){ga4[m].z, ga4[m].w};
                f32x4 n0, n1; u8x8_to_f32(gax, n0, n1);
                if (s < 2) { const u32x2 gbx = bj == 0 ? (u32x2){gb4[m].x, gb4[m].y} : (u32x2){gb4[m].z, gb4[m].w}; f32x4 d0, d1; u8x8_to_f32(gbx, d0, d1);
#pragma unroll
                    for (int j = 0; j < 4; ++j) { n0[j] *= __builtin_amdgcn_rcpf(d0[j]); n1[j] *= __builtin_amdgcn_rcpf(d1[j]); } }
                if (s == 2) { n0 = n0 * (1.0f / 256.0f); n1 = n1 * (1.0f / 256.0f); }
                acc[ai][bj][m][0] *= n0; acc[ai][bj][m][1] *= n1;
                if (s == 2) *(u32x4*)(merged + (size_t)(r0 + ai * 128 + m * 16) * 1024 + c0 + bj * 128) = pack8(acc[ai][bj][m][0], acc[ai][bj][m][1]); }
            EPI_FENCE(); }
        return s < 2;
    }
};
struct SchedH {
    const char* A; const char* W; int l, c;
    __device__ __forceinline__ bool next(int i, gs::Unit& u) const {
        const int nM = l == 0 ? 144 : 128, ntot = nM * 4, L = i * NBLK + c; if (L >= ntot) return false;
        int pm, pn; gs::tile_order(gs::xcd_remap(L, ntot), nM, 4, pm, pn);
        u.pm = pm; u.pn = pn; u.kind = 0; u.aux = 0;
        return true;
    }
    __device__ __forceinline__ void ops(const gs::Unit& u, gs::Ops& o) const { o.A = A + (size_t)u.pm * 256 * 2048; o.B = W + (size_t)u.pn * 256 * 2048; o.lda = 2048; o.ldb = 2048; o.nt = 16; o.rows = nullptr; }
};
template <int LZ> struct EpiH {
    static constexpr bool KEEPS = false, I8 = false;
    const float* xin; const float* cin; bf16_t* Hb; const float* mod;
    __device__ __forceinline__ void operator()(const f32x4 (&acc)[2][2][4][2], const gs::Unit& u, int wr, int wc, int fr, int fq) const {
        const int rt = u.pm * 256, c0 = u.pn * 256 + wc * 32 + 8 * fq;
        const bool lat = rt < TLAT; const int mi = lat ? (rt >> 11) : 16;
        size_t z1 = 0, z2 = 0; OPAQUE_S(z1); OPAQUE_S(z2);
        const float* base = lat ? (xin + z1 + (size_t)rt * D) : (cin + z2 + (size_t)(rt - TLAT) * D);
        bf16_t* hb = Hb + (size_t)rt * D;
        const float* g1 = mod + (size_t)mi * 6144 + 2048 + c0;
        f32x4 g1v[2][2];
#pragma unroll
        for (int bj = 0; bj < 2; ++bj) { g1v[bj][0] = *(const f32x4*)(g1 + bj * 128); g1v[bj][1] = *(const f32x4*)(g1 + bj * 128 + 4); }
#pragma unroll
        for (int ai = 0; ai < 2; ++ai)
#pragma unroll
            for (int m = 0; m < 4; ++m) {
                f32x4 hv[2][2]; const size_t rb_ = (size_t)(wr * 64 + fr + ai * 128 + m * 16) * D + c0;
#pragma unroll
                for (int bj = 0; bj < 2; ++bj) { const size_t ro = rb_ + bj * 128;
                    if constexpr (LZ == 1) { hv[bj][0] = *(const f32x4*)(base + ro); hv[bj][1] = *(const f32x4*)(base + ro + 4); }
                    else unpack8(*(const u32x4*)(hb + ro), hv[bj][0], hv[bj][1]); }
#pragma unroll
                for (int bj = 0; bj < 2; ++bj) { const size_t ro = rb_ + bj * 128;
                    *(u32x4*)(hb + ro) = pack8(hv[bj][0] + g1v[bj][0] * acc[ai][bj][m][0], hv[bj][1] + g1v[bj][1] * acc[ai][bj][m][1]); }
                EPI_FENCE(); }
    }
};
struct SchedK {
    const char* Xn2; const char* Wgu; const int* rowl; const LAS int* toff; int c;
    __device__ __forceinline__ bool next(int i, gs::Unit& u) const {
        const int nt_ = __builtin_amdgcn_readfirstlane(toff[16]), ntot = nt_ * 4, L = i * NBLK + c; if (L >= ntot) return false;
        const int w = gs::xcd_remap(L, ntot), mt = w >> 2; int e = 0;
        { const int ln = (int)__builtin_amdgcn_mbcnt_hi(~0u, __builtin_amdgcn_mbcnt_lo(~0u, 0u)), tv = toff[ln < 16 ? ln : 16];
          e = __builtin_popcountll(__ballot(ln >= 1 && ln < 16 && tv <= mt)); }
        u.pm = mt; u.pn = w & 3; u.kind = 0; u.aux = e;
        return true;
    }
    __device__ __forceinline__ void ops(const gs::Unit& u, gs::Ops& o) const { o.A = Xn2; o.B = Wgu + ((size_t)u.aux * 1024 + u.pn * 256) * 1024; o.lda = 1024; o.ldb = 1024; o.nt = 8; o.rows = rowl + u.pm * 256; }
};
struct EpiK {
    static constexpr bool KEEPS = false, I8 = true;
    bf16_t* He; const float* sxs; const float* swgu;
    __device__ __forceinline__ void operator()(const f32x4 (&acc)[2][2][4][2], const gs::Unit& u, int wr, int wc, int fr, int fq) const {
        const int r0 = u.pm * 256 + wr * 64 + fr, c0 = u.pn * 128 + wc * 32 + 8 * fq, t0 = u.aux * 1024 + u.pn * 256 + wc * 32 + 8 * fq;
        f32x4 sw[2][2]; float sx[2][4];
#pragma unroll
        for (int bj = 0; bj < 2; ++bj) { sw[bj][0] = *(const f32x4*)(swgu + t0 + bj * 128); sw[bj][1] = *(const f32x4*)(swgu + t0 + bj * 128 + 4); }
#pragma unroll
        for (int ai = 0; ai < 2; ++ai)
#pragma unroll
            for (int m = 0; m < 4; ++m) sx[ai][m] = sxs[r0 + ai * 128 + m * 16];
#define DQ(ai, bj, m, n) (__builtin_convertvector(__builtin_bit_cast(i32x4, acc[ai][bj][m][n]), f32x4) * (sw[bj][n] * sx[ai][m]))
#pragma unroll
        for (int ai = 0; ai < 2; ++ai)
#pragma unroll
            for (int m = 0; m < 4; ++m) { f32x4 v0 = DQ(ai, 0, m, 0), v1 = DQ(ai, 0, m, 1); const f32x4 u0 = DQ(ai, 1, m, 0), u1 = DQ(ai, 1, m, 1);
#pragma unroll
                for (int j = 0; j < 4; ++j) { v0[j] = siluf_(v0[j]) * u0[j]; v1[j] = siluf_(v1[j]) * u1[j]; }
                *(u32x4*)(He + (size_t)(r0 + ai * 128 + m * 16) * 512 + c0) = pack8(v0, v1);
                EPI_FENCE(); }
#undef DQ
    }
};
struct SchedL {
    const char* He; const char* Wd; const LAS int* toff; int c;
    __device__ __forceinline__ bool next(int i, gs::Unit& u) const {
        const int nt_ = __builtin_amdgcn_readfirstlane(toff[16]), ntot = nt_ * 4, L = i * NBLK + c; if (L >= ntot) return false;
        const int w = gs::xcd_remap(L, ntot), mt = w >> 2; int e = 0;
        { const int ln = (int)__builtin_amdgcn_mbcnt_hi(~0u, __builtin_amdgcn_mbcnt_lo(~0u, 0u)), tv = toff[ln < 16 ? ln : 16];
          e = __builtin_popcountll(__ballot(ln >= 1 && ln < 16 && tv <= mt)); }
        u.pm = mt; u.pn = w & 3; u.kind = 0; u.aux = e;
        return true;
    }
    __device__ __forceinline__ void ops(const gs::Unit& u, gs::Ops& o) const { o.A = He + (size_t)u.pm * 256 * 1024; o.B = Wd + ((size_t)u.aux * 1024 + u.pn * 256) * 1024; o.lda = 1024; o.ldb = 1024; o.nt = 8; o.rows = nullptr; }
};
struct EpiL {
    static constexpr bool KEEPS = false, I8 = false;
    bf16_t* Y; const float* wl;
    __device__ __forceinline__ void operator()(const f32x4 (&acc)[2][2][4][2], const gs::Unit& u, int wr, int wc, int fr, int fq) const {
        const int r0 = u.pm * 256 + wr * 64 + fr, c0 = u.pn * 256 + wc * 32 + 8 * fq;
        float wv[2][4];
#pragma unroll
        for (int ai = 0; ai < 2; ++ai)
#pragma unroll
            for (int m = 0; m < 4; ++m) wv[ai][m] = wl[r0 + ai * 128 + m * 16];
#pragma unroll
        for (int ai = 0; ai < 2; ++ai)
#pragma unroll
            for (int m = 0; m < 4; ++m) { const int r = r0 + ai * 128 + m * 16; const float w = wv[ai][m];
#pragma unroll
                for (int bj = 0; bj < 2; ++bj) *(u32x4*)(Y + (size_t)r * 1024 + c0 + bj * 128) = pack8(acc[ai][bj][m][0] * w, acc[ai][bj][m][1] * w);
                EPI_FENCE(); }
    }
};

__device__ __forceinline__ void phase_sgu(const Params& p, const Frame& F, int l) {
    bf16_t* U = (bf16_t*)(p.ws + OFF_U); const bf16_t* V = (const bf16_t*)(p.ws + OFF_V);
    const bf16_t* W16 = (const bf16_t*)(p.ws + OFF_SGUW16) + (size_t)l * 4 * 128 * 128;
    LAS float* mu = (LAS float*)F.lds; LAS float* rsd = mu + 128;
    LAS unsigned char* Vn = F.lds + 1024;
    LAS unsigned char* Wl = F.lds + 1024 + 128 * 264;
    const int nchunk = l == 0 ? 288 : 256, tid = F.tid, lane = F.lane, wave = F.wave;
    const float* gam = p.in[I_SGUNG] + l * 512;
    const int vk = tid >> 2, vpart = tid & 3;
    for (int un = 0; un < 2; ++un) {
        int cu, hd0, hd1;
        if (un == 0) { cu = F.blk; hd0 = 0; hd1 = 4; if (cu >= nchunk) continue; }
        else { const int x = F.blk - 128; if (x < 0 || 256 + (x >> 2) >= nchunk) continue; cu = 256 + (x >> 2); hd0 = x & 3; hd1 = hd0 + 1; }
        const int r0 = cu * 128;
        __syncthreads();
        {
            u32x4 w16[16];
#pragma unroll
            for (int x = 0; x < 16; ++x) w16[x] = *(const u32x4*)(V + (size_t)(r0 + wave * 16 + x) * 512 + lane * 8);
#pragma unroll
            for (int x = 0; x < 16; ++x) { const int k = wave * 16 + x; f32x4 a, b; unpack8(w16[x], a, b);
                const float sm = wave_sum((a[0] + a[1]) + (a[2] + a[3]) + (b[0] + b[1]) + (b[2] + b[3])), mean = sm * (1.0f / 512.0f);
                a = a - mean; b = b - mean;
                const float q = wave_sum((a[0] * a[0] + a[1] * a[1]) + (a[2] * a[2] + a[3] * a[3]) + (b[0] * b[0] + b[1] * b[1]) + (b[2] * b[2] + b[3] * b[3]));
                if (lane == 0) { mu[k] = mean; rsd[k] = 1.0f / sqrtf(q * (1.0f / 512.0f) + EPS); } }
        }
        u32x4 pv[4], pw[4]; f32x4 pg[4][2];
#define SGU_PREFETCH(hd_) do { _Pragma("unroll") for (int x = 0; x < 4; ++x) { pv[x] = *(const u32x4*)(V + (size_t)(r0 + vk) * 512 + (hd_) * 128 + vpart * 32 + x * 8); \
            pw[x] = *(const u32x4*)(W16 + (size_t)(hd_) * 16384 + (tid + x * 512) * 8); \
            pg[x][0] = *(const f32x4*)(gam + (hd_) * 128 + vpart * 32 + x * 8); pg[x][1] = *(const f32x4*)(gam + (hd_) * 128 + vpart * 32 + x * 8 + 4); } } while (0)
        SGU_PREFETCH(hd0);
        for (int hd = hd0; hd < hd1; ++hd) {
            __syncthreads();
            { const float m_ = mu[vk], r_ = rsd[vk];
#pragma unroll
              for (int x = 0; x < 4; ++x) { const int c = vpart * 32 + x * 8;
                  f32x4 a, b; unpack8(pv[x], a, b); const f32x4 ga = pg[x][0], gb = pg[x][1];
                  a = (a - m_) * r_ * ga; b = (b - m_) * r_ * gb;
                  u32x2 o0, o1; o0.x = cvt_pk_bf16(a[0], a[1]); o0.y = cvt_pk_bf16(a[2], a[3]); o1.x = cvt_pk_bf16(b[0], b[1]); o1.y = cvt_pk_bf16(b[2], b[3]);
                  *(LAS u32x2*)(Vn + vk * 264 + c * 2) = o0; *(LAS u32x2*)(Vn + vk * 264 + c * 2 + 8) = o1;
                  const int e8 = (tid + x * 512) * 8, qq = e8 >> 7, kk = e8 & 127; *(LAS u32x4*)(Wl + qq * 272 + kk * 2) = pw[x]; } }
            if (hd + 1 < hd1) SGU_PREFETCH(hd + 1);
            const int kg = lane >> 4, cl = wave * 16 + (lane & 15);
            u32x2 uu[8];
#pragma unroll
            for (int qt = 0; qt < 8; ++qt) uu[qt] = *(const u32x2*)(U + (size_t)(r0 + qt * 16 + (lane & 15)) * 512 + hd * 128 + wave * 16 + 4 * kg);
            const float* bs = p.in[I_SGUB] + ((size_t)l * 4 + hd) * 128;
            float bqv[8];
#pragma unroll
            for (int qt = 0; qt < 8; ++qt) bqv[qt] = bs[qt * 16 + (lane & 15)];
            __syncthreads();
            f32x4 o[8];
#pragma unroll
            for (int qt = 0; qt < 8; ++qt) o[qt] = (f32x4){0.f, 0.f, 0.f, 0.f};
#pragma unroll
            for (int ks = 0; ks < 4; ++ks) {
                bf16x8 af, bfv[8];
#pragma unroll
                for (int j = 0; j < 8; ++j) af[j] = (short)*(const LAS bf16_t*)(Vn + (ks * 32 + kg * 8 + j) * 264 + cl * 2);
#pragma unroll
                for (int qt = 0; qt < 8; ++qt) bfv[qt] = *(const LAS bf16x8*)(Wl + (qt * 16 + (lane & 15)) * 272 + (ks * 32 + kg * 8) * 2);
                __builtin_amdgcn_sched_barrier(0);
#pragma unroll
                for (int qt = 0; qt < 8; ++qt) o[qt] = __builtin_amdgcn_mfma_f32_16x16x32_bf16(af, bfv[qt], o[qt], 0, 0, 0);
                __builtin_amdgcn_sched_barrier(0);
            }
#pragma unroll
            for (int qt = 0; qt < 8; ++qt) { const int qq = qt * 16 + (lane & 15); const float bq = bqv[qt]; const u32x2 uw = uu[qt];
                u32x2 ow; ow.x = cvt_pk_bf16(bf_lo(uw.x) * (o[qt][0] + bq), bf_hi(uw.x) * (o[qt][1] + bq)); ow.y = cvt_pk_bf16(bf_lo(uw.y) * (o[qt][2] + bq), bf_hi(uw.y) * (o[qt][3] + bq));
                *(u32x2*)(U + (size_t)(r0 + qq) * 512 + hd * 128 + wave * 16 + 4 * kg) = ow; }
        }
#undef SGU_PREFETCH
    }
    __syncthreads();
}
__device__ __forceinline__ void phase_conv(const Params& p, const Frame& F, int l) {
    bf16_t* Bb = (bf16_t*)(p.ws + OFF_BB); const bf16_t* P = (const bf16_t*)(p.ws + OFF_P);
    const float* cw = p.in[I_CONVW] + l * 3 * 512;
    const int nrows = l == 0 ? TALL : TLAT, npc = nrows * 64;
    const int c = (F.tid & 63) * 8;
    const f32x4 w0a = *(const f32x4*)(cw + c), w0b = *(const f32x4*)(cw + c + 4), w1a = *(const f32x4*)(cw + 512 + c), w1b = *(const f32x4*)(cw + 512 + c + 4), w2a = *(const f32x4*)(cw + 1024 + c), w2b = *(const f32x4*)(cw + 1024 + c + 4);
    const int nv = 352, vb0 = F.blk < 160 ? F.blk : 160 + 2 * (F.blk - 160), nvb = F.blk < 160 ? 1 : 2;
    for (int vb = vb0; vb < vb0 + nvb; ++vb)
    for (int it = vb * NTHR + F.tid; it < npc; it += 2 * nv * NTHR) {
        const int it2 = it + nv * NTHR; const bool two = it2 < npc;
        const int r = it >> 6, r2 = two ? (it2 >> 6) : r;
        const int s = r < TLAT ? (r & 63) : ((r - TLAT) & 255), smax = r < TLAT ? 63 : 255, s2 = r2 < TLAT ? (r2 & 63) : ((r2 - TLAT) & 255), smax2 = r2 < TLAT ? 63 : 255;
        const u32x4 zero = (u32x4){0u, 0u, 0u, 0u};
        const u32x4 xc = *(const u32x4*)(P + (size_t)r * 512 + c), xp = s > 0 ? *(const u32x4*)(P + (size_t)(r - 1) * 512 + c) : zero, xn = s < smax ? *(const u32x4*)(P + (size_t)(r + 1) * 512 + c) : zero, xb = *(const u32x4*)(Bb + (size_t)r * 512 + c);
        const u32x4 yc = *(const u32x4*)(P + (size_t)r2 * 512 + c), yp = s2 > 0 ? *(const u32x4*)(P + (size_t)(r2 - 1) * 512 + c) : zero, yn = s2 < smax2 ? *(const u32x4*)(P + (size_t)(r2 + 1) * 512 + c) : zero, yb = *(const u32x4*)(Bb + (size_t)r2 * 512 + c);
        { f32x4 x0, x1, pa, pb, na, nb, b0, b1; unpack8(xc, x0, x1); unpack8(xp, pa, pb); unpack8(xn, na, nb); unpack8(xb, b0, b1);
          *(u32x4*)(Bb + (size_t)r * 512 + c) = pack8(b0 * (w0a * pa + w1a * x0 + w2a * na), b1 * (w0b * pb + w1b * x1 + w2b * nb)); }
        if (two) { f32x4 x0, x1, pa, pb, na, nb, b0, b1; unpack8(yc, x0, x1); unpack8(yp, pa, pb); unpack8(yn, na, nb); unpack8(yb, b0, b1);
          *(u32x4*)(Bb + (size_t)r2 * 512 + c) = pack8(b0 * (w0a * pa + w1a * x0 + w2a * na), b1 * (w0b * pb + w1b * x1 + w2b * nb)); }
    }
}
__device__ __forceinline__ void phase_scan(const Params& p, const Frame& F, int l) {
    if (F.blk >= 128) return;
    const int T = F.blk * NTHR + F.tid, pp = T & 63, g = (T >> 6) & 31, b = (T >> 11) & 15, dir = T >> 15;
    const float* E = (const float*)(p.ws + OFF_E) + (size_t)g * NCH * 256 + dir * 128 + pp;
    bf16_t* Ux = (bf16_t*)(p.ws + OFF_UX) + (size_t)g * NCHP * 768 + 512 + dir * 128 + pp;
    const float* aq = (const float*)(p.ws + OFF_AQ) + ((((size_t)l * 2 + dir) * 32 + g) * 64 + pp) * 2;
    const float ar = aq[0], ai = aq[1];
    float sr = 0.f, si = 0.f;
#pragma unroll 8
    for (int st = 0; st < 72; ++st) {
        int m;
        if (dir == 0) m = st < 8 ? (1024 + b * 8 + st) : (b * 64 + (st - 8));
        else m = st < 8 ? (1024 + b * 8 + (7 - st)) : (b * 64 + (71 - st));
        const float er = E[(size_t)m * 256], ei = E[(size_t)m * 256 + 64];
        Ux[(size_t)m * 768] = (bf16_t)(cvt_pk_bf16(sr, 0.f) & 0xffffu); Ux[(size_t)m * 768 + 64] = (bf16_t)(cvt_pk_bf16(si, 0.f) & 0xffffu);
        const float nr = ar * sr - ai * si + er, ni = ar * si + ai * sr + ei; sr = nr; si = ni;
    }
}
__device__ __forceinline__ void phase_router(const Params& p, const Frame& F, int l) {
    const float* mod = (const float*)(p.ws + OFF_MOD);
    signed char* Xq2 = (signed char*)(p.ws + OFF_XN); float* sx2 = (float*)(p.ws + OFF_SX2);
    LAS float* rw = (LAS float*)F.lds;
    LAS int* lsel = (LAS int*)(F.lds + 133632);
    LAS int* lrk = lsel + 288;
    LAS float* lgs = (LAS float*)(lrk + 288);
    int* sel = (int*)(p.ws + OFF_SEL); float* wsel = (float*)(p.ws + OFF_WSEL); int* lrank = (int*)(p.ws + OFF_LRANK); int* cnt = (int*)(p.ws + OFF_CNT);
    const int NR = l == 0 ? 144 : 128, RW = NR / 8, lane = F.lane;
    __syncthreads();
    { f32x4 wt[8];
#pragma unroll
      for (int x = 0; x < 8; ++x) wt[x] = *(const f32x4*)(p.in[I_RW] + (F.tid + x * NTHR) * 4);
#pragma unroll
      for (int x = 0; x < 8; ++x) { const int i = (F.tid + x * NTHR) * 4, kk = i >> 4, e = i & 15;
          const int k = 4 * ((kk & 511) >> 3) + 256 * (2 * (kk >> 9) + ((kk >> 2) & 1)) + (kk & 3);
          rw[e * 1024 + k] = wt[x][0]; rw[(e + 1) * 1024 + k] = wt[x][1]; rw[(e + 2) * 1024 + k] = wt[x][2]; rw[(e + 3) * 1024 + k] = wt[x][3]; } }
    __syncthreads();
    float rb[16];
#pragma unroll
    for (int e = 0; e < 16; ++e) rb[e] = p.in[I_RB][e];
    const int row0 = F.blk * NR + F.wave * RW;
    f32x4 chA[4], chB[4], mg[4], ms[4]; int cmi = -1;
#define RT_K(j) (8 * lane + 512 * ((j) >> 1) + 4 * ((j) & 1))
#define RT_LOAD(rr, H) do { const bf16_t* hp_ = hrow_ptr(p, (rr)); _Pragma("unroll") for (int jj = 0; jj < 2; ++jj) { const u32x4 w_ = *(const u32x4*)(hp_ + 8 * lane + 512 * jj); \
            H[2 * jj] = bf4((u32x2){w_.x, w_.y}); H[2 * jj + 1] = bf4((u32x2){w_.z, w_.w}); } } while (0)
#define RT_NORM(rr, V) do { const int r_ = (rr), mi_ = mod_index(r_); float ss_ = 0.f; \
        _Pragma("unroll") for (int j = 0; j < 4; ++j) ss_ += (V[j][0] * V[j][0] + V[j][1] * V[j][1]) + (V[j][2] * V[j][2] + V[j][3] * V[j][3]); \
        const float rs_ = __builtin_amdgcn_rsqf(wave_sum(ss_) * (1.0f / D) + EPS); \
        if (mi_ != cmi) { cmi = mi_; const float* gn_ = p.in[I_N2G] + l * D; const float* sh_ = mod + ((size_t)l * 17 + mi_) * 6144 + 3072; const float* sc_ = sh_ + 1024; \
            _Pragma("unroll") for (int j = 0; j < 4; ++j) { const int k_ = RT_K(j); mg[j] = *(const f32x4*)(gn_ + k_) * (1.0f + *(const f32x4*)(sc_ + k_)); ms[j] = *(const f32x4*)(sh_ + k_); } } \
        float am_ = 0.f; \
        _Pragma("unroll") for (int j = 0; j < 4; ++j) { V[j] = V[j] * rs_ * mg[j] + ms[j]; am_ = fmaxf(am_, fmaxf(fmaxf(fabsf(V[j][0]), fabsf(V[j][1])), fmaxf(fabsf(V[j][2]), fabsf(V[j][3])))); } \
        am_ = fmaxf(wave_max(am_), 1e-30f); const float inv_ = 127.0f * __builtin_amdgcn_rcpf(am_); \
        _Pragma("unroll") for (int jj = 0; jj < 2; ++jj) *(u32x2*)(Xq2 + (size_t)r_ * D + 8 * lane + 512 * jj) = (u32x2){q8x4(V[2 * jj], inv_), q8x4(V[2 * jj + 1], inv_)}; \
        if (lane == 0) sx2[r_] = am_ * (1.0f / 127.0f); } while (0)
#define RT_REDUCE(SX, LX) do { float k8_[8], k4_[4], k2_[2]; \
        _Pragma("unroll") for (int q = 0; q < 8; ++q) { const float keep = b3 ? SX[q + 8] : SX[q], send = b3 ? SX[q] : SX[q + 8]; k8_[q] = keep + dpp_f<0x128>(send); } \
        _Pragma("unroll") for (int q = 0; q < 4; ++q) { const float keep = b2 ? k8_[q + 4] : k8_[q], send = b2 ? k8_[q] : k8_[q + 4]; k4_[q] = keep + dpp_f<0x141>(send); } \
        _Pragma("unroll") for (int q = 0; q < 2; ++q) { const float keep = b1 ? k4_[q + 2] : k4_[q], send = b1 ? k4_[q] : k4_[q + 2]; k2_[q] = keep + dpp_f<0x4E>(send); } \
        { const float keep = b0 ? k2_[1] : k2_[0], send = b0 ? k2_[0] : k2_[1]; LX = keep + dpp_f<0xB1>(send); } } while (0)
    const bool b3 = (lane & 8) != 0, b2 = (lane & 4) != 0, b1 = (lane & 2) != 0, b0 = (lane & 1) != 0;
    RT_LOAD(row0, chA); RT_LOAD(row0 + 1, chB);
    for (int i = 0; i < RW; i += 2) {
        const int lr_ = F.wave * RW + i, r = row0 + i;
        f32x4 nA[4], nB[4];
        if (i + 2 < RW) { RT_LOAD(r + 2, nA); RT_LOAD(r + 3, nB); }
        RT_NORM(r, chA); RT_NORM(r + 1, chB);
        float sxA[16], sxB[16]; f32x4 wq[2][4];
#pragma unroll
        for (int j = 0; j < 4; ++j) wq[0][j] = *(const LAS f32x4*)(rw + 4 * lane + 256 * j);
#pragma unroll
        for (int e = 0; e < 16; ++e) { f32x4 a4 = (f32x4){0.f, 0.f, 0.f, 0.f}, c4 = (f32x4){0.f, 0.f, 0.f, 0.f};
            if (e < 15) {
#pragma unroll
                for (int j = 0; j < 4; ++j) wq[(e + 1) & 1][j] = *(const LAS f32x4*)(rw + (e + 1) * 1024 + 4 * lane + 256 * j); }
            __builtin_amdgcn_sched_barrier(0);
#pragma unroll
            for (int j = 0; j < 4; ++j) { a4 += chA[j] * wq[e & 1][j]; c4 += chB[j] * wq[e & 1][j]; }
            sxA[e] = (a4[0] + a4[1]) + (a4[2] + a4[3]); sxB[e] = (c4[0] + c4[1]) + (c4[2] + c4[3]);
            __builtin_amdgcn_sched_barrier(0); }
        float lxA, lxB; RT_REDUCE(sxA, lxA); RT_REDUCE(sxB, lxB);
        lxA += __shfl_xor(lxA, 16); lxB += __shfl_xor(lxB, 16); lxA += __shfl_xor(lxA, 32); lxB += __shfl_xor(lxB, 32);
        if (lane < 16) { lgs[lr_ * 16 + lane] = lxA; lgs[(lr_ + 1) * 16 + lane] = lxB; }
#pragma unroll
        for (int j = 0; j < 4; ++j) { chA[j] = nA[j]; chB[j] = nB[j]; }
    }
#undef RT_LOAD
#undef RT_K
#undef RT_NORM
#undef RT_REDUCE
    asm volatile("s_waitcnt lgkmcnt(0)" ::: "memory");
    if (lane < RW) {
        const int lr_ = F.wave * RW + lane, r = row0 + lane;
        float sc_[16], bi[16];
#pragma unroll
        for (int e = 0; e < 16; ++e) { sc_[e] = 1.0f / (1.0f + expf(-lgs[lr_ * 16 + e])); bi[e] = sc_[e] + rb[e]; }
        int bg = 0; float bgs = -1e30f;
#pragma unroll
        for (int gq = 0; gq < 4; ++gq) { float m1 = -1e30f, m2 = -1e30f;
#pragma unroll
            for (int j = 0; j < 4; ++j) { const float x = bi[gq * 4 + j]; if (x > m1) { m2 = m1; m1 = x; } else if (x > m2) m2 = x; }
            const float gsum = m1 + m2; if (gsum > bgs) { bgs = gsum; bg = gq; } }
        float c4[4], s4[4];
#pragma unroll
        for (int j = 0; j < 4; ++j) { c4[j] = bg == 0 ? bi[j] : (bg == 1 ? bi[4 + j] : (bg == 2 ? bi[8 + j] : bi[12 + j])); s4[j] = bg == 0 ? sc_[j] : (bg == 1 ? sc_[4 + j] : (bg == 2 ? sc_[8 + j] : sc_[12 + j])); }
        int i1 = 0; float b1v = c4[0], w1 = s4[0];
#pragma unroll
        for (int j = 1; j < 4; ++j) if (c4[j] > b1v) { i1 = j; b1v = c4[j]; w1 = s4[j]; }
        int i2 = -1; float b2v = -1e30f, w2 = 0.f;
#pragma unroll
        for (int j = 0; j < 4; ++j) if (j != i1 && (i2 < 0 || c4[j] > b2v)) { i2 = j; b2v = c4[j]; w2 = s4[j]; }
        const float inv = 1.0f / (w1 + w2);
        const int e0 = bg * 4 + i1, e1 = bg * 4 + i2; sel[2 * r] = e0; sel[2 * r + 1] = e1; wsel[2 * r] = w1 * inv; wsel[2 * r + 1] = w2 * inv; lsel[2 * lr_] = e0; lsel[2 * lr_ + 1] = e1;
    }
    __syncthreads();
    int me = -1, myrank = 0;
    if (F.tid < 320) {
        me = F.tid < 2 * NR ? lsel[F.tid] : -1; int wc = 0;
        const unsigned long long below = (1ull << lane) - 1ull;
#pragma unroll
        for (int e = 0; e < 16; ++e) { const unsigned long long m = __ballot(me == e); if (me == e) myrank = __builtin_popcountll(m & below); if (lane == e) wc = __builtin_popcountll(m); }
        if (lane < 16) lrk[F.wave * 16 + lane] = wc;
    }
    __syncthreads();
    if (F.tid < 2 * NR) { int c = myrank;
#pragma unroll
        for (int w = 0; w < 4; ++w) c += (w < F.wave) ? lrk[w * 16 + me] : 0;
        lrank[2 * (F.blk * NR) + F.tid] = c; }
    if (F.tid >= 496) { const int e = F.tid - 496; cnt[F.blk * 16 + e] = (lrk[e] + lrk[16 + e]) + (lrk[32 + e] + lrk[48 + e]) + lrk[64 + e]; }
}
__device__ __forceinline__ void phase_lists(const Params& p, const Frame& F, int l) {
    LAS int* part = (LAS int*)F.lds;
    LAS int* tot = part + 512;
    LAS int* base = tot + 16;
    LAS int* toff = base + 16;
    const int* cnt = (const int*)(p.ws + OFF_CNT); const int* sel = (const int*)(p.ws + OFF_SEL); const float* wsel = (const float*)(p.ws + OFF_WSEL); const int* lrank = (const int*)(p.ws + OFF_LRANK);
    int* pos = (int*)(p.ws + OFF_POS); int* rowl = (int*)(p.ws + OFF_ROWL); float* wl = (float*)(p.ws + OFF_WL); int* seg = (int*)(p.ws + OFF_SEG);
    float* sxs = (float*)(p.ws + OFF_SXS); const float* sx2 = (const float*)(p.ws + OFF_SX2);
    const int NR = l == 0 ? 144 : 128;
    __syncthreads();
    { const int e = F.tid & 15, pt = F.tid >> 4; int s = 0, sb = 0;
      int cv[8];
#pragma unroll
      for (int j = 0; j < 8; ++j) cv[j] = cnt[(pt * 8 + j) * 16 + e];
#pragma unroll
      for (int j = 0; j < 8; ++j) { s += cv[j]; if (pt * 8 + j < F.blk) sb += cv[j]; }
      part[pt * 16 + e] = s; part[512 + 64 + pt * 16 + e] = sb; }
    __syncthreads();
    if (F.tid < 16) { int s = 0, sb = 0;
#pragma unroll
        for (int pt = 0; pt < 32; ++pt) { s += part[pt * 16 + F.tid]; sb += part[576 + pt * 16 + F.tid]; }
        tot[F.tid] = s; base[F.tid] = sb; }
    __syncthreads();
    if (F.tid == 0) { int o = 0, tv[16];
#pragma unroll
        for (int e = 0; e < 16; ++e) tv[e] = tot[e];
#pragma unroll
        for (int e = 0; e < 16; ++e) { toff[e] = o; o += (tv[e] + 255) >> 8; }
        toff[16] = o; }
    __syncthreads();
    if (F.blk == 0 && F.tid < 17) seg[F.tid] = toff[F.tid];
    for (int i = F.tid; i < 2 * NR; i += NTHR) { const int idx = 2 * (F.blk * NR) + i, e = sel[idx], ps = toff[e] * 256 + base[e] + lrank[idx]; pos[idx] = ps; rowl[ps] = idx >> 1; wl[ps] = wsel[idx]; sxs[ps] = sx2[idx >> 1]; }
    if (F.blk < 16) { const int e = F.blk, lo = toff[e] * 256 + tot[e], hi = toff[e + 1] * 256; for (int i = lo + F.tid; i < hi; i += NTHR) { rowl[i] = 0; wl[i] = 0.f; sxs[i] = 0.f; } }
    __syncthreads();
}
__device__ __forceinline__ void load_toff(const Params& p, const Frame& F) {
    LAS int* toff = (LAS int*)(F.lds + LDS_CTL_OFF + 64);
    __syncthreads();
    if (F.tid < 17) toff[F.tid] = ((const int*)(p.ws + OFF_SEG))[F.tid];
    __syncthreads();
}

#define OPAQUE_V(x) asm volatile("" : "+v"(x))
#define PHASE_ENTER() Frame F; { int t_ = threadIdx.x; OPAQUE_V(t_); F.tid = t_; F.lane = t_ & 63; F.wave = __builtin_amdgcn_readfirstlane(t_ >> 6); int b_ = blockIdx.x; OPAQUE_S(b_); F.blk = b_; F.lds = (LAS unsigned char*)lds_raw; } \
    size_t wz_ = 0; OPAQUE_S(wz_); unsigned char* ws = p.ws + wz_; int l = l0; OPAQUE_S(l); (void)l; (void)ws
__global__ void __launch_bounds__(NTHR, 2) fwd_kernel(Params p) {
    extern __shared__ __attribute__((aligned(16))) unsigned char lds_raw[];
    for (int u = threadIdx.x; u < (LDS_BYTES - LDS_CTL_OFF) / 4; u += NTHR) ((LAS unsigned*)((LAS unsigned char*)lds_raw + LDS_CTL_OFF))[u] = 0u;
    __syncthreads();
#if !MK_LAUNCH_PER_PHASE
    XcdBarrier bar = xcd_barrier_post((unsigned*)(p.ws + OFF_CTL), (volatile LAS unsigned*)((LAS unsigned char*)lds_raw + LDS_CTL_OFF));
#define GRID_BAR() xcd_barrier(bar)
#else
#define GRID_BAR() do { } while (0)
#endif
    const int lo = (int)p.ph_lo, hi = (int)p.ph_hi;
#define IN(k) (lo <= (k) && (k) < hi)
#define SEAM(k) do { if (IN(k) && IN((k) + 1)) { GRID_BAR(); if ((REPEAT_MASK >> 16) & 1) GRID_BAR(); } } while (0)
#ifndef NPASS
#define NPASS 1
#endif
    for (int pass_ = 0; pass_ < NPASS; ++pass_) {
    if (pass_ > 0) GRID_BAR();
    if (PH_ON(0) && IN(0)) {
        const int l0 = 0;
        REP(0) { PHASE_ENTER();
        { bf16_t* w16 = (bf16_t*)(ws + OFF_SGUW16); const int i8 = (F.blk * NTHR + F.tid) * 8;
          for (int i = i8; i < 262144; i += NBLK * NTHR * 8) { const f32x4 a = *(const f32x4*)(p.in[I_SGUW] + i), b = *(const f32x4*)(p.in[I_SGUW] + i + 4); *(u32x4*)(w16 + i) = pack8(a, b); } }
        mod_items(p, F);
        if (F.blk >= 128) s5_build_job(p, F, 0, 255 - F.blk);
        __syncthreads();
        if (F.blk < 128) { colmax_win(p, F); convert_mix(p, F, 0, 1, F.blk * NWAVE + F.wave, 128 * NWAVE); } }
    }
    SEAM(0);
    for (int l0 = 0; l0 < DEPTH; ++l0) {
        const int pb = 1 + 12 * l0;
        if (PH_ON(1) && IN(pb + 0)) {
            for (int rep_ = 0; rep_ < 1 + (((REPEAT_MASK >> 1) & 1) && l0 == 0 ? 1 : 0); ++rep_) { PHASE_ENTER();
            if (l == 1) convert_mix(p, F, 1, 1, F.blk * NWAVE + F.wave, NBLK * NWAVE);
            else convert_mix(p, F, 0, 0, F.blk * NWAVE + F.wave, NBLK * NWAVE);
            if (((REPEAT_MASK >> 18) & 1) && l == 1) phase_norm1(p, F, l, true);
            phase_norm1(p, F, l); }
        }
        SEAM(pb + 0);
        if (PH_ON(2) && IN(pb + 1)) {
            REP(2) { PHASE_ENTER();
            SchedB S{(const char*)(ws + OFF_XN), (const char*)(ws + OFF_WIN), l, F.blk};
            EpiB E{(bf16_t*)(ws + OFF_U), (bf16_t*)(ws + OFF_V), (bf16_t*)(ws + OFF_BB), (bf16_t*)(ws + OFF_P), (bf16_t*)(ws + OFF_UX), ws + OFF_G8, (const float*)(ws + OFF_SXA), (const float*)(ws + OFF_SWIN) + (size_t)l * 6144};
            gs::gemm_stream<EpiB, SchedB, false>(F.lds, F.tid, S, E); }
        }
        SEAM(pb + 1);
        if (PH_ON(3) && IN(pb + 2)) {
            REP(3) { PHASE_ENTER(); SchedE S{(const char*)(ws + OFF_UX), (const char*)(ws + OFF_WE), F.blk}; EpiE E{(float*)(ws + OFF_E)}; gs::gemm_stream<EpiE, SchedE, false>(F.lds, F.tid, S, E); }
            { PHASE_ENTER(); phase_conv(p, F, l); }
        }
        SEAM(pb + 2);
        if (PH_ON(4) && IN(pb + 3)) { REP(4) { PHASE_ENTER(); phase_scan(p, F, l); } { PHASE_ENTER(); phase_sgu(p, F, l); } }
        SEAM(pb + 3);
        if (PH_ON(5) && IN(pb + 4)) REP(5) { PHASE_ENTER(); SchedY S{(const char*)(ws + OFF_UX), (const char*)(ws + OFF_TW), l, F.blk}; EpiY E{(bf16_t*)(ws + OFF_V)}; gs::gemm_stream<EpiY, SchedY, false>(F.lds, F.tid, S, E); }
        SEAM(pb + 4);
        if (PH_ON(6) && IN(pb + 5)) REP(6) { PHASE_ENTER(); SchedF S{(const char*)(ws + OFF_V), (const char*)(ws + OFF_GLU), l, F.blk}; EpiF E{(const bf16_t*)(ws + OFF_V), (bf16_t*)(ws + OFF_P), p.in[I_GLUB] + l * 512}; gs::gemm_stream<EpiF, SchedF, false>(F.lds, F.tid, S, E); }
        SEAM(pb + 5);
        if (PH_ON(7) && IN(pb + 6)) {
            REP(7) { PHASE_ENTER();
            SchedG S{(const char*)(ws + OFF_U), (const char*)(ws + OFF_BB), (const char*)(ws + OFF_P), (const char*)(ws + OFF_WBR), l, F.blk};
            EpiG E{ws + OFF_G8, (bf16_t*)(ws + OFF_MERGED)};
            gs::gemm_stream<EpiG, SchedG, false>(F.lds, F.tid, S, E); }
            if (l0 == 0) {
                PHASE_ENTER();
                if (F.blk >= 64 && F.blk < 192) s5_build_job(p, F, 1, F.blk - 64);
                __syncthreads();
                if (F.blk >= 64) convert_mix(p, F, 1, 0, (F.blk - 64) * NWAVE + F.wave, 192 * NWAVE);
            }
        }
        SEAM(pb + 6);
        if (PH_ON(8) && IN(pb + 7)) {
            for (int rep_ = 0; rep_ < 1 + (((REPEAT_MASK >> 8) & 1) && l0 == 0 ? 1 : 0); ++rep_) { PHASE_ENTER();
            SchedH S{(const char*)(ws + OFF_MERGED), (const char*)(ws + OFF_WOUT), l, F.blk};
            if (l == 0) { EpiH<1> E{p.in[I_X], p.in[I_CTX], (bf16_t*)(ws + OFF_HB), (const float*)(ws + OFF_MOD) + (size_t)l * 17 * 6144}; gs::gemm_stream<EpiH<1>, SchedH, false>(F.lds, F.tid, S, E); }
            else { EpiH<0> E{p.in[I_X], p.in[I_CTX], (bf16_t*)(ws + OFF_HB), (const float*)(ws + OFF_MOD) + (size_t)l * 17 * 6144}; gs::gemm_stream<EpiH<0>, SchedH, false>(F.lds, F.tid, S, E); } }
            { PHASE_ENTER(); if (l == 0 && F.blk >= 64) convert_experts(p, F, 0, F.blk - 64, NBLK - 64, 3); }
        }
        SEAM(pb + 7);
        if (PH_ON(9) && IN(pb + 8)) { REP(9) { PHASE_ENTER(); phase_router(p, F, l); } REP(10) { PHASE_ENTER(); if (l == 1) convert_experts(p, F, l, F.blk, NBLK, 1); } }
        SEAM(pb + 8);
        if (PH_ON(10) && IN(pb + 9)) REP(13) { PHASE_ENTER(); phase_lists(p, F, l); }
        SEAM(pb + 9);
        if (PH_ON(11) && IN(pb + 10)) {
            REP(11) { PHASE_ENTER();
            load_toff(p, F);
            SchedK S{(const char*)(ws + OFF_XN), (const char*)(ws + OFF_WGU), (const int*)(ws + OFF_ROWL), (const LAS int*)(F.lds + LDS_CTL_OFF + 64), F.blk};
            EpiK E{(bf16_t*)(ws + OFF_HE), (const float*)(ws + OFF_SXS), (const float*)(ws + OFF_SWGU)};
            gs::gemm_stream<EpiK, SchedK, true>(F.lds, F.tid, S, E); }
            { PHASE_ENTER(); if (l == 1) { const int r = (__builtin_amdgcn_readfirstlane(((const LAS int*)(F.lds + LDS_CTL_OFF + 64))[16]) * 4) & 255;
                if (r == 0 || r > 128) convert_experts(p, F, 1, F.blk, NBLK, 2); else if (F.blk >= r) convert_experts(p, F, 1, F.blk - r, NBLK - r, 2); } }
        }
        SEAM(pb + 10);
        if (PH_ON(12) && IN(pb + 11)) {
            REP(12) { PHASE_ENTER();
            load_toff(p, F);
            SchedL S{(const char*)(ws + OFF_HE), (const char*)(ws + OFF_WD), (const LAS int*)(F.lds + LDS_CTL_OFF + 64), F.blk};
            EpiL E{(bf16_t*)(ws + OFF_Y), (const float*)(ws + OFF_WL)};
            gs::gemm_stream<EpiL, SchedL, false>(F.lds, F.tid, S, E); }
        }
        SEAM(pb + 11);
    }
    if (PH_ON(13) && IN(25)) { const int l0 = 1; REP(17) { PHASE_ENTER(); phase_final(p, F); } }
    }
#undef IN
#undef SEAM
}


extern "C" void kernel_launch(void* const* d_in, const int* in_sizes, int n_in, void* d_out, int out_size, void* d_ws, size_t ws_size, hipStream_t stream) {
    static int ready = 0;
    if (ready == 0) {
        if (n_in != 31 || out_size != TLAT * D || ws_size < WS_END) { fprintf(stderr, "kernel_launch: unexpected shapes (n_in %d out %d ws %zu)\n", n_in, out_size, ws_size); ready = -1; return; }
        if (hipFuncSetAttribute((const void*)fwd_kernel, hipFuncAttributeMaxDynamicSharedMemorySize, LDS_BYTES) != hipSuccess) { fprintf(stderr, "kernel_launch: hipFuncSetAttribute failed\n"); ready = -1; return; }
        int per_cu = 0;
        if (hipOccupancyMaxActiveBlocksPerMultiprocessor(&per_cu, (const void*)fwd_kernel, NTHR, LDS_BYTES) != hipSuccess || per_cu < 1) fprintf(stderr, "kernel_launch: occupancy query says %d\n", per_cu);
        (void)hipGetLastError();
        ready = 1;
    }
    if (ready < 0) return;
    (void)hipMemsetAsync((char*)d_ws + OFF_CTL, 0, CTL_ZERO_BYTES, stream);
    Params p{};
    for (int i = 0; i < 31; ++i) p.in[i] = (const float*)d_in[i];
    p.out = (float*)d_out; p.ws = (unsigned char*)d_ws;
#if MK_LAUNCH_PER_PHASE
    for (int ph = 0; ph < 26; ++ph) { p.ph_lo = ph; p.ph_hi = ph + 1; hipLaunchKernelGGL(fwd_kernel, dim3(NBLK), dim3(NTHR), LDS_BYTES, stream, p); }
#else
    p.ph_lo = 0; p.ph_hi = 26;
    hipLaunchKernelGGL(fwd_kernel, dim3(NBLK), dim3(NTHR), LDS_BYTES, stream, p);
#endif
}
```

```cpp
#include <hip/hip_runtime.h>
#include <cstdio>
#include <cstdint>

#ifndef MK_LAUNCH_PER_PHASE
#define MK_LAUNCH_PER_PHASE 0
#endif

#ifndef PHASE_MASK
#define PHASE_MASK 0xFFFF
#endif
#define PH_ON(k) (((PHASE_MASK) >> (k)) & 1)
#ifndef REPEAT_MASK
#define REPEAT_MASK 0
#endif
#define REP(k) for (int rep_ = 0; rep_ < 1 + ((REPEAT_MASK >> (k)) & 1); ++rep_)
#define LAS __attribute__((address_space(3)))
#define GAS __attribute__((address_space(1)))
typedef unsigned short bf16_t;
typedef short bf16x8 __attribute__((ext_vector_type(8)));
typedef float f32x4 __attribute__((ext_vector_type(4)));
typedef float f32x2 __attribute__((ext_vector_type(2)));
typedef unsigned u32x4 __attribute__((ext_vector_type(4)));
typedef unsigned u32x2 __attribute__((ext_vector_type(2)));
typedef int i32x4 __attribute__((ext_vector_type(4)));

constexpr int D = 1024, TLAT = 32768, TCTX = 4096, TALL = 36864, DEPTH = 2;
constexpr int NBLK = 256, NTHR = 512, NWAVE = 8;
constexpr int NCH = 1152, NCHP = 1280, SQ = 32;
constexpr float EPS = 1e-6f;
constexpr int MAXROWS = 77824;

constexpr size_t MiB = 1u << 20;
constexpr size_t OFF_CTL = 0, CTL_ZERO_BYTES = 65536;
constexpr size_t OFF_CMAXW = OFF_CTL + 16384;
constexpr size_t OFF_SXA = OFF_CTL + 393216;
constexpr size_t OFF_SWIN = OFF_CTL + 655360;
constexpr size_t OFF_SWGU = OFF_CTL + 720896;
constexpr size_t OFF_SX2 = OFF_CTL + 786432;
constexpr size_t OFF_SXS = 21 * MiB + 512 * 1024;
constexpr size_t OFF_SGUW16 = OFF_CTL + 131072;
constexpr size_t OFF_MOD = 1 * MiB;
constexpr size_t OFF_MISC = 2 * MiB;
constexpr size_t OFF_AQ = OFF_MISC;
constexpr size_t OFF_CNT = OFF_MISC + 64 * 1024;
constexpr size_t OFF_SEG = OFF_MISC + 80 * 1024;
constexpr size_t OFF_SEL = OFF_MISC + 128 * 1024;
constexpr size_t OFF_WSEL = OFF_MISC + 448 * 1024;
constexpr size_t OFF_LRANK = OFF_MISC + 768 * 1024;
constexpr size_t OFF_POS = OFF_MISC + 1088 * 1024;
constexpr size_t OFF_ROWL = OFF_MISC + 1408 * 1024;
constexpr size_t OFF_WL = OFF_MISC + 1728 * 1024;
constexpr size_t OFF_WIN = 4 * MiB;
constexpr size_t OFF_WBR = 16 * MiB;
constexpr size_t OFF_WOUT = 19 * MiB;
constexpr size_t OFF_GLU = 21 * MiB;
constexpr size_t OFF_WE = 22 * MiB;
constexpr size_t OFF_TW = 30 * MiB;
constexpr size_t OFF_HB = 54 * MiB;
constexpr size_t OFF_XN = 126 * MiB;
constexpr size_t OFF_U = 198 * MiB;
constexpr size_t OFF_V = 234 * MiB;
constexpr size_t OFF_BB = 270 * MiB;
constexpr size_t OFF_P = 306 * MiB;
constexpr size_t OFF_UX = 342 * MiB;
constexpr size_t OFF_G8 = 402 * MiB;
constexpr size_t WS_END = 510 * MiB;
constexpr size_t OFF_MERGED = OFF_XN;
constexpr size_t OFF_E = OFF_XN;
constexpr size_t OFF_Y = 198 * MiB;
constexpr size_t OFF_HE = 350 * MiB;
constexpr size_t OFF_WGU = 426 * MiB;
constexpr size_t OFF_WD = 458 * MiB;
static_assert(OFF_Y + (size_t)MAXROWS * 1024 * 2 <= OFF_HE && OFF_HE + (size_t)MAXROWS * 512 * 2 <= OFF_WGU && OFF_WD + (size_t)16 * 1024 * 512 * 2 <= WS_END && OFF_G8 + (size_t)TALL * 3072 <= WS_END, "overlay map");

constexpr int RING_BYTES = 131072;
constexpr int LDS_CTL_OFF = 159744;
constexpr int LDS_BYTES = 160768;

__device__ __forceinline__ unsigned cvt_pk_bf16(float lo, float hi) { unsigned r; asm volatile("v_cvt_pk_bf16_f32 %0, %1, %2" : "=v"(r) : "v"(lo), "v"(hi)); return r; }
__device__ __forceinline__ float bf_lo(unsigned w) { return __uint_as_float(w << 16); }
__device__ __forceinline__ float bf_hi(unsigned w) { return __uint_as_float(w & 0xffff0000u); }
__device__ __forceinline__ float bf1(bf16_t b) { return __uint_as_float(((unsigned)b) << 16); }
__device__ __forceinline__ float sigmoidf_(float x) { return __builtin_amdgcn_rcpf(1.0f + __builtin_amdgcn_exp2f(-1.44269504089f * x)); }
__device__ __forceinline__ float siluf_(float x) { return x * sigmoidf_(x); }
__device__ __forceinline__ float geluf_(float x) { return x * sigmoidf_(1.59576912161f * x * (1.0f + 0.044715f * x * x)); }
__device__ __forceinline__ f32x4 gelu4(const f32x4 x) {
    const f32x4 t = x * (x * x * (-0.10294324f) + (-2.30220821f));
    f32x4 e; e[0] = __builtin_amdgcn_exp2f(t[0]); e[1] = __builtin_amdgcn_exp2f(t[1]); e[2] = __builtin_amdgcn_exp2f(t[2]); e[3] = __builtin_amdgcn_exp2f(t[3]);
    e = e + 1.0f;
    f32x4 r; r[0] = __builtin_amdgcn_rcpf(e[0]); r[1] = __builtin_amdgcn_rcpf(e[1]); r[2] = __builtin_amdgcn_rcpf(e[2]); r[3] = __builtin_amdgcn_rcpf(e[3]);
    return x * r;
}
__device__ __forceinline__ unsigned gate4_u8_t(const f32x4 t) {
    f32x4 e; e[0] = __builtin_amdgcn_exp2f(t[0]); e[1] = __builtin_amdgcn_exp2f(t[1]); e[2] = __builtin_amdgcn_exp2f(t[2]); e[3] = __builtin_amdgcn_exp2f(t[3]);
    e = e + 0.0039177277f;
    unsigned w = __builtin_amdgcn_cvt_pk_u8_f32(__builtin_amdgcn_rcpf(e[0]), 0, 0u);
    w = __builtin_amdgcn_cvt_pk_u8_f32(__builtin_amdgcn_rcpf(e[1]), 1, w);
    w = __builtin_amdgcn_cvt_pk_u8_f32(__builtin_amdgcn_rcpf(e[2]), 2, w);
    w = __builtin_amdgcn_cvt_pk_u8_f32(__builtin_amdgcn_rcpf(e[3]), 3, w);
    return w;
}
template <int CTRL> __device__ __forceinline__ float dpp_f(float v) { return __int_as_float(__builtin_amdgcn_update_dpp(0, __float_as_int(v), CTRL, 0xF, 0xF, false)); }
__device__ __forceinline__ float row16_sum(float v) { v += dpp_f<0xB1>(v); v += dpp_f<0x4E>(v); v += dpp_f<0x141>(v); v += dpp_f<0x140>(v); return v; }
__device__ __forceinline__ float wave_sum(float v) {
    v = row16_sum(v);
    const float a = __int_as_float(__builtin_amdgcn_readlane(__float_as_int(v), 0)), b = __int_as_float(__builtin_amdgcn_readlane(__float_as_int(v), 16)),
                c = __int_as_float(__builtin_amdgcn_readlane(__float_as_int(v), 32)), d = __int_as_float(__builtin_amdgcn_readlane(__float_as_int(v), 48));
    return (a + b) + (c + d);
}
__device__ __forceinline__ u32x4 pack8(const f32x4 a, const f32x4 b) { u32x4 w; w.x = cvt_pk_bf16(a[0], a[1]); w.y = cvt_pk_bf16(a[2], a[3]); w.z = cvt_pk_bf16(b[0], b[1]); w.w = cvt_pk_bf16(b[2], b[3]); return w; }
__device__ __forceinline__ void unpack8(const u32x4 w, f32x4& a, f32x4& b) { a = (f32x4){bf_lo(w.x), bf_hi(w.x), bf_lo(w.y), bf_hi(w.y)}; b = (f32x4){bf_lo(w.z), bf_hi(w.z), bf_lo(w.w), bf_hi(w.w)}; }

#define XB_TMO      128
#define XB_XCNT(j)  (256  + 64 * (j))
#define XB_XSUB(j)  (1280 + 64 * (j))
#define XB_XGEN(j)  (2304 + 64 * (j))
#define XB_TOP      3328
#define XB_TOPGEN   3392
#define XCD_BAR_WORDS 3456
#define XB_SPIN_CAP (1u << 18)
__device__ __forceinline__ unsigned xb_ld(unsigned* p)              { return __hip_atomic_load(p, __ATOMIC_RELAXED, __HIP_MEMORY_SCOPE_AGENT); }
__device__ __forceinline__ unsigned xb_add(unsigned* p, unsigned v) { return __hip_atomic_fetch_add(p, v, __ATOMIC_RELAXED, __HIP_MEMORY_SCOPE_AGENT); }
__device__ __forceinline__ unsigned xb_xcc_id() { return (unsigned)__builtin_amdgcn_s_getreg((3 << 11) | 20) & 0xFu; }
#define XB_SPIN(cond, bar) do { unsigned _sp = 0; while (cond) { __builtin_amdgcn_s_sleep(1); \
    if ((++_sp & 255u) == 0u) { if (xb_ld(&(bar)[XB_TMO])) break; if (_sp > XB_SPIN_CAP) { atomicAdd(&(bar)[XB_TMO], 1u); break; } } } } while (0)
struct XcdBarrier { unsigned* bar; unsigned x; volatile LAS unsigned* st; };
__device__ __forceinline__ XcdBarrier xcd_barrier_post(unsigned* bar, volatile LAS unsigned* st) {
    XcdBarrier b; b.bar = bar; b.x = xb_xcc_id(); b.st = st;
    if (threadIdx.x == 0) (void)xb_add(&bar[XB_XCNT(b.x)], 1u);
    return b;
}
__device__ __forceinline__ void xcd_barrier_complete(unsigned* bar, unsigned x, unsigned& nloc, unsigned& nx) {
    const unsigned G = gridDim.x * gridDim.y * gridDim.z;
    unsigned sum, cnt, mine, sp = 0u;
    for (;;) {
        sum = 0u; cnt = 0u; mine = 0u;
#pragma unroll
        for (unsigned j = 0; j < 16; ++j) { const unsigned c = xb_ld(&bar[XB_XCNT(j)]); sum += c; cnt += (c > 0u) ? 1u : 0u; mine = (j == x) ? c : mine; }
        if (sum == G) break;
        __builtin_amdgcn_s_sleep(1);
        if ((++sp & 255u) == 0u) { if (xb_ld(&bar[XB_TMO])) break; if (sp > XB_SPIN_CAP) { atomicAdd(&bar[XB_TMO], 1u); break; } }
    }
    nloc = mine > 0u ? mine : 1u; nx = cnt > 0u ? cnt : 1u;
}
__device__ __forceinline__ void xcd_barrier(const XcdBarrier& b) {
    asm volatile("s_waitcnt vmcnt(0)" ::: "memory");
    __syncthreads();
    if (threadIdx.x == 0) {
        unsigned* bar = b.bar;
        __builtin_amdgcn_s_waitcnt(0);
        unsigned nloc = b.st[0], nx = b.st[1];
        if (nloc == 0u) { xcd_barrier_complete(bar, b.x, nloc, nx); b.st[0] = nloc; b.st[1] = nx; }
        const unsigned old = xb_add(&bar[XB_XSUB(b.x)], 1u);
        const unsigned gen = old / nloc;
        if (old + 1u == (gen + 1u) * nloc) {
            __builtin_amdgcn_fence(__ATOMIC_RELEASE, "agent");
            asm volatile("s_waitcnt vmcnt(0)" ::: "memory");
            const unsigned og = xb_add(&bar[XB_TOP], 1u);
            const unsigned tg = og / nx;
            if (og + 1u == (tg + 1u) * nx) xb_add(&bar[XB_TOPGEN], 1u);
            else XB_SPIN(xb_ld(&bar[XB_TOPGEN]) == tg, bar);
            __builtin_amdgcn_fence(__ATOMIC_ACQUIRE, "agent");
            xb_add(&bar[XB_XGEN(b.x)], 1u);
            asm volatile("s_waitcnt vmcnt(0)" ::: "memory");
        } else {
            XB_SPIN(xb_ld(&bar[XB_XGEN(b.x)]) == gen, bar);
            __builtin_amdgcn_fence(__ATOMIC_ACQUIRE, "agent");
            asm volatile("s_waitcnt vmcnt(0)" ::: "memory");
        }
    }
    __syncthreads();
}

namespace gs {
constexpr int BM = 256, BK = 64, HALF = 128, HTB = HALF * BK * 2, STAGE_BYTES = 8 * HTB;
__device__ __forceinline__ int lds_byte(int r, int c) { const int st = (r >> 4) * 2 + (c >> 5), rr = r & 15, cc = c & 31, ob = rr * 64 + cc * 2; return st * 1024 + (ob ^ (((ob >> 9) & 1) << 5)); }
__device__ __forceinline__ void stage_rc(int b, int& R, int& C) { const int st = b / 1024, sb = b % 1024, swz = sb ^ (((sb >> 9) & 1) << 5); R = (st >> 1) * 16 + swz / 64; C = (st & 1) * 32 + (swz % 64) / 2; }
__device__ __forceinline__ int perm32(int rho) { const int n = rho >> 4, i = rho & 15; return 8 * (i >> 2) + 4 * n + (i & 3); }
__device__ __forceinline__ int xcd_remap(int L, int nwg) { const int q = nwg >> 3, r = nwg & 7, xcd = L & 7, off = L >> 3; return (xcd < r ? xcd * (q + 1) : r * (q + 1) + (xcd - r) * q) + off; }
__device__ __forceinline__ void tile_order(int wgid, int nM, int nN, int& pm, int& pn) { const int nig = 8 * nN, gid = wgid / nig, fm = gid * 8, gsz = (nM - fm) < 8 ? (nM - fm) : 8; pm = fm + ((wgid % nig) % gsz); pn = (wgid % nig) / gsz; }

struct Unit { int pm, pn, kind, aux; };
struct Ops { const char* A; const char* B; unsigned lda, ldb; int nt; const int* rows; };

template <class Epi, class Sched, bool GATHER>
__device__ __forceinline__ void gemm_stream(LAS unsigned char* lds, const int tid, const Sched& S, const Epi& E) {
    const int wid = __builtin_amdgcn_readfirstlane(tid >> 6), lane = tid & 63, wr = wid >> 2, wc = wid & 3, fr = lane & 15, fq = lane >> 4;
    const unsigned ldsw = (unsigned)wid * 1024u;
    const int aoff = lds_byte(wr * 64 + fr, fq * 8), boff = lds_byte(wc * 32 + fr, fq * 8);
    Unit cur, nxt; int ui = 0;
    if (!S.next(0, cur)) return;
    unsigned vA0[2], vA1[2], vB[2];
    const char* cA; const char* cB; size_t hA, hB; int nt;
#define GS_SETOFF(u) do { Ops _o; S.ops((u), _o); cA = _o.A; cB = _o.B; nt = _o.nt; hB = (size_t)HALF * _o.ldb; hA = GATHER ? (size_t)0 : (size_t)HALF * _o.lda; \
        _Pragma("unroll") for (int _i = 0; _i < 2; ++_i) { int _R, _C; stage_rc(tid * 16 + _i * 8192, _R, _C); const int _Rb = (_R & ~31) + perm32(_R & 31); \
        if constexpr (GATHER) { vA0[_i] = (unsigned)_o.rows[_R] * _o.lda + (unsigned)_C * 2u; vA1[_i] = (unsigned)_o.rows[HALF + _R] * _o.lda + (unsigned)_C * 2u; } \
        else { vA0[_i] = (unsigned)_R * _o.lda + (unsigned)_C * 2u; vA1[_i] = 0u; } \
        vB[_i] = (unsigned)_Rb * _o.ldb + (unsigned)_C * 2u; } } while (0)
#define GS_SA(b, h) (((b) * 2 + (h)) * HTB)
#define GS_SB(b, h) ((4 + (b) * 2 + (h)) * HTB)
#define GS_STAGE(bufoff, gbase, voff) do { _Pragma("unroll") for (int _i = 0; _i < 2; ++_i) \
        __builtin_amdgcn_global_load_lds((const unsigned*)((const char*)(gbase) + (voff)[_i]), (LAS unsigned*)(lds + (bufoff) + ldsw + _i * 8192), 16, 0, 0); } while (0)
#define GS_STAGE_A1(bufoff, gbase) do { if constexpr (GATHER) { GS_STAGE(bufoff, gbase, vA1); } else { GS_STAGE(bufoff, (gbase) + hA, vA0); } } while (0)
#define GS_LDA(dst, b, h) do { _Pragma("unroll") for (int m = 0; m < 4; ++m) _Pragma("unroll") for (int k = 0; k < 2; ++k) dst[m][k] = *(const LAS bf16x8*)(lds + GS_SA(b, h) + aoff + m * 2048 + k * 1024); } while (0)
#define GS_LDB(dst, b, h) do { _Pragma("unroll") for (int n = 0; n < 2; ++n) _Pragma("unroll") for (int k = 0; k < 2; ++k) dst[n][k] = *(const LAS bf16x8*)(lds + GS_SB(b, h) + boff + n * 2048 + k * 1024); } while (0)
#define GS_MMA(ai, bj, At, Bt) do { __builtin_amdgcn_s_setprio(1); _Pragma("unroll") for (int m = 0; m < 4; ++m) _Pragma("unroll") for (int n = 0; n < 2; ++n) _Pragma("unroll") for (int k = 0; k < 2; ++k) { \
        if constexpr (Epi::I8) acc[ai][bj][m][n] = __builtin_bit_cast(f32x4, __builtin_amdgcn_mfma_i32_16x16x64_i8(__builtin_bit_cast(i32x4, Bt[n][k]), __builtin_bit_cast(i32x4, At[m][k]), __builtin_bit_cast(i32x4, acc[ai][bj][m][n]), 0, 0, 0)); \
        else acc[ai][bj][m][n] = __builtin_amdgcn_mfma_f32_16x16x32_bf16(Bt[n][k], At[m][k], acc[ai][bj][m][n], 0, 0, 0); } __builtin_amdgcn_s_setprio(0); } while (0)
#define GS_WAIT_V(n) asm volatile("s_waitcnt vmcnt(" #n ")" ::: "memory")
#define GS_WAIT_L(n) asm volatile("s_waitcnt lgkmcnt(" #n ")" ::: "memory")
#define GS_BAR __builtin_amdgcn_s_barrier()
#define GS_SCHED __builtin_amdgcn_sched_barrier(0)
    f32x4 acc[2][2][4][2];
#pragma unroll
    for (int a = 0; a < 2; ++a)
#pragma unroll
        for (int b = 0; b < 2; ++b)
#pragma unroll
            for (int m = 0; m < 4; ++m)
#pragma unroll
                for (int n = 0; n < 2; ++n) acc[a][b][m][n] = (f32x4){0.f, 0.f, 0.f, 0.f};
    bf16x8 At[4][2], B0[2][2], B1[2][2];
    GS_SETOFF(cur);
    const size_t kstep = (size_t)(BK * 2);
    GS_STAGE(GS_SB(0, 0), cB, vB); GS_STAGE(GS_SB(0, 1), cB + hB, vB); GS_STAGE(GS_SA(0, 0), cA, vA0); GS_STAGE_A1(GS_SA(0, 1), cA);
    if (wr == 1) GS_BAR;
    GS_WAIT_V(2); GS_BAR;
    GS_STAGE(GS_SB(1, 0), cB + kstep, vB); GS_STAGE(GS_SA(1, 0), cA + kstep, vA0); GS_STAGE(GS_SB(1, 1), cB + hB + kstep, vB);
    GS_WAIT_V(6); GS_BAR;
    for (;;) {
        const bool has_next = S.next(ui + 1, nxt);
        const int ntc = nt;
        for (int t = 0; t < ntc; t += 2) {
            const bool last = (t == ntc - 2);
            GS_LDB(B0, 0, 0); GS_LDB(B1, 0, 1); GS_SCHED; GS_LDA(At, 0, 0); GS_STAGE_A1(GS_SA(1, 1), cA + (size_t)(t + 1) * kstep);
            const char* a2; const char* b2;
            if (last) { if (has_next) { GS_SETOFF(nxt); } a2 = cA; b2 = cB; }
            else { a2 = cA + (size_t)(t + 2) * kstep; b2 = cB + (size_t)(t + 2) * kstep; }
            const char* a3 = a2 + kstep; const char* b3 = b2 + kstep;
            GS_WAIT_V(8); GS_WAIT_L(0); GS_BAR; GS_MMA(0, 0, At, B0); GS_MMA(0, 1, At, B1); GS_BAR; GS_SCHED;
            GS_LDA(At, 0, 1); GS_STAGE(GS_SB(0, 0), b2, vB); GS_STAGE(GS_SB(0, 1), b2 + hB, vB); GS_STAGE(GS_SA(0, 0), a2, vA0);
            GS_WAIT_V(8); GS_WAIT_L(0); GS_BAR; GS_MMA(1, 0, At, B0); GS_MMA(1, 1, At, B1); GS_BAR; GS_SCHED;
            GS_LDB(B0, 1, 0); GS_LDB(B1, 1, 1); GS_SCHED; GS_LDA(At, 1, 0); GS_STAGE_A1(GS_SA(0, 1), a2);
            GS_WAIT_V(8); GS_WAIT_L(0); GS_BAR; GS_MMA(0, 0, At, B0); GS_MMA(0, 1, At, B1); GS_BAR; GS_SCHED;
            GS_LDA(At, 1, 1); GS_STAGE(GS_SB(1, 0), b3, vB); GS_STAGE(GS_SB(1, 1), b3 + hB, vB); GS_STAGE(GS_SA(1, 0), a3, vA0);
            GS_WAIT_V(8); GS_WAIT_L(0); GS_BAR; GS_MMA(1, 0, At, B0); GS_MMA(1, 1, At, B1); GS_BAR; GS_SCHED;
        }
        if (wr == 0) GS_BAR;
        bool keep = false;
        if constexpr (Epi::KEEPS) keep = E.scale(acc, cur, wr, wc, fr, fq);
        else E(acc, cur, wr, wc, fr, fq);
        if (!has_next) break;
        if (!keep) {
#pragma unroll
        for (int a = 0; a < 2; ++a)
#pragma unroll
            for (int b = 0; b < 2; ++b)
#pragma unroll
                for (int m = 0; m < 4; ++m)
#pragma unroll
                    for (int n = 0; n < 2; ++n) acc[a][b][m][n] = (f32x4){0.f, 0.f, 0.f, 0.f};
        }
        cur = nxt; ++ui;
        if (wr == 1) GS_BAR;
    }
    GS_WAIT_V(0);
    GS_BAR;
#undef GS_SETOFF
#undef GS_SA
#undef GS_SB
#undef GS_STAGE
#undef GS_STAGE_A1
#undef GS_LDA
#undef GS_LDB
#undef GS_MMA
#undef GS_WAIT_V
#undef GS_WAIT_L
#undef GS_BAR
#undef GS_SCHED
}
}

struct Params {
    const float* in[31];
    float* out;
    unsigned char* ws;
    long long ph_lo, ph_hi;
};
enum { I_X = 0, I_C, I_CTX, I_CCTX, I_WMOD, I_BMOD, I_N1G, I_N2G, I_WIN, I_SGUNG, I_SGUW, I_SGUB, I_CONVW, I_LAMRE, I_LAMIM, I_LOGDT, I_BRE, I_BIM, I_CRE, I_CIM, I_S5D,
       I_GLUW, I_GLUB, I_WBR, I_WOUT, I_RW, I_RB, I_EWG, I_EWU, I_EWD, I_FNG };

struct Frame {
    LAS unsigned char* lds;
    int tid, lane, wave, blk;
};

__device__ __forceinline__ float wave_max(float v) {
    v = fmaxf(v, dpp_f<0xB1>(v)); v = fmaxf(v, dpp_f<0x4E>(v)); v = fmaxf(v, dpp_f<0x141>(v)); v = fmaxf(v, dpp_f<0x140>(v));
    const float a = __int_as_float(__builtin_amdgcn_readlane(__float_as_int(v), 0)), b = __int_as_float(__builtin_amdgcn_readlane(__float_as_int(v), 16)),
                c = __int_as_float(__builtin_amdgcn_readlane(__float_as_int(v), 32)), d = __int_as_float(__builtin_amdgcn_readlane(__float_as_int(v), 48));
    return fmaxf(fmaxf(a, b), fmaxf(c, d));
}
__device__ __forceinline__ unsigned q8x4(const f32x4 v, const float inv) {
    const unsigned a = __float_as_uint(__builtin_fmaf(v[0], inv, 12582912.0f)), b = __float_as_uint(__builtin_fmaf(v[1], inv, 12582912.0f));
    const unsigned c = __float_as_uint(__builtin_fmaf(v[2], inv, 12582912.0f)), d = __float_as_uint(__builtin_fmaf(v[3], inv, 12582912.0f));
    return __builtin_amdgcn_perm(__builtin_amdgcn_perm(d, c, 0x0c0c0400u), __builtin_amdgcn_perm(b, a, 0x0c0c0400u), 0x05040100u);
}
__device__ __forceinline__ void tr_item(const float* src, int ld_src, int k0, int c0, bf16_t* dst, int ld_dst, int r0, LAS float* scr, int lane) {
    f32x4 t[8];
#pragma unroll
    for (int i = 0; i < 8; ++i) t[i] = *(const f32x4*)(src + (size_t)(k0 + 8 * i + (lane >> 3)) * ld_src + c0 + 4 * (lane & 7));
#pragma unroll
    for (int i = 0; i < 8; ++i) { LAS float* d = scr + (8 * i + (lane >> 3)) * 33 + 4 * (lane & 7); d[0] = t[i][0]; d[1] = t[i][1]; d[2] = t[i][2]; d[3] = t[i][3]; }
    asm volatile("s_waitcnt lgkmcnt(0)" ::: "memory");
    const int c = lane & 7;
    float sv[4][8];
#pragma unroll
    for (int j = 0; j < 4; ++j) { const LAS float* s = scr + (8 * c) * 33 + (lane >> 3) + 8 * j;
#pragma unroll
        for (int i = 0; i < 8; ++i) sv[j][i] = s[i * 33]; }
#pragma unroll
    for (int j = 0; j < 4; ++j) { const int n = (lane >> 3) + 8 * j;
        u32x4 o; o.x = cvt_pk_bf16(sv[j][0], sv[j][1]); o.y = cvt_pk_bf16(sv[j][2], sv[j][3]); o.z = cvt_pk_bf16(sv[j][4], sv[j][5]); o.w = cvt_pk_bf16(sv[j][6], sv[j][7]);
        *(u32x4*)(dst + (size_t)(r0 + n) * ld_dst + k0 + 8 * c) = o; }
    asm volatile("s_waitcnt lgkmcnt(0)" ::: "memory");
}
__device__ __forceinline__ void tr_item_i8(const float* src, int ld_src, int k0, int c0, signed char* dst, int ld_dst, int r0, const unsigned* cmax_c0, float* scale_out, LAS float* scr, int lane) {
    f32x4 t[8];
#pragma unroll
    for (int i = 0; i < 8; ++i) t[i] = *(const f32x4*)(src + (size_t)(k0 + 8 * i + (lane >> 3)) * ld_src + c0 + 4 * (lane & 7));
#pragma unroll
    for (int i = 0; i < 8; ++i) { LAS float* d = scr + (8 * i + (lane >> 3)) * 33 + 4 * (lane & 7); d[0] = t[i][0]; d[1] = t[i][1]; d[2] = t[i][2]; d[3] = t[i][3]; }
    asm volatile("s_waitcnt lgkmcnt(0)" ::: "memory");
    const int n = lane & 31, hf = lane >> 5;
    const float cm = fmaxf(__uint_as_float(cmax_c0[n]), 1e-30f), inv = 127.0f / cm;
    if (scale_out && hf == 0) scale_out[n] = cm * (1.0f / 127.0f);
    u32x4 o[2];
#pragma unroll
    for (int h = 0; h < 2; ++h) {
        unsigned w[4];
#pragma unroll
        for (int x = 0; x < 4; ++x) { const LAS float* sp = scr + (32 * hf + 16 * h + 4 * x) * 33 + n; w[x] = q8x4((f32x4){sp[0], sp[33], sp[66], sp[99]}, inv); }
        o[h] = (u32x4){w[0], w[1], w[2], w[3]}; }
    *(u32x4*)(dst + (size_t)(r0 + n) * ld_dst + k0 + 32 * hf) = o[0]; *(u32x4*)(dst + (size_t)(r0 + n) * ld_dst + k0 + 32 * hf + 16) = o[1];
    asm volatile("s_waitcnt lgkmcnt(0)" ::: "memory");
}
__device__ __forceinline__ void colmax_win(const Params& p, const Frame& F) {
    unsigned* cmax = (unsigned*)(p.ws + OFF_CMAXW);
    for (int it = F.blk * NWAVE + F.wave; it < 768; it += NBLK * NWAVE) {
        const int l = it / 384, rem = it % 384, kb = rem / 24, cb = rem % 24;
        const float* src = p.in[I_WIN] + ((size_t)l * 1024 + 64 * kb) * 6144 + cb * 256 + 4 * F.lane;
        f32x4 m = (f32x4){0.f, 0.f, 0.f, 0.f};
#pragma unroll 16
        for (int i = 0; i < 64; ++i) { const f32x4 v = *(const f32x4*)(src + (size_t)i * 6144); m[0] = fmaxf(m[0], fabsf(v[0])); m[1] = fmaxf(m[1], fabsf(v[1])); m[2] = fmaxf(m[2], fabsf(v[2])); m[3] = fmaxf(m[3], fabsf(v[3])); }
        unsigned* dst = cmax + l * 6144 + cb * 256 + 4 * F.lane;
        atomicMax(dst + 0, __float_as_uint(m[0])); atomicMax(dst + 1, __float_as_uint(m[1])); atomicMax(dst + 2, __float_as_uint(m[2])); atomicMax(dst + 3, __float_as_uint(m[3]));
    }
}
__device__ __forceinline__ int win_col(int n) {
    if (n < 1536 || n >= 2560) return n;
    const int j = (n - 1536) >> 8, q = (n - 1536) & 255;
    return (q < 128) ? (1536 + 128 * j + q) : (2048 + 128 * j + (q - 128));
}
__device__ __forceinline__ void convert_mix(const Params& p, const Frame& F, int l, int part, int wslot, int nwslots) {
    LAS float* scr = (LAS float*)(F.lds + F.wave * 16384);
    bf16_t* WinT = (bf16_t*)(p.ws + OFF_WIN); bf16_t* WbrT = (bf16_t*)(p.ws + OFF_WBR); bf16_t* WoutT = (bf16_t*)(p.ws + OFF_WOUT); bf16_t* GluT = (bf16_t*)(p.ws + OFF_GLU);
    const int nit = part == 0 ? 3200 : (part == 1 ? 1280 : 4480);
    for (int it0 = wslot; it0 < nit; it0 += nwslots) {
        int r = part == 0 ? (it0 < 3072 ? it0 : it0 + 1280) : (part == 1 ? it0 + 3072 : it0);
        if (r < 3072) { const int kb = r / 192, nb = r % 192, oc = win_col(32 * nb);
            tr_item_i8(p.in[I_WIN] + (size_t)l * 1024 * 6144, 6144, 64 * kb, oc, (signed char*)WinT, 1024, 32 * nb, (const unsigned*)(p.ws + OFF_CMAXW) + l * 6144 + oc, kb == 0 ? (float*)(p.ws + OFF_SWIN) + l * 6144 + 32 * nb : nullptr, scr, F.lane); continue; }
        r -= 3072;
        if (r < 768) { const int br = r / 256, rem = r % 256, kb = rem / 32, nb = rem % 32; tr_item(p.in[I_WBR] + ((size_t)l * 3 + br) * 512 * 1024, 1024, 64 * kb, 32 * nb, WbrT + (size_t)br * 1024 * 512, 512, 32 * nb, scr, F.lane); continue; }
        r -= 768;
        if (r < 512) { const int kb = r / 32, nb = r % 32; tr_item(p.in[I_WOUT] + (size_t)l * 1024 * 1024, 1024, 64 * kb, 32 * nb, WoutT, 1024, 32 * nb, scr, F.lane); continue; }
        r -= 512;
        { const int kb = r / 16, nb = r % 16; tr_item(p.in[I_GLUW] + (size_t)l * 512 * 512, 512, 64 * kb, 32 * nb, GluT, 512, 32 * nb, scr, F.lane); }
    }
}
__device__ __forceinline__ void convert_experts(const Params& p, const Frame& F, int l, int slot, int nslots, int parts) {
    LAS float* scr = (LAS float*)(F.lds + 65536 + F.wave * 8448);
    LAS unsigned* cmx = (LAS unsigned*)(F.lds + 65536 + 8 * 8448);
    signed char* Wgu = (signed char*)(p.ws + OFF_WGU); bf16_t* Wd = (bf16_t*)(p.ws + OFF_WD); float* swgu = (float*)(p.ws + OFF_SWGU);
    const int lane = F.lane;
    if (parts & 1)
    for (int st = slot; st < 512; st += nslots) {
        const int e = st >> 5, nb = st & 31, n0 = 32 * nb, t = n0 >> 8, qq = n0 & 255, c0 = 128 * t + (qq & 127);
        const float* src = (qq < 128 ? p.in[I_EWG] : p.in[I_EWU]) + ((size_t)l * 16 + e) * 1024 * 512;
        __syncthreads();
        if (F.tid < 32) cmx[F.tid] = 0u;
        __syncthreads();
        f32x4 t0[8], t1[8];
#pragma unroll
        for (int i = 0; i < 8; ++i) { t0[i] = *(const f32x4*)(src + (size_t)(128 * F.wave + 8 * i + (lane >> 3)) * 512 + c0 + 4 * (lane & 7)); t1[i] = *(const f32x4*)(src + (size_t)(128 * F.wave + 64 + 8 * i + (lane >> 3)) * 512 + c0 + 4 * (lane & 7)); }
        f32x4 m = (f32x4){0.f, 0.f, 0.f, 0.f};
#pragma unroll
        for (int i = 0; i < 8; ++i) {
#pragma unroll
            for (int j = 0; j < 4; ++j) m[j] = fmaxf(m[j], fmaxf(fabsf(t0[i][j]), fabsf(t1[i][j]))); }
#pragma unroll
        for (int j = 0; j < 4; ++j) __hip_atomic_fetch_max(cmx + 4 * (lane & 7) + j, __float_as_uint(m[j]), __ATOMIC_RELAXED, __HIP_MEMORY_SCOPE_WORKGROUP);
        __syncthreads();
        const int n = lane & 31, hf = lane >> 5;
        const float cm = fmaxf(__uint_as_float(cmx[n]), 1e-30f), inv = 127.0f / cm;
        if (F.wave == 0 && hf == 0) swgu[e * 1024 + n0 + n] = cm * (1.0f / 127.0f);
#pragma unroll
        for (int tt = 0; tt < 2; ++tt) {
#pragma unroll
            for (int i = 0; i < 8; ++i) { LAS float* d = scr + (8 * i + (lane >> 3)) * 33 + 4 * (lane & 7); const f32x4 v = tt == 0 ? t0[i] : t1[i]; d[0] = v[0]; d[1] = v[1]; d[2] = v[2]; d[3] = v[3]; }
            asm volatile("s_waitcnt lgkmcnt(0)" ::: "memory");
            u32x4 o[2];
#pragma unroll
            for (int h = 0; h < 2; ++h) { unsigned w[4];
#pragma unroll
                for (int x = 0; x < 4; ++x) { const LAS float* sp = scr + (32 * hf + 16 * h + 4 * x) * 33 + n; w[x] = q8x4((f32x4){sp[0], sp[33], sp[66], sp[99]}, inv); }
                o[h] = (u32x4){w[0], w[1], w[2], w[3]}; }
            signed char* dp = Wgu + ((size_t)e * 1024 + n0 + n) * 1024 + 128 * F.wave + 64 * tt + 32 * hf;
            *(u32x4*)dp = o[0]; *(u32x4*)(dp + 16) = o[1];
            asm volatile("s_waitcnt lgkmcnt(0)" ::: "memory");
        }
    }
    if (parts & 2)
    for (int it = slot * NWAVE + F.wave; it < 4096; it += nslots * NWAVE) {
        const int e = it / 256, rem = it % 256, kb = rem / 32, nb = rem % 32;
        tr_item(p.in[I_EWD] + ((size_t)l * 16 + e) * 512 * 1024, 1024, 64 * kb, 32 * nb, Wd + (size_t)e * 1024 * 512, 512, 32 * nb, scr, F.lane);
    }
}

__device__ __forceinline__ void mod_items(const Params& p, const Frame& F) {
    LAS float* sc = (LAS float*)F.lds;
    LAS float* red = (LAS float*)(F.lds + 17 * 1024 * 4);
    float* mod = (float*)(p.ws + OFF_MOD);
    bool staged = false;
    __syncthreads();
    for (int it = F.blk; it < 384; it += NBLK) {
        if (!staged) {
            f32x4 tv[9];
#pragma unroll
            for (int x = 0; x < 8; ++x) tv[x] = *(const f32x4*)(p.in[I_C] + (F.tid + x * NTHR) * 4);
            tv[8] = *(const f32x4*)(p.in[I_CCTX] + (F.tid & 255) * 4);
#pragma unroll
            for (int x = 0; x < 9; ++x) { const int i = (x < 8 ? F.tid + x * NTHR : 4096 + (F.tid & 255)) * 4;
                if (x < 8 || F.tid < 256) *(LAS f32x4*)(sc + i) = (f32x4){siluf_(tv[x][0]), siluf_(tv[x][1]), siluf_(tv[x][2]), siluf_(tv[x][3])}; }
            staged = true;
        }
        __syncthreads();
        const int l = it / 192, n0 = (it % 192) * 32, ks = F.tid >> 5, cn = F.tid & 31;
        const float* w = p.in[I_WMOD] + (size_t)l * 1024 * 6144 + n0 + cn;
        float a[17];
#pragma unroll
        for (int mi = 0; mi < 17; ++mi) a[mi] = 0.f;
        for (int k0 = ks * 64; k0 < ks * 64 + 64; k0 += 16) { float wv[16];
#pragma unroll
            for (int x = 0; x < 16; ++x) wv[x] = w[(size_t)(k0 + x) * 6144];
#pragma unroll
            for (int x = 0; x < 16; ++x) {
#pragma unroll
                for (int mi = 0; mi < 17; ++mi) a[mi] += sc[mi * 1024 + k0 + x] * wv[x]; } }
#pragma unroll
        for (int mi = 0; mi < 17; ++mi) red[(ks * 17 + mi) * 32 + cn] = a[mi];
        __syncthreads();
        for (int i = F.tid; i < 17 * 32; i += NTHR) { const int mi = i >> 5, c2 = i & 31; float s = 0.f;
#pragma unroll
            for (int q = 0; q < 16; ++q) s += red[(q * 17 + mi) * 32 + c2];
            mod[((size_t)l * 17 + mi) * 6144 + n0 + c2] = s + p.in[I_BMOD][l * 6144 + n0 + c2]; }
    }
    __syncthreads();
}

__device__ __forceinline__ void s5_build_job(const Params& p, const Frame& F, int l, int job) {
    const int g = job >> 2, q = job & 3, tid = F.tid;
    LAS f32x2* ap = (LAS f32x2*)F.lds;
    LAS f32x2* bb = (LAS f32x2*)(F.lds + 34816);
    LAS f32x2* cc = (LAS f32x2*)(F.lds + 34816 + 16384);
    LAS f32x2* fz = (LAS f32x2*)(F.lds + 34816 + 32768);
    LAS float* kt = (LAS float*)(F.lds + 69632);
    LAS float* dvs = (LAS float*)(F.lds + 34816 + 32768 + 1024);
    __syncthreads();
    {
        const int pp = tid & 63, d = tid >> 8, tq = (tid >> 6) & 3, gi = (l * 2 + d) * 32 + g;
        const float ldt = p.in[I_LOGDT][gi], lr = p.in[I_LAMRE][gi * 64 + pp], li = p.in[I_LAMIM][gi * 64 + pp];
        if (tid < 16) dvs[tid] = p.in[I_S5D][l * 512 + g * 16 + tid];
        const float dt = expf(ldt), t0 = 8.0f * (float)tq;
        float sn, cs; const float m1 = expf(lr * dt); sincosf(li * dt, &sn, &cs); const float a1r = m1 * cs, a1i = m1 * sn;
        const float m0 = expf(lr * dt * t0); sincosf(li * dt * t0, &sn, &cs); float cr = m0 * cs, ci = m0 * sn;
        if (tq == 0) ap[(d * 33) * 64 + pp] = (f32x2){1.0f, 0.0f};
#pragma unroll
        for (int s_ = 1; s_ <= 8; ++s_) { const float nr = cr * a1r - ci * a1i, ni = cr * a1i + ci * a1r; cr = nr; ci = ni; ap[(d * 33 + 8 * tq + s_) * 64 + pp] = (f32x2){cr, ci}; }
    }
    if (tid < 128) {
        const int d = tid >> 6, pp = tid & 63, gi = (l * 2 + d) * 32 + g;
        const float dt = expf(p.in[I_LOGDT][gi]), lr = p.in[I_LAMRE][gi * 64 + pp], li = p.in[I_LAMIM][gi * 64 + pp];
        const float mag = expf(lr * dt); float sn, cs; sincosf(li * dt, &sn, &cs);
        const float abr = mag * cs, abi = mag * sn, den = lr * lr + li * li, nr = abr - 1.0f;
        fz[tid] = (f32x2){(nr * lr + abi * li) / den, (abi * lr - nr * li) / den};
    }
    __syncthreads();
    if (q == 0 && tid < 128) { const int d = tid >> 6, pp = tid & 63; const f32x2 a = ap[(d * 33 + 32) * 64 + pp]; float* aq = (float*)(p.ws + OFF_AQ) + ((((size_t)l * 2 + d) * 32 + g) * 64 + pp) * 2; aq[0] = a.x; aq[1] = a.y; }
#pragma unroll
    for (int it = 0; it < 4; ++it) { const int i = tid + it * NTHR;
        { const int d = i >> 10, pp = (i >> 4) & 63, h = i & 15; const size_t gi = ((((size_t)l * 2 + d) * 32 + g) * 64 + pp) * 16 + h;
          const float br = p.in[I_BRE][gi], bi = p.in[I_BIM][gi]; const f32x2 f = fz[d * 64 + pp]; bb[i] = (f32x2){f.x * br - f.y * bi, f.x * bi + f.y * br}; }
        { const int d = i >> 10, h = (i >> 6) & 15, pp = i & 63; const size_t gi = ((((size_t)l * 2 + d) * 32 + g) * 16 + h) * 64 + pp; cc[i] = (f32x2){p.in[I_CRE][gi], p.in[I_CIM][gi]}; }
    }
    __syncthreads();
    {
        const int hh = F.lane & 15, kg = F.lane >> 4;
        u32x4 bfr[2][4];
#pragma unroll
        for (int d = 0; d < 2; ++d)
#pragma unroll
            for (int ks = 0; ks < 4; ++ks) { unsigned w[4]; f32x2 bq[4];
#pragma unroll
                for (int jp = 0; jp < 4; ++jp) bq[jp] = bb[(d * 64 + 16 * ks + 4 * kg + jp) * 16 + hh];
#pragma unroll
                for (int jp = 0; jp < 4; ++jp) w[jp] = cvt_pk_bf16(bq[jp].x, bq[jp].y);
                bfr[d][ks] = (u32x4){w[0], w[1], w[2], w[3]}; }
        for (int tile = F.wave; tile < 64; tile += NWAVE) {
            const int d = tile >> 5, tau = tile & 31;
            f32x4 o = (f32x4){0.f, 0.f, 0.f, 0.f};
#pragma unroll
            for (int ks = 0; ks < 4; ++ks) { unsigned w[4];
                f32x2 cq[4], aq[4];
#pragma unroll
                for (int jp = 0; jp < 4; ++jp) { const int pp = 16 * ks + 4 * kg + jp; cq[jp] = cc[(d * 16 + hh) * 64 + pp]; aq[jp] = ap[(d * 33 + tau) * 64 + pp]; }
#pragma unroll
                for (int jp = 0; jp < 4; ++jp) { const f32x2 c = cq[jp], av = aq[jp];
                    w[jp] = cvt_pk_bf16(c.x * av.x - c.y * av.y, -(c.x * av.y + c.y * av.x)); }
                const u32x4 af = (u32x4){w[0], w[1], w[2], w[3]};
                o = __builtin_amdgcn_mfma_f32_16x16x32_bf16(__builtin_bit_cast(bf16x8, af), __builtin_bit_cast(bf16x8, d == 0 ? bfr[0][ks] : bfr[1][ks]), o, 0, 0, 0); }
#pragma unroll
            for (int r = 0; r < 4; ++r) kt[((d * 32 + tau) * 16 + 4 * kg + r) * 16 + hh] = o[r];
        }
    }
    __syncthreads();
    {
        bf16_t* WE = (bf16_t*)(p.ws + OFF_WE) + (size_t)g * 256 * 512;
        const int d = q >> 1, c = q & 1;
        for (int pc = tid; pc < 64 * 64; pc += NTHR) {
            const int pp = pc >> 6, col0 = (pc & 63) * 8, j = col0 >> 4, h0 = col0 & 15;
            const f32x2 a = ap[(d * 33 + (d == 0 ? 31 - j : j)) * 64 + pp];
            float v[8];
#pragma unroll
            for (int x = 0; x < 8; ++x) { const f32x2 b = bb[(d * 64 + pp) * 16 + h0 + x]; v[x] = c == 0 ? (a.x * b.x - a.y * b.y) : (a.x * b.y + a.y * b.x); }
            u32x4 o; o.x = cvt_pk_bf16(v[0], v[1]); o.y = cvt_pk_bf16(v[2], v[3]); o.z = cvt_pk_bf16(v[4], v[5]); o.w = cvt_pk_bf16(v[6], v[7]);
            *(u32x4*)(WE + (size_t)(64 * q + pp) * 512 + col0) = o;
        }
    }
    {
        bf16_t* TW = (bf16_t*)(p.ws + OFF_TW) + (size_t)g * 512 * 768;
        for (int pc = tid; pc < 128 * 96; pc += NTHR) {
            const int rl = pc / 96, cp = pc % 96, rr = 128 * q + rl, i = rr >> 4, h = rr & 15, col0 = cp * 8;
            float v[8];
            if (col0 < 512) {
                const int j = col0 >> 4, h0 = col0 & 15;
#pragma unroll
                for (int x = 0; x < 8; ++x) {
                    const int hp = h0 + x; float val;
                    if (i > j) val = kt[((0 * 32 + (i - j)) * 16 + h) * 16 + hp];
                    else if (i < j) val = kt[((1 * 32 + (j - i)) * 16 + h) * 16 + hp];
                    else val = kt[((0 * 32 + 0) * 16 + h) * 16 + hp] + kt[((1 * 32 + 0) * 16 + h) * 16 + hp] + (h == hp ? dvs[h] : 0.f);
                    v[x] = val;
                }
            } else {
                const int n0 = col0 - 512, d = n0 >> 7, c = (n0 >> 6) & 1, p0 = n0 & 63, tau = d == 0 ? i + 1 : 32 - i;
#pragma unroll
                for (int x = 0; x < 8; ++x) { const f32x2 cv = cc[(d * 16 + h) * 64 + p0 + x], a = ap[(d * 33 + tau) * 64 + p0 + x];
                    v[x] = c == 0 ? (cv.x * a.x - cv.y * a.y) : -(cv.x * a.y + cv.y * a.x); }
            }
            u32x4 o; o.x = cvt_pk_bf16(v[0], v[1]); o.y = cvt_pk_bf16(v[2], v[3]); o.z = cvt_pk_bf16(v[4], v[5]); o.w = cvt_pk_bf16(v[6], v[7]);
            *(u32x4*)(TW + (size_t)rr * 768 + col0) = o;
        }
    }
    __syncthreads();
}

__device__ __forceinline__ bf16_t* hrow_ptr(const Params& p, int r) { return (bf16_t*)(p.ws + OFF_HB) + (size_t)r * D; }
__device__ __forceinline__ f32x4 bf4(const u32x2 w) { return (f32x4){bf_lo(w.x), bf_hi(w.x), bf_lo(w.y), bf_hi(w.y)}; }
__device__ __forceinline__ int mod_index(int r) { return r < TLAT ? (r >> 11) : 16; }

__device__ __forceinline__ void phase_norm1(const Params& p, const Frame& F, int l, bool dry = false) {
    const float* mod = (const float*)(p.ws + OFF_MOD);
    signed char* Xq = (signed char*)(p.ws + (dry ? 422 * MiB : OFF_XN)); float* sxa = (float*)(p.ws + (dry ? 460 * MiB : OFF_SXA));
    const bf16_t* Y = (const bf16_t*)(p.ws + OFF_Y);
    const int* pos = (const int*)(p.ws + OFF_POS);
    const int lane = F.lane, row0 = F.blk * 144 + F.wave * 18;
    int mypos = 0; if (l == 1 && lane < 36) mypos = pos[2 * row0 + lane];
    f32x4 ch[4], mg[4], ms[4], m2[4]; u32x2 ca[4], cb[4]; int cmi = -1;
#define N1_LOAD(rr, H, A, B) do { const int r_ = (rr); \
        if (l == 0) { const float* src_ = (r_ < TLAT) ? (p.in[I_X] + (size_t)r_ * D) : (p.in[I_CTX] + (size_t)(r_ - TLAT) * D); \
            _Pragma("unroll") for (int j = 0; j < 4; ++j) { H[j] = *(const f32x4*)(src_ + 4 * lane + 256 * j); A[j] = (u32x2){0u, 0u}; B[j] = (u32x2){0u, 0u}; } } \
        else { const bf16_t* hp_ = hrow_ptr(p, r_); const int q_ = 2 * (r_ - row0); \
            const bf16_t* y0_ = Y + (size_t)__builtin_amdgcn_readlane(mypos, q_) * D; const bf16_t* y1_ = Y + (size_t)__builtin_amdgcn_readlane(mypos, q_ + 1) * D; \
            _Pragma("unroll") for (int jj = 0; jj < 2; ++jj) { const int k_ = 8 * lane + 512 * jj; const u32x4 h_ = *(const u32x4*)(hp_ + k_), a_ = *(const u32x4*)(y0_ + k_), b_ = *(const u32x4*)(y1_ + k_); \
                H[2 * jj] = bf4((u32x2){h_.x, h_.y}); H[2 * jj + 1] = bf4((u32x2){h_.z, h_.w}); A[2 * jj] = (u32x2){a_.x, a_.y}; A[2 * jj + 1] = (u32x2){a_.z, a_.w}; B[2 * jj] = (u32x2){b_.x, b_.y}; B[2 * jj + 1] = (u32x2){b_.z, b_.w}; } } } while (0)
#define N1_K(j) (l == 0 ? 4 * lane + 256 * (j) : 8 * lane + 512 * ((j) >> 1) + 4 * ((j) & 1))
    N1_LOAD(row0, ch, ca, cb);
    for (int i = 0; i < 18; ++i) {
        const int r = row0 + i, mi = mod_index(r);
        f32x4 nh[4]; u32x2 na[4], nb[4];
        if (i + 1 < 18) N1_LOAD(r + 1, nh, na, nb);
        f32x4 v[4];
        if (mi != cmi) { cmi = mi; const float* gn = p.in[I_N1G] + l * D; const float* sh = mod + ((size_t)l * 17 + mi) * 6144; const float* sc = sh + 1024;
            const float* g2 = mod + ((size_t)(l > 0 ? l - 1 : 0) * 17 + mi) * 6144 + 5120;
#pragma unroll
            for (int j = 0; j < 4; ++j) { const int k = N1_K(j); mg[j] = *(const f32x4*)(gn + k) * (1.0f + *(const f32x4*)(sc + k)); ms[j] = *(const f32x4*)(sh + k); m2[j] = *(const f32x4*)(g2 + k); } }
        if (l == 0) {
#pragma unroll
            for (int j = 0; j < 4; ++j) v[j] = ch[j];
        } else {
            bf16_t* hp = dry ? (bf16_t*)(p.ws + 350 * MiB) + (size_t)r * D : hrow_ptr(p, r);
#pragma unroll
            for (int j = 0; j < 4; ++j) {
                const f32x4 gg = m2[j]; const u32x2 a = ca[j], b = cb[j];
                const f32x4 sm = (f32x4){bf_lo(a.x) + bf_lo(b.x), bf_hi(a.x) + bf_hi(b.x), bf_lo(a.y) + bf_lo(b.y), bf_hi(a.y) + bf_hi(b.y)};
                v[j] = ch[j] + gg * sm;
            }
#pragma unroll
            for (int jj = 0; jj < 2; ++jj) *(u32x4*)(hp + 8 * lane + 512 * jj) = pack8(v[2 * jj], v[2 * jj + 1]);
        }
        float ss = 0.f;
#pragma unroll
        for (int j = 0; j < 4; ++j) ss += (v[j][0] * v[j][0] + v[j][1] * v[j][1]) + (v[j][2] * v[j][2] + v[j][3] * v[j][3]);
        const float rs = __builtin_amdgcn_rsqf(wave_sum(ss) * (1.0f / D) + EPS);
        float am = 0.f;
#pragma unroll
        for (int j = 0; j < 4; ++j) { v[j] = v[j] * rs * mg[j] + ms[j]; am = fmaxf(am, fmaxf(fmaxf(fabsf(v[j][0]), fabsf(v[j][1])), fmaxf(fabsf(v[j][2]), fabsf(v[j][3])))); }
        am = fmaxf(wave_max(am), 1e-30f);
        const float inv = 127.0f * __builtin_amdgcn_rcpf(am);
#pragma unroll
        for (int jj = 0; jj < 2; ++jj) { const unsigned q0 = q8x4(v[2 * jj], inv), q1 = q8x4(v[2 * jj + 1], inv);
            if (l == 0) { *(unsigned*)(Xq + (size_t)r * D + 4 * lane + 512 * jj) = q0; *(unsigned*)(Xq + (size_t)r * D + 4 * lane + 512 * jj + 256) = q1; }
            else *(u32x2*)(Xq + (size_t)r * D + 8 * lane + 512 * jj) = (u32x2){q0, q1}; }
        if (lane == 0) sxa[r] = am * (1.0f / 127.0f);
#pragma unroll
        for (int j = 0; j < 4; ++j) { ch[j] = nh[j]; ca[j] = na[j]; cb[j] = nb[j]; }
    }
#undef N1_LOAD
#undef N1_K
}

__device__ __forceinline__ void phase_final(const Params& p, const Frame& F) {
    const float* mod = (const float*)(p.ws + OFF_MOD);
    const bf16_t* Y = (const bf16_t*)(p.ws + OFF_Y);
    const int* pos = (const int*)(p.ws + OFF_POS);
    const int lane = F.lane, row0 = F.blk * 128 + F.wave * 16;
    int mypos = 0; if (lane < 32) mypos = pos[2 * row0 + lane];
    f32x4 ch[4], m2[4], fg[4]; u32x2 ca[4], cb[4]; int cmi = -1;
#pragma unroll
    for (int j = 0; j < 4; ++j) fg[j] = *(const f32x4*)(p.in[I_FNG] + 4 * lane + 256 * j);
#define FN_LOAD(rr, H, A, B) do { const int r_ = (rr); const bf16_t* hp_ = hrow_ptr(p, r_); const int q_ = 2 * (r_ - row0); \
        const bf16_t* y0_ = Y + (size_t)__builtin_amdgcn_readlane(mypos, q_) * D; const bf16_t* y1_ = Y + (size_t)__builtin_amdgcn_readlane(mypos, q_ + 1) * D; \
        _Pragma("unroll") for (int j = 0; j < 4; ++j) { const int k_ = 4 * lane + 256 * j; H[j] = bf4(*(const u32x2*)(hp_ + k_)); A[j] = *(const u32x2*)(y0_ + k_); B[j] = *(const u32x2*)(y1_ + k_); } } while (0)
    FN_LOAD(row0, ch, ca, cb);
    for (int i = 0; i < 16; ++i) {
        const int r = row0 + i, mi = r >> 11;
        f32x4 nh[4]; u32x2 na[4], nb[4];
        if (i + 1 < 16) FN_LOAD(r + 1, nh, na, nb);
        float* hp = p.out + (size_t)r * D;
        if (mi != cmi) { cmi = mi; const float* g2 = mod + ((size_t)1 * 17 + mi) * 6144 + 5120;
#pragma unroll
            for (int j = 0; j < 4; ++j) m2[j] = *(const f32x4*)(g2 + 4 * lane + 256 * j); }
        f32x4 v[4]; float ss = 0.f;
#pragma unroll
        for (int j = 0; j < 4; ++j) {
            const int k = 4 * lane + 256 * j; const f32x4 gg = m2[j]; const u32x2 a = ca[j], b = cb[j];
            const f32x4 sm = (f32x4){bf_lo(a.x) + bf_lo(b.x), bf_hi(a.x) + bf_hi(b.x), bf_lo(a.y) + bf_lo(b.y), bf_hi(a.y) + bf_hi(b.y)};
            v[j] = ch[j] + gg * sm;
            ss += (v[j][0] * v[j][0] + v[j][1] * v[j][1]) + (v[j][2] * v[j][2] + v[j][3] * v[j][3]);
        }
        const float rs = __builtin_amdgcn_rsqf(wave_sum(ss) * (1.0f / D) + EPS);
#pragma unroll
        for (int j = 0; j < 4; ++j) { const int k = 4 * lane + 256 * j; *(f32x4*)(hp + k) = v[j] * rs * fg[j]; }
#pragma unroll
        for (int j = 0; j < 4; ++j) { ch[j] = nh[j]; ca[j] = na[j]; cb[j] = nb[j]; }
    }
#undef FN_LOAD
}

#define EPI_FENCE() asm volatile("" ::: "memory")
#define OPAQUE_S(x) asm volatile("" : "+s"(x))
struct SchedB {
    const char* Xn; const char* W; int l, c;
    __device__ __forceinline__ bool next(int i, gs::Unit& u) const {
        const int L = i * NBLK + c, nmain = (l == 0 ? 144 : 128) * 24, ntot = nmain + (l == 0 ? 0 : 32);
        if (L >= ntot) return false;
        int pm, pn;
        if (L < nmain) { gs::tile_order(gs::xcd_remap(L, nmain), l == 0 ? 144 : 128, 24, pm, pn); }
        else { const int x = L - nmain; pm = 128 + (x >> 1); pn = 10 + (x & 1); }
        u.pm = pm; u.pn = pn; u.kind = 0; u.aux = 0;
        return true;
    }
    __device__ __forceinline__ void ops(const gs::Unit& u, gs::Ops& o) const { o.A = Xn + (size_t)u.pm * 256 * 1024; o.B = W + (size_t)u.pn * 256 * 1024; o.lda = 1024; o.ldb = 1024; o.nt = 8; o.rows = nullptr; }
};
struct EpiB {
    static constexpr bool KEEPS = false, I8 = true;
    bf16_t *U, *V, *Bb, *P, *Ux; unsigned char* G8; const float* sxa; const float* swin;
    __device__ __forceinline__ void operator()(const f32x4 (&acc)[2][2][4][2], const gs::Unit& u, int wr, int wc, int fr, int fq) const {
        const int pn = u.pn, r0 = u.pm * 256 + wr * 64 + fr, c0 = wc * 32 + 8 * fq;
        f32x4 sw[2][2]; float sx[2][4];
#pragma unroll
        for (int bj = 0; bj < 2; ++bj) { sw[bj][0] = *(const f32x4*)(swin + pn * 256 + bj * 128 + c0); sw[bj][1] = *(const f32x4*)(swin + pn * 256 + bj * 128 + c0 + 4); }
#pragma unroll
        for (int ai = 0; ai < 2; ++ai)
#pragma unroll
            for (int m = 0; m < 4; ++m) sx[ai][m] = sxa[r0 + ai * 128 + m * 16];
#define DQ(ai, bj, m, n) (__builtin_convertvector(__builtin_bit_cast(i32x4, acc[ai][bj][m][n]), f32x4) * (sw[bj][n] * sx[ai][m]))
        if (pn < 6) {
            size_t z1 = 0, z2 = 0, z3 = 0; OPAQUE_S(z1); OPAQUE_S(z2); OPAQUE_S(z3); bf16_t *u_ = U + z1, *v_ = V + z2, *b_ = Bb + z3;
            bf16_t* O = pn < 2 ? u_ : (pn < 4 ? v_ : b_); const bool act = pn < 4; const int cb = (pn & 1) * 256 + c0;
#pragma unroll
            for (int ai = 0; ai < 2; ++ai)
#pragma unroll
                for (int m = 0; m < 4; ++m) { bf16_t* rowp = O + (size_t)(r0 + ai * 128 + m * 16) * 512 + cb;
#pragma unroll
                    for (int bj = 0; bj < 2; ++bj) { f32x4 v0 = DQ(ai, bj, m, 0), v1 = DQ(ai, bj, m, 1);
                        if (act) { v0 = gelu4(v0); v1 = gelu4(v1); }
                        *(u32x4*)(rowp + bj * 128) = pack8(v0, v1); }
                    EPI_FENCE(); }
        } else if (pn < 10) {
            const int cb = (pn - 6) * 128 + c0;
#pragma unroll
            for (int ai = 0; ai < 2; ++ai)
#pragma unroll
                for (int m = 0; m < 4; ++m) {
                    *(u32x4*)(P + (size_t)(r0 + ai * 128 + m * 16) * 512 + cb) = pack8(DQ(ai, 0, m, 0) * DQ(ai, 1, m, 0), DQ(ai, 0, m, 1) * DQ(ai, 1, m, 1));
                    EPI_FENCE(); }
        } else if (pn >= 12) {
            const int cb = (pn - 12) * 256 + wc * 64 + fq * 16;
#pragma unroll
            for (int ai = 0; ai < 2; ++ai)
#pragma unroll
                for (int m = 0; m < 4; ++m) { unsigned char* rowp = G8 + (size_t)(r0 + ai * 128 + m * 16) * 3072 + cb; unsigned wq[2][2];
#pragma unroll
                    for (int bj = 0; bj < 2; ++bj)
#pragma unroll
                        for (int n = 0; n < 2; ++n) wq[bj][n] = gate4_u8_t(__builtin_convertvector(__builtin_bit_cast(i32x4, acc[ai][bj][m][n]), f32x4) * (sw[bj][n] * (sx[ai][m] * -1.44269504089f)) + (-8.0f));
                    *(u32x4*)rowp = (u32x4){wq[0][0], wq[0][1], wq[1][0], wq[1][1]};
                    EPI_FENCE(); }
        } else {
#pragma unroll
            for (int ai = 0; ai < 2; ++ai)
#pragma unroll
                for (int m = 0; m < 4; ++m) { const int r = r0 + ai * 128 + m * 16, ch = r >> 5, ii = r & 31;
#pragma unroll
                    for (int bj = 0; bj < 2; ++bj) { const int cch = (pn - 10) * 256 + bj * 128 + c0, g = cch >> 4, h0 = cch & 15;
                        *(u32x4*)(Ux + ((size_t)g * NCHP + ch) * 768 + ii * 16 + h0) = pack8(DQ(ai, bj, m, 0), DQ(ai, bj, m, 1)); }
                    EPI_FENCE(); }
        }
#undef DQ
    }
};
struct SchedE {
    const char* Ux; const char* WE; int c;
    __device__ __forceinline__ bool next(int i, gs::Unit& u) const {
        const int L = i * NBLK + c; if (L >= 160) return false;
        u.pm = L % 5; u.pn = 0; u.kind = 0; u.aux = L / 5;
        return true;
    }
    __device__ __forceinline__ void ops(const gs::Unit& u, gs::Ops& o) const { o.A = Ux + ((size_t)u.aux * NCHP + u.pm * 256) * 1536; o.B = WE + (size_t)u.aux * 256 * 1024; o.lda = 1536; o.ldb = 1024; o.nt = 8; o.rows = nullptr; }
};
struct EpiE {
    static constexpr bool KEEPS = false, I8 = false;
    float* E;
    __device__ __forceinline__ void operator()(const f32x4 (&acc)[2][2][4][2], const gs::Unit& u, int wr, int wc, int fr, int fq) const {
        const int g = u.aux, m0 = u.pm * 256 + wr * 64 + fr, c0 = wc * 32 + 8 * fq;
#pragma unroll
        for (int ai = 0; ai < 2; ++ai)
#pragma unroll
            for (int m = 0; m < 4; ++m) { const int mm = m0 + ai * 128 + m * 16;
                if (mm < NCH) { float* rowp = E + ((size_t)g * NCH + mm) * 256 + c0;
#pragma unroll
                    for (int bj = 0; bj < 2; ++bj) { *(f32x4*)(rowp + bj * 128) = acc[ai][bj][m][0]; *(f32x4*)(rowp + bj * 128 + 4) = acc[ai][bj][m][1]; } }
                EPI_FENCE(); }
    }
};
struct SchedY {
    const char* Ux; const char* TW; int l, c;
    __device__ __forceinline__ bool next(int i, gs::Unit& u) const {
        const int npm = l == 0 ? 5 : 4, ntot = 32 * npm * 2, L = i * NBLK + c; if (L >= ntot) return false;
        const int g = L / (npm * 2), rem = L % (npm * 2);
        u.pm = rem >> 1; u.pn = rem & 1; u.kind = 0; u.aux = g;
        return true;
    }
    __device__ __forceinline__ void ops(const gs::Unit& u, gs::Ops& o) const { o.A = Ux + ((size_t)u.aux * NCHP + u.pm * 256) * 1536; o.B = TW + ((size_t)u.aux * 512 + u.pn * 256) * 1536; o.lda = 1536; o.ldb = 1536; o.nt = 12; o.rows = nullptr; }
};
struct EpiY {
    static constexpr bool KEEPS = false, I8 = false;
    bf16_t* Z;
    __device__ __forceinline__ void operator()(const f32x4 (&acc)[2][2][4][2], const gs::Unit& u, int wr, int wc, int fr, int fq) const {
        const int g = u.aux, m0 = u.pm * 256 + wr * 64 + fr, c0 = u.pn * 256 + wc * 32 + 8 * fq;
#pragma unroll
        for (int ai = 0; ai < 2; ++ai)
#pragma unroll
            for (int m = 0; m < 4; ++m) { const int mm = m0 + ai * 128 + m * 16;
                if (mm < NCH) {
#pragma unroll
                    for (int bj = 0; bj < 2; ++bj) { const int cn = c0 + bj * 128, ii = cn >> 4, h0 = cn & 15; const f32x4 v0 = gelu4(acc[ai][bj][m][0]), v1 = gelu4(acc[ai][bj][m][1]);
                        *(u32x4*)(Z + ((size_t)mm * 32 + ii) * 512 + g * 16 + h0) = pack8(v0, v1); } }
                EPI_FENCE(); }
    }
};
struct SchedF {
    const char* Z; const char* W; int l, c;
    __device__ __forceinline__ bool next(int i, gs::Unit& u) const {
        const int nM = l == 0 ? 144 : 128, ntot = nM * 2, L = i * NBLK + c; if (L >= ntot) return false;
        int pm, pn; gs::tile_order(gs::xcd_remap(L, ntot), nM, 2, pm, pn);
        u.pm = pm; u.pn = pn; u.kind = 0; u.aux = 0;
        return true;
    }
    __device__ __forceinline__ void ops(const gs::Unit& u, gs::Ops& o) const { o.A = Z + (size_t)u.pm * 256 * 1024; o.B = W + (size_t)u.pn * 256 * 1024; o.lda = 1024; o.ldb = 1024; o.nt = 8; o.rows = nullptr; }
};
struct EpiF {
    static constexpr bool KEEPS = false, I8 = false;
    const bf16_t* Z; bf16_t* Yc; const float* gb;
    __device__ __forceinline__ void operator()(const f32x4 (&acc)[2][2][4][2], const gs::Unit& u, int wr, int wc, int fr, int fq) const {
        const int r0 = u.pm * 256 + wr * 64 + fr, c0 = u.pn * 256 + wc * 32 + 8 * fq;
        f32x4 gbv[2][2];
#pragma unroll
        for (int bj = 0; bj < 2; ++bj) { gbv[bj][0] = *(const f32x4*)(gb + c0 + bj * 128); gbv[bj][1] = *(const f32x4*)(gb + c0 + bj * 128 + 4); }
#pragma unroll
        for (int ai = 0; ai < 2; ++ai)
#pragma unroll
            for (int mh = 0; mh < 2; ++mh) {
                u32x4 zw[4];
#pragma unroll
                for (int x = 0; x < 4; ++x) zw[x] = *(const u32x4*)(Z + (size_t)(r0 + ai * 128 + (mh * 2 + (x >> 1)) * 16) * 512 + c0 + (x & 1) * 128);
#pragma unroll
                for (int x = 0; x < 4; ++x) { const int m = mh * 2 + (x >> 1), bj = x & 1; const size_t ro = (size_t)(r0 + ai * 128 + m * 16) * 512 + c0;
                    f32x4 z0, z1; unpack8(zw[x], z0, z1);
                    f32x4 v0 = acc[ai][bj][m][0] + gbv[bj][0], v1 = acc[ai][bj][m][1] + gbv[bj][1];
#pragma unroll
                    for (int j = 0; j < 4; ++j) { v0[j] = z0[j] * sigmoidf_(v0[j]); v1[j] = z1[j] * sigmoidf_(v1[j]); }
                    *(u32x4*)(Yc + ro + bj * 128) = pack8(v0, v1); }
                EPI_FENCE(); }
    }
};
struct SchedG {
    const char* Y0; const char* Y1; const char* Y2; const char* Wbr; int l, c;
    __device__ __forceinline__ bool next(int i, gs::Unit& u) const {
        const int nM = l == 0 ? 144 : 128, ntile = nM * 4, tl = i / 3, s = i % 3, L = tl * NBLK + c; if (L >= ntile) return false;
        int pm, pn; gs::tile_order(gs::xcd_remap(L, ntile), nM, 4, pm, pn);
        u.pm = pm; u.pn = pn; u.kind = s; u.aux = 0;
        return true;
    }
    __device__ __forceinline__ void ops(const gs::Unit& u, gs::Ops& o) const {
        const int br = u.kind;
        size_t z1 = 0, z2 = 0, z3 = 0; OPAQUE_S(z1); OPAQUE_S(z2); OPAQUE_S(z3); const char *y0_ = Y0 + z1, *y1_ = Y1 + z2, *y2_ = Y2 + z3; const char* y = br == 0 ? y0_ : (br == 1 ? y1_ : y2_);
        o.A = y + (size_t)u.pm * 256 * 1024; o.B = Wbr + ((size_t)br * 1024 + u.pn * 256) * 1024; o.lda = 1024; o.ldb = 1024; o.nt = 8; o.rows = nullptr;
    }
};
__device__ __forceinline__ void u8x8_to_f32(const u32x2 w, f32x4& a, f32x4& b) {
    a = (f32x4){(float)(w.x & 255u), (float)((w.x >> 8) & 255u), (float)((w.x >> 16) & 255u), (float)(w.x >> 24)};
    b = (f32x4){(float)(w.y & 255u), (float)((w.y >> 8) & 255u), (float)((w.y >> 16) & 255u), (float)(w.y >> 24)};
    a = a + 0.5f; b = b + 0.5f;
}
struct EpiG {
    static constexpr bool KEEPS = true, I8 = false;
    const unsigned char* G8; bf16_t* merged;
    __device__ __forceinline__ bool scale(f32x4 (&acc)[2][2][4][2], const gs::Unit& u, int wr, int wc, int fr, int fq) const {
        const int s = u.kind, r0 = u.pm * 256 + wr * 64 + fr, c0 = u.pn * 256 + wc * 32 + 8 * fq;
        const unsigned char* gp = G8 + (size_t)r0 * 3072 + s * 1024 + u.pn * 256 + wc * 64 + fq * 16;
#pragma unroll
        for (int ai = 0; ai < 2; ++ai) {
            u32x4 ga4[4], gb4[4];
#pragma unroll
            for (int m = 0; m < 4; ++m) { const size_t o = (size_t)(ai * 128 + m * 16) * 3072; ga4[m] = *(const u32x4*)(gp + o); if (s < 2) gb4[m] = *(const u32x4*)(gp + o + 1024); }
#pragma unroll
            for (int x = 0; x < 8; ++x) { const int m = x >> 1, bj = x & 1;
                const u32x2 gax = bj == 0 ? (u32x2){ga4[m].x, ga4[m].y} : (u32x2){ga4[m].z, ga4[m].w};
                f32x4 n0, n1; u8x8_to_f32(gax, n0, n1);
                if (s < 2) { const u32x2 gbx = bj == 0 ? (u32x2){gb4[m].x, gb4[m].y} : (u32x2){gb4[m].z, gb4[m].w}; f32x4 d0, d1; u8x8_to_f32(gbx, d0, d1);
#pragma unroll
                    for (int j = 0; j < 4; ++j) { n0[j] *= __builtin_amdgcn_rcpf(d0[j]); n1[j] *= __builtin_amdgcn_rcpf(d1[j]); } }
                if (s == 2) { n0 = n0 * (1.0f / 256.0f); n1 = n1 * (1.0f / 256.0f); }
                acc[ai][bj][m][0] *= n0; acc[ai][bj][m][1] *= n1;
                if (s == 2) *(u32x4*)(merged + (size_t)(r0 + ai * 128 + m * 16) * 1024 + c0 + bj * 128) = pack8(acc[ai][bj][m][0], acc[ai][bj][m][1]); }
            EPI_FENCE(); }
        return s < 2;
    }
};
struct SchedH {
    const char* A; const char* W; int l, c;
    __device__ __forceinline__ bool next(int i, gs::Unit& u) const {
        const int nM = l == 0 ? 144 : 128, ntot = nM * 4, L = i * NBLK + c; if (L >= ntot) return false;
        int pm, pn; gs::tile_order(gs::xcd_remap(L, ntot), nM, 4, pm, pn);
        u.pm = pm; u.pn = pn; u.kind = 0; u.aux = 0;
        return true;
    }
    __device__ __forceinline__ void ops(const gs::Unit& u, gs::Ops& o) const { o.A = A + (size_t)u.pm * 256 * 2048; o.B = W + (size_t)u.pn * 256 * 2048; o.lda = 2048; o.ldb = 2048; o.nt = 16; o.rows = nullptr; }
};
template <int LZ> struct EpiH {
    static constexpr bool KEEPS = false, I8 = false;
    const float* xin; const float* cin; bf16_t* Hb; const float* mod;
    __device__ __forceinline__ void operator()(const f32x4 (&acc)[2][2][4][2], const gs::Unit& u, int wr, int wc, int fr, int fq) const {
        const int rt = u.pm * 256, c0 = u.pn * 256 + wc * 32 + 8 * fq;
        const bool lat = rt < TLAT; const int mi = lat ? (rt >> 11) : 16;
        size_t z1 = 0, z2 = 0; OPAQUE_S(z1); OPAQUE_S(z2);
        const float* base = lat ? (xin + z1 + (size_t)rt * D) : (cin + z2 + (size_t)(rt - TLAT) * D);
        bf16_t* hb = Hb + (size_t)rt * D;
        const float* g1 = mod + (size_t)mi * 6144 + 2048 + c0;
        f32x4 g1v[2][2];
#pragma unroll
        for (int bj = 0; bj < 2; ++bj) { g1v[bj][0] = *(const f32x4*)(g1 + bj * 128); g1v[bj][1] = *(const f32x4*)(g1 + bj * 128 + 4); }
#pragma unroll
        for (int ai = 0; ai < 2; ++ai)
#pragma unroll
            for (int m = 0; m < 4; ++m) {
                f32x4 hv[2][2]; const size_t rb_ = (size_t)(wr * 64 + fr + ai * 128 + m * 16) * D + c0;
#pragma unroll
                for (int bj = 0; bj < 2; ++bj) { const size_t ro = rb_ + bj * 128;
                    if constexpr (LZ == 1) { hv[bj][0] = *(const f32x4*)(base + ro); hv[bj][1] = *(const f32x4*)(base + ro + 4); }
                    else unpack8(*(const u32x4*)(hb + ro), hv[bj][0], hv[bj][1]); }
#pragma unroll
                for (int bj = 0; bj < 2; ++bj) { const size_t ro = rb_ + bj * 128;
                    *(u32x4*)(hb + ro) = pack8(hv[bj][0] + g1v[bj][0] * acc[ai][bj][m][0], hv[bj][1] + g1v[bj][1] * acc[ai][bj][m][1]); }
                EPI_FENCE(); }
    }
};
struct SchedK {
    const char* Xn2; const char* Wgu; const int* rowl; const LAS int* toff; int c;
    __device__ __forceinline__ bool next(int i, gs::Unit& u) const {
        const int nt_ = __builtin_amdgcn_readfirstlane(toff[16]), ntot = nt_ * 4, L = i * NBLK + c; if (L >= ntot) return false;
        const int w = gs::xcd_remap(L, ntot), mt = w >> 2; int e = 0;
        { const int ln = (int)__builtin_amdgcn_mbcnt_hi(~0u, __builtin_amdgcn_mbcnt_lo(~0u, 0u)), tv = toff[ln < 16 ? ln : 16];
          e = __builtin_popcountll(__ballot(ln >= 1 && ln < 16 && tv <= mt)); }
        u.pm = mt; u.pn = w & 3; u.kind = 0; u.aux = e;
        return true;
    }
    __device__ __forceinline__ void ops(const gs::Unit& u, gs::Ops& o) const { o.A = Xn2; o.B = Wgu + ((size_t)u.aux * 1024 + u.pn * 256) * 1024; o.lda = 1024; o.ldb = 1024; o.nt = 8; o.rows = rowl + u.pm * 256; }
};
struct EpiK {
    static constexpr bool KEEPS = false, I8 = true;
    bf16_t* He; const float* sxs; const float* swgu;
    __device__ __forceinline__ void operator()(const f32x4 (&acc)[2][2][4][2], const gs::Unit& u, int wr, int wc, int fr, int fq) const {
        const int r0 = u.pm * 256 + wr * 64 + fr, c0 = u.pn * 128 + wc * 32 + 8 * fq, t0 = u.aux * 1024 + u.pn * 256 + wc * 32 + 8 * fq;
        f32x4 sw[2][2]; float sx[2][4];
#pragma unroll
        for (int bj = 0; bj < 2; ++bj) { sw[bj][0] = *(const f32x4*)(swgu + t0 + bj * 128); sw[bj][1] = *(const f32x4*)(swgu + t0 + bj * 128 + 4); }
#pragma unroll
        for (int ai = 0; ai < 2; ++ai)
#pragma unroll
            for (int m = 0; m < 4; ++m) sx[ai][m] = sxs[r0 + ai * 128 + m * 16];
#define DQ(ai, bj, m, n) (__builtin_convertvector(__builtin_bit_cast(i32x4, acc[ai][bj][m][n]), f32x4) * (sw[bj][n] * sx[ai][m]))
#pragma unroll
        for (int ai = 0; ai < 2; ++ai)
#pragma unroll
            for (int m = 0; m < 4; ++m) { f32x4 v0 = DQ(ai, 0, m, 0), v1 = DQ(ai, 0, m, 1); const f32x4 u0 = DQ(ai, 1, m, 0), u1 = DQ(ai, 1, m, 1);
#pragma unroll
                for (int j = 0; j < 4; ++j) { v0[j] = siluf_(v0[j]) * u0[j]; v1[j] = siluf_(v1[j]) * u1[j]; }
                *(u32x4*)(He + (size_t)(r0 + ai * 128 + m * 16) * 512 + c0) = pack8(v0, v1);
                EPI_FENCE(); }
#undef DQ
    }
};
struct SchedL {
    const char* He; const char* Wd; const LAS int* toff; int c;
    __device__ __forceinline__ bool next(int i, gs::Unit& u) const {
        const int nt_ = __builtin_amdgcn_readfirstlane(toff[16]), ntot = nt_ * 4, L = i * NBLK + c; if (L >= ntot) return false;
        const int w = gs::xcd_remap(L, ntot), mt = w >> 2; int e = 0;
        { const int ln = (int)__builtin_amdgcn_mbcnt_hi(~0u, __builtin_amdgcn_mbcnt_lo(~0u, 0u)), tv = toff[ln < 16 ? ln : 16];
          e = __builtin_popcountll(__ballot(ln >= 1 && ln < 16 && tv <= mt)); }
        u.pm = mt; u.pn = w & 3; u.kind = 0; u.aux = e;
        return true;
    }
    __device__ __forceinline__ void ops(const gs::Unit& u, gs::Ops& o) const { o.A = He + (size_t)u.pm * 256 * 1024; o.B = Wd + ((size_t)u.aux * 1024 + u.pn * 256) * 1024; o.lda = 1024; o.ldb = 1024; o.nt = 8; o.rows = nullptr; }
};
struct EpiL {
    static constexpr bool KEEPS = false, I8 = false;
    bf16_t* Y; const float* wl;
    __device__ __forceinline__ void operator()(const f32x4 (&acc)[2][2][4][2], const gs::Unit& u, int wr, int wc, int fr, int fq) const {
        const int r0 = u.pm * 256 + wr * 64 + fr, c0 = u.pn * 256 + wc * 32 + 8 * fq;
        float wv[2][4];
#pragma unroll
        for (int ai = 0; ai < 2; ++ai)
#pragma unroll
            for (int m = 0; m < 4; ++m) wv[ai][m] = wl[r0 + ai * 128 + m * 16];
#pragma unroll
        for (int ai = 0; ai < 2; ++ai)
#pragma unroll
            for (int m = 0; m < 4; ++m) { const int r = r0 + ai * 128 + m * 16; const float w = wv[ai][m];
#pragma unroll
                for (int bj = 0; bj < 2; ++bj) *(u32x4*)(Y + (size_t)r * 1024 + c0 + bj * 128) = pack8(acc[ai][bj][m][0] * w, acc[ai][bj][m][1] * w);
                EPI_FENCE(); }
    }
};

__device__ __forceinline__ void phase_sgu(const Params& p, const Frame& F, int l) {
    bf16_t* U = (bf16_t*)(p.ws + OFF_U); const bf16_t* V = (const bf16_t*)(p.ws + OFF_V);
    const bf16_t* W16 = (const bf16_t*)(p.ws + OFF_SGUW16) + (size_t)l * 4 * 128 * 128;
    LAS float* mu = (LAS float*)F.lds; LAS float* rsd = mu + 128;
    LAS unsigned char* Vn = F.lds + 1024;
    LAS unsigned char* Wl = F.lds + 1024 + 128 * 264;
    const int nchunk = l == 0 ? 288 : 256, tid = F.tid, lane = F.lane, wave = F.wave;
    const float* gam = p.in[I_SGUNG] + l * 512;
    const int vk = tid >> 2, vpart = tid & 3;
    for (int un = 0; un < 2; ++un) {
        int cu, hd0, hd1;
        if (un == 0) { cu = F.blk; hd0 = 0; hd1 = 4; if (cu >= nchunk) continue; }
        else { const int x = F.blk - 128; if (x < 0 || 256 + (x >> 2) >= nchunk) continue; cu = 256 + (x >> 2); hd0 = x & 3; hd1 = hd0 + 1; }
        const int r0 = cu * 128;
        __syncthreads();
        {
            u32x4 w16[16];
#pragma unroll
            for (int x = 0; x < 16; ++x) w16[x] = *(const u32x4*)(V + (size_t)(r0 + wave * 16 + x) * 512 + lane * 8);
#pragma unroll
            for (int x = 0; x < 16; ++x) { const int k = wave * 16 + x; f32x4 a, b; unpack8(w16[x], a, b);
                const float sm = wave_sum((a[0] + a[1]) + (a[2] + a[3]) + (b[0] + b[1]) + (b[2] + b[3])), mean = sm * (1.0f / 512.0f);
                a = a - mean; b = b - mean;
                const float q = wave_sum((a[0] * a[0] + a[1] * a[1]) + (a[2] * a[2] + a[3] * a[3]) + (b[0] * b[0] + b[1] * b[1]) + (b[2] * b[2] + b[3] * b[3]));
                if (lane == 0) { mu[k] = mean; rsd[k] = 1.0f / sqrtf(q * (1.0f / 512.0f) + EPS); } }
        }
        u32x4 pv[4], pw[4]; f32x4 pg[4][2];
#define SGU_PREFETCH(hd_) do { _Pragma("unroll") for (int x = 0; x < 4; ++x) { pv[x] = *(const u32x4*)(V + (size_t)(r0 + vk) * 512 + (hd_) * 128 + vpart * 32 + x * 8); \
            pw[x] = *(const u32x4*)(W16 + (size_t)(hd_) * 16384 + (tid + x * 512) * 8); \
            pg[x][0] = *(const f32x4*)(gam + (hd_) * 128 + vpart * 32 + x * 8); pg[x][1] = *(const f32x4*)(gam + (hd_) * 128 + vpart * 32 + x * 8 + 4); } } while (0)
        SGU_PREFETCH(hd0);
        for (int hd = hd0; hd < hd1; ++hd) {
            __syncthreads();
            { const float m_ = mu[vk], r_ = rsd[vk];
#pragma unroll
              for (int x = 0; x < 4; ++x) { const int c = vpart * 32 + x * 8;
                  f32x4 a, b; unpack8(pv[x], a, b); const f32x4 ga = pg[x][0], gb = pg[x][1];
                  a = (a - m_) * r_ * ga; b = (b - m_) * r_ * gb;
                  u32x2 o0, o1; o0.x = cvt_pk_bf16(a[0], a[1]); o0.y = cvt_pk_bf16(a[2], a[3]); o1.x = cvt_pk_bf16(b[0], b[1]); o1.y = cvt_pk_bf16(b[2], b[3]);
                  *(LAS u32x2*)(Vn + vk * 264 + c * 2) = o0; *(LAS u32x2*)(Vn + vk * 264 + c * 2 + 8) = o1;
                  const int e8 = (tid + x * 512) * 8, qq = e8 >> 7, kk = e8 & 127; *(LAS u32x4*)(Wl + qq * 272 + kk * 2) = pw[x]; } }
            if (hd + 1 < hd1) SGU_PREFETCH(hd + 1);
            const int kg = lane >> 4, cl = wave * 16 + (lane & 15);
            u32x4 uw4[4];
            const size_t uoff = (size_t)(r0 + (lane & 15) + 16 * (kg & 1)) * 512 + hd * 128 + wave * 16 + 4 * (kg & 2);
#pragma unroll
            for (int qp = 0; qp < 4; ++qp) uw4[qp] = *(const u32x4*)(U + uoff + (size_t)(32 * qp) * 512);
            const float* bs = p.in[I_SGUB] + ((size_t)l * 4 + hd) * 128;
            float bqv[8];
#pragma unroll
            for (int qt = 0; qt < 8; ++qt) bqv[qt] = bs[qt * 16 + (lane & 15)];
            __syncthreads();
            f32x4 o[8];
#pragma unroll
            for (int qt = 0; qt < 8; ++qt) o[qt] = (f32x4){0.f, 0.f, 0.f, 0.f};
#pragma unroll
            for (int ks = 0; ks < 4; ++ks) {
                bf16x8 af, bfv[8];
#pragma unroll
                for (int j = 0; j < 8; ++j) af[j] = (short)*(const LAS bf16_t*)(Vn + (ks * 32 + kg * 8 + j) * 264 + cl * 2);
#pragma unroll
                for (int qt = 0; qt < 8; ++qt) bfv[qt] = *(const LAS bf16x8*)(Wl + (qt * 16 + (lane & 15)) * 272 + (ks * 32 + kg * 8) * 2);
                __builtin_amdgcn_sched_barrier(0);
#pragma unroll
                for (int qt = 0; qt < 8; ++qt) o[qt] = __builtin_amdgcn_mfma_f32_16x16x32_bf16(af, bfv[qt], o[qt], 0, 0, 0);
                __builtin_amdgcn_sched_barrier(0);
            }
#pragma unroll
            for (int qp = 0; qp < 4; ++qp) {
                u32x2 ua = (u32x2){uw4[qp].x, uw4[qp].y}, ub = (u32x2){uw4[qp].z, uw4[qp].w};
                { const auto r0_ = __builtin_amdgcn_permlane16_swap(ua.x, ub.x, false, false); ua.x = r0_[0]; ub.x = r0_[1];
                  const auto r1_ = __builtin_amdgcn_permlane16_swap(ua.y, ub.y, false, false); ua.y = r1_[0]; ub.y = r1_[1]; }
                u32x2 oa, ob; { const int qt = 2 * qp; const float bq = bqv[qt];
                    oa.x = cvt_pk_bf16(bf_lo(ua.x) * (o[qt][0] + bq), bf_hi(ua.x) * (o[qt][1] + bq)); oa.y = cvt_pk_bf16(bf_lo(ua.y) * (o[qt][2] + bq), bf_hi(ua.y) * (o[qt][3] + bq)); }
                { const int qt = 2 * qp + 1; const float bq = bqv[qt];
                    ob.x = cvt_pk_bf16(bf_lo(ub.x) * (o[qt][0] + bq), bf_hi(ub.x) * (o[qt][1] + bq)); ob.y = cvt_pk_bf16(bf_lo(ub.y) * (o[qt][2] + bq), bf_hi(ub.y) * (o[qt][3] + bq)); }
                { const auto r0_ = __builtin_amdgcn_permlane16_swap(oa.x, ob.x, false, false); oa.x = r0_[0]; ob.x = r0_[1];
                  const auto r1_ = __builtin_amdgcn_permlane16_swap(oa.y, ob.y, false, false); oa.y = r1_[0]; ob.y = r1_[1]; }
                *(u32x4*)(U + uoff + (size_t)(32 * qp) * 512) = (u32x4){oa.x, oa.y, ob.x, ob.y}; }
        }
#undef SGU_PREFETCH
    }
    __syncthreads();
}
__device__ __forceinline__ void phase_conv(const Params& p, const Frame& F, int l) {
    bf16_t* Bb = (bf16_t*)(p.ws + OFF_BB); const bf16_t* P = (const bf16_t*)(p.ws + OFF_P);
    const float* cw = p.in[I_CONVW] + l * 3 * 512;
    const int nrows = l == 0 ? TALL : TLAT, npc = nrows * 64;
    const int c = (F.tid & 63) * 8;
    const f32x4 w0a = *(const f32x4*)(cw + c), w0b = *(const f32x4*)(cw + c + 4), w1a = *(const f32x4*)(cw + 512 + c), w1b = *(const f32x4*)(cw + 512 + c + 4), w2a = *(const f32x4*)(cw + 1024 + c), w2b = *(const f32x4*)(cw + 1024 + c + 4);
    const int nv = 352, vb0 = F.blk < 160 ? F.blk : 160 + 2 * (F.blk - 160), nvb = F.blk < 160 ? 1 : 2;
    for (int vb = vb0; vb < vb0 + nvb; ++vb)
    for (int it = vb * NTHR + F.tid; it < npc; it += 2 * nv * NTHR) {
        const int it2 = it + nv * NTHR; const bool two = it2 < npc;
        const int r = it >> 6, r2 = two ? (it2 >> 6) : r;
        const int s = r < TLAT ? (r & 63) : ((r - TLAT) & 255), smax = r < TLAT ? 63 : 255, s2 = r2 < TLAT ? (r2 & 63) : ((r2 - TLAT) & 255), smax2 = r2 < TLAT ? 63 : 255;
        const u32x4 zero = (u32x4){0u, 0u, 0u, 0u};
        const u32x4 xc = *(const u32x4*)(P + (size_t)r * 512 + c), xp = s > 0 ? *(const u32x4*)(P + (size_t)(r - 1) * 512 + c) : zero, xn = s < smax ? *(const u32x4*)(P + (size_t)(r + 1) * 512 + c) : zero, xb = *(const u32x4*)(Bb + (size_t)r * 512 + c);
        const u32x4 yc = *(const u32x4*)(P + (size_t)r2 * 512 + c), yp = s2 > 0 ? *(const u32x4*)(P + (size_t)(r2 - 1) * 512 + c) : zero, yn = s2 < smax2 ? *(const u32x4*)(P + (size_t)(r2 + 1) * 512 + c) : zero, yb = *(const u32x4*)(Bb + (size_t)r2 * 512 + c);
        { f32x4 x0, x1, pa, pb, na, nb, b0, b1; unpack8(xc, x0, x1); unpack8(xp, pa, pb); unpack8(xn, na, nb); unpack8(xb, b0, b1);
          *(u32x4*)(Bb + (size_t)r * 512 + c) = pack8(b0 * (w0a * pa + w1a * x0 + w2a * na), b1 * (w0b * pb + w1b * x1 + w2b * nb)); }
        if (two) { f32x4 x0, x1, pa, pb, na, nb, b0, b1; unpack8(yc, x0, x1); unpack8(yp, pa, pb); unpack8(yn, na, nb); unpack8(yb, b0, b1);
          *(u32x4*)(Bb + (size_t)r2 * 512 + c) = pack8(b0 * (w0a * pa + w1a * x0 + w2a * na), b1 * (w0b * pb + w1b * x1 + w2b * nb)); }
    }
}
__device__ __forceinline__ void phase_scan(const Params& p, const Frame& F, int l) {
    if (F.blk >= 128) return;
    const int T = F.blk * NTHR + F.tid, pp = T & 63, g = (T >> 6) & 31, b = (T >> 11) & 15, dir = T >> 15;
    const float* E = (const float*)(p.ws + OFF_E) + (size_t)g * NCH * 256 + dir * 128 + pp;
    bf16_t* Ux = (bf16_t*)(p.ws + OFF_UX) + (size_t)g * NCHP * 768 + 512 + dir * 128 + pp;
    const float* aq = (const float*)(p.ws + OFF_AQ) + ((((size_t)l * 2 + dir) * 32 + g) * 64 + pp) * 2;
    const float ar = aq[0], ai = aq[1];
    float sr = 0.f, si = 0.f;
#pragma unroll 8
    for (int st = 0; st < 72; ++st) {
        int m;
        if (dir == 0) m = st < 8 ? (1024 + b * 8 + st) : (b * 64 + (st - 8));
        else m = st < 8 ? (1024 + b * 8 + (7 - st)) : (b * 64 + (71 - st));
        const float er = E[(size_t)m * 256], ei = E[(size_t)m * 256 + 64];
        Ux[(size_t)m * 768] = (bf16_t)(cvt_pk_bf16(sr, 0.f) & 0xffffu); Ux[(size_t)m * 768 + 64] = (bf16_t)(cvt_pk_bf16(si, 0.f) & 0xffffu);
        const float nr = ar * sr - ai * si + er, ni = ar * si + ai * sr + ei; sr = nr; si = ni;
    }
}
__device__ __forceinline__ void phase_router(const Params& p, const Frame& F, int l) {
    const float* mod = (const float*)(p.ws + OFF_MOD);
    signed char* Xq2 = (signed char*)(p.ws + OFF_XN); float* sx2 = (float*)(p.ws + OFF_SX2);
    LAS float* rw = (LAS float*)F.lds;
    LAS int* lsel = (LAS int*)(F.lds + 133632);
    LAS int* lrk = lsel + 288;
    LAS float* lgs = (LAS float*)(lrk + 288);
    int* sel = (int*)(p.ws + OFF_SEL); float* wsel = (float*)(p.ws + OFF_WSEL); int* lrank = (int*)(p.ws + OFF_LRANK); int* cnt = (int*)(p.ws + OFF_CNT);
    const int NR = l == 0 ? 144 : 128, RW = NR / 8, lane = F.lane;
    __syncthreads();
    { f32x4 wt[8];
#pragma unroll
      for (int x = 0; x < 8; ++x) wt[x] = *(const f32x4*)(p.in[I_RW] + (F.tid + x * NTHR) * 4);
#pragma unroll
      for (int x = 0; x < 8; ++x) { const int i = (F.tid + x * NTHR) * 4, kk = i >> 4, e = i & 15;
          const int k = 4 * ((kk & 511) >> 3) + 256 * (2 * (kk >> 9) + ((kk >> 2) & 1)) + (kk & 3);
          rw[e * 1024 + k] = wt[x][0]; rw[(e + 1) * 1024 + k] = wt[x][1]; rw[(e + 2) * 1024 + k] = wt[x][2]; rw[(e + 3) * 1024 + k] = wt[x][3]; } }
    __syncthreads();
    float rb[16];
#pragma unroll
    for (int e = 0; e < 16; ++e) rb[e] = p.in[I_RB][e];
    const int row0 = F.blk * NR + F.wave * RW;
    f32x4 chA[4], chB[4], mg[4], ms[4]; int cmi = -1;
#define RT_K(j) (8 * lane + 512 * ((j) >> 1) + 4 * ((j) & 1))
#define RT_LOAD(rr, H) do { const bf16_t* hp_ = hrow_ptr(p, (rr)); _Pragma("unroll") for (int jj = 0; jj < 2; ++jj) { const u32x4 w_ = *(const u32x4*)(hp_ + 8 * lane + 512 * jj); \
            H[2 * jj] = bf4((u32x2){w_.x, w_.y}); H[2 * jj + 1] = bf4((u32x2){w_.z, w_.w}); } } while (0)
#define RT_NORM(rr, V) do { const int r_ = (rr), mi_ = mod_index(r_); float ss_ = 0.f; \
        _Pragma("unroll") for (int j = 0; j < 4; ++j) ss_ += (V[j][0] * V[j][0] + V[j][1] * V[j][1]) + (V[j][2] * V[j][2] + V[j][3] * V[j][3]); \
        const float rs_ = __builtin_amdgcn_rsqf(wave_sum(ss_) * (1.0f / D) + EPS); \
        if (mi_ != cmi) { cmi = mi_; const float* gn_ = p.in[I_N2G] + l * D; const float* sh_ = mod + ((size_t)l * 17 + mi_) * 6144 + 3072; const float* sc_ = sh_ + 1024; \
            _Pragma("unroll") for (int j = 0; j < 4; ++j) { const int k_ = RT_K(j); mg[j] = *(const f32x4*)(gn_ + k_) * (1.0f + *(const f32x4*)(sc_ + k_)); ms[j] = *(const f32x4*)(sh_ + k_); } } \
        float am_ = 0.f; \
        _Pragma("unroll") for (int j = 0; j < 4; ++j) { V[j] = V[j] * rs_ * mg[j] + ms[j]; am_ = fmaxf(am_, fmaxf(fmaxf(fabsf(V[j][0]), fabsf(V[j][1])), fmaxf(fabsf(V[j][2]), fabsf(V[j][3])))); } \
        am_ = fmaxf(wave_max(am_), 1e-30f); const float inv_ = 127.0f * __builtin_amdgcn_rcpf(am_); \
        _Pragma("unroll") for (int jj = 0; jj < 2; ++jj) *(u32x2*)(Xq2 + (size_t)r_ * D + 8 * lane + 512 * jj) = (u32x2){q8x4(V[2 * jj], inv_), q8x4(V[2 * jj + 1], inv_)}; \
        if (lane == 0) sx2[r_] = am_ * (1.0f / 127.0f); } while (0)
#define RT_REDUCE(SX, LX) do { float k8_[8], k4_[4], k2_[2]; \
        _Pragma("unroll") for (int q = 0; q < 8; ++q) { const float keep = b3 ? SX[q + 8] : SX[q], send = b3 ? SX[q] : SX[q + 8]; k8_[q] = keep + dpp_f<0x128>(send); } \
        _Pragma("unroll") for (int q = 0; q < 4; ++q) { const float keep = b2 ? k8_[q + 4] : k8_[q], send = b2 ? k8_[q] : k8_[q + 4]; k4_[q] = keep + dpp_f<0x141>(send); } \
        _Pragma("unroll") for (int q = 0; q < 2; ++q) { const float keep = b1 ? k4_[q + 2] : k4_[q], send = b1 ? k4_[q] : k4_[q + 2]; k2_[q] = keep + dpp_f<0x4E>(send); } \
        { const float keep = b0 ? k2_[1] : k2_[0], send = b0 ? k2_[0] : k2_[1]; LX = keep + dpp_f<0xB1>(send); } } while (0)
    const bool b3 = (lane & 8) != 0, b2 = (lane & 4) != 0, b1 = (lane & 2) != 0, b0 = (lane & 1) != 0;
    RT_LOAD(row0, chA); RT_LOAD(row0 + 1, chB);
    for (int i = 0; i < RW; i += 2) {
        const int lr_ = F.wave * RW + i, r = row0 + i;
        f32x4 nA[4], nB[4];
        if (i + 2 < RW) { RT_LOAD(r + 2, nA); RT_LOAD(r + 3, nB); }
        RT_NORM(r, chA); RT_NORM(r + 1, chB);
        float sxA[16], sxB[16]; f32x4 wq[2][4];
#pragma unroll
        for (int j = 0; j < 4; ++j) wq[0][j] = *(const LAS f32x4*)(rw + 4 * lane + 256 * j);
#pragma unroll
        for (int e = 0; e < 16; ++e) { f32x4 a4 = (f32x4){0.f, 0.f, 0.f, 0.f}, c4 = (f32x4){0.f, 0.f, 0.f, 0.f};
            if (e < 15) {
#pragma unroll
                for (int j = 0; j < 4; ++j) wq[(e + 1) & 1][j] = *(const LAS f32x4*)(rw + (e + 1) * 1024 + 4 * lane + 256 * j); }
            __builtin_amdgcn_sched_barrier(0);
#pragma unroll
            for (int j = 0; j < 4; ++j) { a4 += chA[j] * wq[e & 1][j]; c4 += chB[j] * wq[e & 1][j]; }
            sxA[e] = (a4[0] + a4[1]) + (a4[2] + a4[3]); sxB[e] = (c4[0] + c4[1]) + (c4[2] + c4[3]);
            __builtin_amdgcn_sched_barrier(0); }
        float lxA, lxB; RT_REDUCE(sxA, lxA); RT_REDUCE(sxB, lxB);
        lxA += __shfl_xor(lxA, 16); lxB += __shfl_xor(lxB, 16); lxA += __shfl_xor(lxA, 32); lxB += __shfl_xor(lxB, 32);
        if (lane < 16) { lgs[lr_ * 16 + lane] = lxA; lgs[(lr_ + 1) * 16 + lane] = lxB; }
#pragma unroll
        for (int j = 0; j < 4; ++j) { chA[j] = nA[j]; chB[j] = nB[j]; }
    }
#undef RT_LOAD
#undef RT_K
#undef RT_NORM
#undef RT_REDUCE
    asm volatile("s_waitcnt lgkmcnt(0)" ::: "memory");
    if (lane < RW) {
        const int lr_ = F.wave * RW + lane, r = row0 + lane;
        float sc_[16], bi[16];
#pragma unroll
        for (int e = 0; e < 16; ++e) { sc_[e] = 1.0f / (1.0f + expf(-lgs[lr_ * 16 + e])); bi[e] = sc_[e] + rb[e]; }
        int bg = 0; float bgs = -1e30f;
#pragma unroll
        for (int gq = 0; gq < 4; ++gq) { float m1 = -1e30f, m2 = -1e30f;
#pragma unroll
            for (int j = 0; j < 4; ++j) { const float x = bi[gq * 4 + j]; if (x > m1) { m2 = m1; m1 = x; } else if (x > m2) m2 = x; }
            const float gsum = m1 + m2; if (gsum > bgs) { bgs = gsum; bg = gq; } }
        float c4[4], s4[4];
#pragma unroll
        for (int j = 0; j < 4; ++j) { c4[j] = bg == 0 ? bi[j] : (bg == 1 ? bi[4 + j] : (bg == 2 ? bi[8 + j] : bi[12 + j])); s4[j] = bg == 0 ? sc_[j] : (bg == 1 ? sc_[4 + j] : (bg == 2 ? sc_[8 + j] : sc_[12 + j])); }
        int i1 = 0; float b1v = c4[0], w1 = s4[0];
#pragma unroll
        for (int j = 1; j < 4; ++j) if (c4[j] > b1v) { i1 = j; b1v = c4[j]; w1 = s4[j]; }
        int i2 = -1; float b2v = -1e30f, w2 = 0.f;
#pragma unroll
        for (int j = 0; j < 4; ++j) if (j != i1 && (i2 < 0 || c4[j] > b2v)) { i2 = j; b2v = c4[j]; w2 = s4[j]; }
        const float inv = 1.0f / (w1 + w2);
        const int e0 = bg * 4 + i1, e1 = bg * 4 + i2; sel[2 * r] = e0; sel[2 * r + 1] = e1; wsel[2 * r] = w1 * inv; wsel[2 * r + 1] = w2 * inv; lsel[2 * lr_] = e0; lsel[2 * lr_ + 1] = e1;
    }
    __syncthreads();
    int me = -1, myrank = 0;
    if (F.tid < 320) {
        me = F.tid < 2 * NR ? lsel[F.tid] : -1; int wc = 0;
        const unsigned long long below = (1ull << lane) - 1ull;
#pragma unroll
        for (int e = 0; e < 16; ++e) { const unsigned long long m = __ballot(me == e); if (me == e) myrank = __builtin_popcountll(m & below); if (lane == e) wc = __builtin_popcountll(m); }
        if (lane < 16) lrk[F.wave * 16 + lane] = wc;
    }
    __syncthreads();
    if (F.tid < 2 * NR) { int c = myrank;
#pragma unroll
        for (int w = 0; w < 4; ++w) c += (w < F.wave) ? lrk[w * 16 + me] : 0;
        lrank[2 * (F.blk * NR) + F.tid] = c; }
    if (F.tid >= 496) { const int e = F.tid - 496; cnt[F.blk * 16 + e] = (lrk[e] + lrk[16 + e]) + (lrk[32 + e] + lrk[48 + e]) + lrk[64 + e]; }
}
__device__ __forceinline__ void phase_lists(const Params& p, const Frame& F, int l) {
    LAS int* part = (LAS int*)F.lds;
    LAS int* tot = part + 512;
    LAS int* base = tot + 16;
    LAS int* toff = base + 16;
    const int* cnt = (const int*)(p.ws + OFF_CNT); const int* sel = (const int*)(p.ws + OFF_SEL); const float* wsel = (const float*)(p.ws + OFF_WSEL); const int* lrank = (const int*)(p.ws + OFF_LRANK);
    int* pos = (int*)(p.ws + OFF_POS); int* rowl = (int*)(p.ws + OFF_ROWL); float* wl = (float*)(p.ws + OFF_WL); int* seg = (int*)(p.ws + OFF_SEG);
    float* sxs = (float*)(p.ws + OFF_SXS); const float* sx2 = (const float*)(p.ws + OFF_SX2);
    const int NR = l == 0 ? 144 : 128;
    __syncthreads();
    { const int e = F.tid & 15, pt = F.tid >> 4; int s = 0, sb = 0;
      int cv[8];
#pragma unroll
      for (int j = 0; j < 8; ++j) cv[j] = cnt[(pt * 8 + j) * 16 + e];
#pragma unroll
      for (int j = 0; j < 8; ++j) { s += cv[j]; if (pt * 8 + j < F.blk) sb += cv[j]; }
      part[pt * 16 + e] = s; part[512 + 64 + pt * 16 + e] = sb; }
    __syncthreads();
    if (F.tid < 16) { int s = 0, sb = 0;
#pragma unroll
        for (int pt = 0; pt < 32; ++pt) { s += part[pt * 16 + F.tid]; sb += part[576 + pt * 16 + F.tid]; }
        tot[F.tid] = s; base[F.tid] = sb; }
    __syncthreads();
    if (F.tid == 0) { int o = 0, tv[16];
#pragma unroll
        for (int e = 0; e < 16; ++e) tv[e] = tot[e];
#pragma unroll
        for (int e = 0; e < 16; ++e) { toff[e] = o; o += (tv[e] + 255) >> 8; }
        toff[16] = o; }
    __syncthreads();
    if (F.blk == 0 && F.tid < 17) seg[F.tid] = toff[F.tid];
    for (int i = F.tid; i < 2 * NR; i += NTHR) { const int idx = 2 * (F.blk * NR) + i, e = sel[idx], ps = toff[e] * 256 + base[e] + lrank[idx]; pos[idx] = ps; rowl[ps] = idx >> 1; wl[ps] = wsel[idx]; sxs[ps] = sx2[idx >> 1]; }
    if (F.blk < 16) { const int e = F.blk, lo = toff[e] * 256 + tot[e], hi = toff[e + 1] * 256; for (int i = lo + F.tid; i < hi; i += NTHR) { rowl[i] = 0; wl[i] = 0.f; sxs[i] = 0.f; } }
    __syncthreads();
}
__device__ __forceinline__ void load_toff(const Params& p, const Frame& F) {
    LAS int* toff = (LAS int*)(F.lds + LDS_CTL_OFF + 64);
    __syncthreads();
    if (F.tid < 17) toff[F.tid] = ((const int*)(p.ws + OFF_SEG))[F.tid];
    __syncthreads();
}

#define OPAQUE_V(x) asm volatile("" : "+v"(x))
#define PHASE_ENTER() Frame F; { int t_ = threadIdx.x; OPAQUE_V(t_); F.tid = t_; F.lane = t_ & 63; F.wave = __builtin_amdgcn_readfirstlane(t_ >> 6); int b_ = blockIdx.x; OPAQUE_S(b_); F.blk = b_; F.lds = (LAS unsigned char*)lds_raw; } \
    size_t wz_ = 0; OPAQUE_S(wz_); unsigned char* ws = p.ws + wz_; int l = l0; OPAQUE_S(l); (void)l; (void)ws
__global__ void __launch_bounds__(NTHR, 2) fwd_kernel(Params p) {
    extern __shared__ __attribute__((aligned(16))) unsigned char lds_raw[];
    for (int u = threadIdx.x; u < (LDS_BYTES - LDS_CTL_OFF) / 4; u += NTHR) ((LAS unsigned*)((LAS unsigned char*)lds_raw + LDS_CTL_OFF))[u] = 0u;
    __syncthreads();
#if !MK_LAUNCH_PER_PHASE
    XcdBarrier bar = xcd_barrier_post((unsigned*)(p.ws + OFF_CTL), (volatile LAS unsigned*)((LAS unsigned char*)lds_raw + LDS_CTL_OFF));
#define GRID_BAR() xcd_barrier(bar)
#else
#define GRID_BAR() do { } while (0)
#endif
    const int lo = (int)p.ph_lo, hi = (int)p.ph_hi;
#define IN(k) (lo <= (k) && (k) < hi)
#define SEAM(k) do { if (IN(k) && IN((k) + 1)) { GRID_BAR(); if ((REPEAT_MASK >> 16) & 1) GRID_BAR(); } } while (0)
#ifndef NPASS
#define NPASS 1
#endif
    for (int pass_ = 0; pass_ < NPASS; ++pass_) {
    if (pass_ > 0) GRID_BAR();
    if (PH_ON(0) && IN(0)) {
        const int l0 = 0;
        REP(0) { PHASE_ENTER();
        { bf16_t* w16 = (bf16_t*)(ws + OFF_SGUW16); const int i8 = (F.blk * NTHR + F.tid) * 8;
          for (int i = i8; i < 262144; i += NBLK * NTHR * 8) { const f32x4 a = *(const f32x4*)(p.in[I_SGUW] + i), b = *(const f32x4*)(p.in[I_SGUW] + i + 4); *(u32x4*)(w16 + i) = pack8(a, b); } }
        mod_items(p, F);
        if (F.blk >= 128) s5_build_job(p, F, 0, 255 - F.blk);
        __syncthreads();
        if (F.blk < 128) { colmax_win(p, F); convert_mix(p, F, 0, 1, F.blk * NWAVE + F.wave, 128 * NWAVE); } }
    }
    SEAM(0);
    for (int l0 = 0; l0 < DEPTH; ++l0) {
        const int pb = 1 + 12 * l0;
        if (PH_ON(1) && IN(pb + 0)) {
            for (int rep_ = 0; rep_ < 1 + (((REPEAT_MASK >> 1) & 1) && l0 == 0 ? 1 : 0); ++rep_) { PHASE_ENTER();
            if (l == 1) convert_mix(p, F, 1, 1, F.blk * NWAVE + F.wave, NBLK * NWAVE);
            else convert_mix(p, F, 0, 0, F.blk * NWAVE + F.wave, NBLK * NWAVE);
            if (((REPEAT_MASK >> 18) & 1) && l == 1) phase_norm1(p, F, l, true);
            phase_norm1(p, F, l); }
        }
        SEAM(pb + 0);
        if (PH_ON(2) && IN(pb + 1)) {
            REP(2) { PHASE_ENTER();
            SchedB S{(const char*)(ws + OFF_XN), (const char*)(ws + OFF_WIN), l, F.blk};
            EpiB E{(bf16_t*)(ws + OFF_U), (bf16_t*)(ws + OFF_V), (bf16_t*)(ws + OFF_BB), (bf16_t*)(ws + OFF_P), (bf16_t*)(ws + OFF_UX), ws + OFF_G8, (const float*)(ws + OFF_SXA), (const float*)(ws + OFF_SWIN) + (size_t)l * 6144};
            gs::gemm_stream<EpiB, SchedB, false>(F.lds, F.tid, S, E); }
        }
        SEAM(pb + 1);
        if (PH_ON(3) && IN(pb + 2)) {
            REP(3) { PHASE_ENTER(); SchedE S{(const char*)(ws + OFF_UX), (const char*)(ws + OFF_WE), F.blk}; EpiE E{(float*)(ws + OFF_E)}; gs::gemm_stream<EpiE, SchedE, false>(F.lds, F.tid, S, E); }
            { PHASE_ENTER(); phase_conv(p, F, l); }
        }
        SEAM(pb + 2);
        if (PH_ON(4) && IN(pb + 3)) { REP(4) { PHASE_ENTER(); phase_scan(p, F, l); } { PHASE_ENTER(); phase_sgu(p, F, l); } }
        SEAM(pb + 3);
        if (PH_ON(5) && IN(pb + 4)) REP(5) { PHASE_ENTER(); SchedY S{(const char*)(ws + OFF_UX), (const char*)(ws + OFF_TW), l, F.blk}; EpiY E{(bf16_t*)(ws + OFF_V)}; gs::gemm_stream<EpiY, SchedY, false>(F.lds, F.tid, S, E); }
        SEAM(pb + 4);
        if (PH_ON(6) && IN(pb + 5)) REP(6) { PHASE_ENTER(); SchedF S{(const char*)(ws + OFF_V), (const char*)(ws + OFF_GLU), l, F.blk}; EpiF E{(const bf16_t*)(ws + OFF_V), (bf16_t*)(ws + OFF_P), p.in[I_GLUB] + l * 512}; gs::gemm_stream<EpiF, SchedF, false>(F.lds, F.tid, S, E); }
        SEAM(pb + 5);
        if (PH_ON(7) && IN(pb + 6)) {
            REP(7) { PHASE_ENTER();
            SchedG S{(const char*)(ws + OFF_U), (const char*)(ws + OFF_BB), (const char*)(ws + OFF_P), (const char*)(ws + OFF_WBR), l, F.blk};
            EpiG E{ws + OFF_G8, (bf16_t*)(ws + OFF_MERGED)};
            gs::gemm_stream<EpiG, SchedG, false>(F.lds, F.tid, S, E); }
            if (l0 == 0) {
                PHASE_ENTER();
                if (F.blk >= 64 && F.blk < 192) s5_build_job(p, F, 1, F.blk - 64);
                __syncthreads();
                if (F.blk >= 64) convert_mix(p, F, 1, 0, (F.blk - 64) * NWAVE + F.wave, 192 * NWAVE);
            }
        }
        SEAM(pb + 6);
        if (PH_ON(8) && IN(pb + 7)) {
            for (int rep_ = 0; rep_ < 1 + (((REPEAT_MASK >> 8) & 1) && l0 == 0 ? 1 : 0); ++rep_) { PHASE_ENTER();
            SchedH S{(const char*)(ws + OFF_MERGED), (const char*)(ws + OFF_WOUT), l, F.blk};
            if (l == 0) { EpiH<1> E{p.in[I_X], p.in[I_CTX], (bf16_t*)(ws + OFF_HB), (const float*)(ws + OFF_MOD) + (size_t)l * 17 * 6144}; gs::gemm_stream<EpiH<1>, SchedH, false>(F.lds, F.tid, S, E); }
            else { EpiH<0> E{p.in[I_X], p.in[I_CTX], (bf16_t*)(ws + OFF_HB), (const float*)(ws + OFF_MOD) + (size_t)l * 17 * 6144}; gs::gemm_stream<EpiH<0>, SchedH, false>(F.lds, F.tid, S, E); } }
            { PHASE_ENTER(); if (l == 0 && F.blk >= 64) convert_experts(p, F, 0, F.blk - 64, NBLK - 64, 3); }
        }
        SEAM(pb + 7);
        if (PH_ON(9) && IN(pb + 8)) { REP(9) { PHASE_ENTER(); phase_router(p, F, l); } REP(10) { PHASE_ENTER(); if (l == 1) convert_experts(p, F, l, F.blk, NBLK, 1); } }
        SEAM(pb + 8);
        if (PH_ON(10) && IN(pb + 9)) REP(13) { PHASE_ENTER(); phase_lists(p, F, l); }
        SEAM(pb + 9);
        if (PH_ON(11) && IN(pb + 10)) {
            REP(11) { PHASE_ENTER();
            load_toff(p, F);
            SchedK S{(const char*)(ws + OFF_XN), (const char*)(ws + OFF_WGU), (const int*)(ws + OFF_ROWL), (const LAS int*)(F.lds + LDS_CTL_OFF + 64), F.blk};
            EpiK E{(bf16_t*)(ws + OFF_HE), (const float*)(ws + OFF_SXS), (const float*)(ws + OFF_SWGU)};
            gs::gemm_stream<EpiK, SchedK, true>(F.lds, F.tid, S, E); }
            { PHASE_ENTER(); if (l == 1) { const int r = (__builtin_amdgcn_readfirstlane(((const LAS int*)(F.lds + LDS_CTL_OFF + 64))[16]) * 4) & 255;
                if (r == 0 || r > 128) convert_experts(p, F, 1, F.blk, NBLK, 2); else if (F.blk >= r) convert_experts(p, F, 1, F.blk - r, NBLK - r, 2); } }
        }
        SEAM(pb + 10);
        if (PH_ON(12) && IN(pb + 11)) {
            REP(12) { PHASE_ENTER();
            load_toff(p, F);
            SchedL S{(const char*)(ws + OFF_HE), (const char*)(ws + OFF_WD), (const LAS int*)(F.lds + LDS_CTL_OFF + 64), F.blk};
            EpiL E{(bf16_t*)(ws + OFF_Y), (const float*)(ws + OFF_WL)};
            gs::gemm_stream<EpiL, SchedL, false>(F.lds, F.tid, S, E); }
        }
        SEAM(pb + 11);
    }
    if (PH_ON(13) && IN(25)) { const int l0 = 1; REP(17) { PHASE_ENTER(); phase_final(p, F); } }
    }
#undef IN
#undef SEAM
}


extern "C" void kernel_launch(void* const* d_in, const int* in_sizes, int n_in, void* d_out, int out_size, void* d_ws, size_t ws_size, hipStream_t stream) {
    static int ready = 0;
    if (ready == 0) {
        if (n_in != 31 || out_size != TLAT * D || ws_size < WS_END) { fprintf(stderr, "kernel_launch: unexpected shapes (n_in %d out %d ws %zu)\n", n_in, out_size, ws_size); ready = -1; return; }
        if (hipFuncSetAttribute((const void*)fwd_kernel, hipFuncAttributeMaxDynamicSharedMemorySize, LDS_BYTES) != hipSuccess) { fprintf(stderr, "kernel_launch: hipFuncSetAttribute failed\n"); ready = -1; return; }
        int per_cu = 0;
        if (hipOccupancyMaxActiveBlocksPerMultiprocessor(&per_cu, (const void*)fwd_kernel, NTHR, LDS_BYTES) != hipSuccess || per_cu < 1) fprintf(stderr, "kernel_launch: occupancy query says %d\n", per_cu);
        (void)hipGetLastError();
        ready = 1;
    }
    if (ready < 0) return;
    (void)hipMemsetAsync((char*)d_ws + OFF_CTL, 0, CTL_ZERO_BYTES, stream);
    Params p{};
    for (int i = 0; i < 31; ++i) p.in[i] = (const float*)d_in[i];
    p.out = (float*)d_out; p.ws = (unsigned char*)d_ws;
#if MK_LAUNCH_PER_PHASE
    for (int ph = 0; ph < 26; ++ph) { p.ph_lo = ph; p.ph_hi = ph + 1; hipLaunchKernelGGL(fwd_kernel, dim3(NBLK), dim3(NTHR), LDS_BYTES, stream, p); }
#else
    p.ph_lo = 0; p.ph_hi = 26;
    hipLaunchKernelGGL(fwd_kernel, dim3(NBLK), dim3(NTHR), LDS_BYTES, stream, p);
#endif
}
```

```cpp
#include <hip/hip_runtime.h>
#include <cstdio>
#include <cstdint>

#ifndef MK_LAUNCH_PER_PHASE
#define MK_LAUNCH_PER_PHASE 0
#endif

#ifndef PHASE_MASK
#define PHASE_MASK 0xFFFF
#endif
#define PH_ON(k) (((PHASE_MASK) >> (k)) & 1)
#ifndef REPEAT_MASK
#define REPEAT_MASK 0
#endif
#define REP(k) for (int rep_ = 0; rep_ < 1 + ((REPEAT_MASK >> (k)) & 1); ++rep_)
#define LAS __attribute__((address_space(3)))
#define GAS __attribute__((address_space(1)))
typedef unsigned short bf16_t;
typedef short bf16x8 __attribute__((ext_vector_type(8)));
typedef float f32x4 __attribute__((ext_vector_type(4)));
typedef float f32x2 __attribute__((ext_vector_type(2)));
typedef unsigned u32x4 __attribute__((ext_vector_type(4)));
typedef unsigned u32x2 __attribute__((ext_vector_type(2)));
typedef int i32x4 __attribute__((ext_vector_type(4)));

constexpr int D = 1024, TLAT = 32768, TCTX = 4096, TALL = 36864, DEPTH = 2;
constexpr int NBLK = 256, NTHR = 512, NWAVE = 8;
constexpr int NCH = 1152, NCHP = 1280, SQ = 32;
constexpr float EPS = 1e-6f;
constexpr int MAXROWS = 77824;

constexpr size_t MiB = 1u << 20;
constexpr size_t OFF_CTL = 0, CTL_ZERO_BYTES = 65536;
constexpr size_t OFF_CMAXW = OFF_CTL + 16384;
constexpr size_t OFF_SXA = OFF_CTL + 393216;
constexpr size_t OFF_SWIN = OFF_CTL + 655360;
constexpr size_t OFF_SWGU = OFF_CTL + 720896;
constexpr size_t OFF_SX2 = OFF_CTL + 786432;
constexpr size_t OFF_SXS = 21 * MiB + 512 * 1024;
constexpr size_t OFF_SGUW16 = OFF_CTL + 131072;
constexpr size_t OFF_MOD = 1 * MiB;
constexpr size_t OFF_MISC = 2 * MiB;
constexpr size_t OFF_AQ = OFF_MISC;
constexpr size_t OFF_CNT = OFF_MISC + 64 * 1024;
constexpr size_t OFF_SEG = OFF_MISC + 80 * 1024;
constexpr size_t OFF_SEL = OFF_MISC + 128 * 1024;
constexpr size_t OFF_WSEL = OFF_MISC + 448 * 1024;
constexpr size_t OFF_LRANK = OFF_MISC + 768 * 1024;
constexpr size_t OFF_POS = OFF_MISC + 1088 * 1024;
constexpr size_t OFF_ROWL = OFF_MISC + 1408 * 1024;
constexpr size_t OFF_WL = OFF_MISC + 1728 * 1024;
constexpr size_t OFF_WIN = 4 * MiB;
constexpr size_t OFF_WBR = 16 * MiB;
constexpr size_t OFF_WOUT = 19 * MiB;
constexpr size_t OFF_GLU = 21 * MiB;
constexpr size_t OFF_WE = 22 * MiB;
constexpr size_t OFF_TW = 30 * MiB;
constexpr size_t OFF_HB = 54 * MiB;
constexpr size_t OFF_XN = 126 * MiB;
constexpr size_t OFF_U = 198 * MiB;
constexpr size_t OFF_V = 234 * MiB;
constexpr size_t OFF_BB = 270 * MiB;
constexpr size_t OFF_P = 306 * MiB;
constexpr size_t OFF_UX = 342 * MiB;
constexpr size_t OFF_G8 = 402 * MiB;
constexpr size_t WS_END = 510 * MiB;
constexpr size_t OFF_MERGED = OFF_XN;
constexpr size_t OFF_E = OFF_XN;
constexpr size_t OFF_Y = 198 * MiB;
constexpr size_t OFF_HE = 350 * MiB;
constexpr size_t OFF_WGU = 426 * MiB;
constexpr size_t OFF_WD = 458 * MiB;
static_assert(OFF_Y + (size_t)MAXROWS * 1024 * 2 <= OFF_HE && OFF_HE + (size_t)MAXROWS * 512 * 2 <= OFF_WGU && OFF_WD + (size_t)16 * 1024 * 512 * 2 <= WS_END && OFF_G8 + (size_t)TALL * 3072 <= WS_END, "overlay map");

constexpr int RING_BYTES = 131072;
constexpr int LDS_CTL_OFF = 159744;
constexpr int LDS_BYTES = 160768;

__device__ __forceinline__ unsigned cvt_pk_bf16(float lo, float hi) { unsigned r; asm volatile("v_cvt_pk_bf16_f32 %0, %1, %2" : "=v"(r) : "v"(lo), "v"(hi)); return r; }
__device__ __forceinline__ unsigned cvt_pk_bf16_f(float lo, float hi) { unsigned r; asm("v_cvt_pk_bf16_f32 %0, %1, %2" : "=v"(r) : "v"(lo), "v"(hi)); return r; }
__device__ __forceinline__ float bf_lo(unsigned w) { return __uint_as_float(w << 16); }
__device__ __forceinline__ float bf_hi(unsigned w) { return __uint_as_float(w & 0xffff0000u); }
__device__ __forceinline__ float bf1(bf16_t b) { return __uint_as_float(((unsigned)b) << 16); }
__device__ __forceinline__ float sigmoidf_(float x) { return __builtin_amdgcn_rcpf(1.0f + __builtin_amdgcn_exp2f(-1.44269504089f * x)); }
__device__ __forceinline__ float siluf_(float x) { return x * sigmoidf_(x); }
__device__ __forceinline__ float geluf_(float x) { return x * sigmoidf_(1.59576912161f * x * (1.0f + 0.044715f * x * x)); }
__device__ __forceinline__ f32x4 gelu4(const f32x4 x) {
    const f32x4 t = x * (x * x * (-0.10294324f) + (-2.30220821f));
    f32x4 e; e[0] = __builtin_amdgcn_exp2f(t[0]); e[1] = __builtin_amdgcn_exp2f(t[1]); e[2] = __builtin_amdgcn_exp2f(t[2]); e[3] = __builtin_amdgcn_exp2f(t[3]);
    e = e + 1.0f;
    f32x4 r; r[0] = __builtin_amdgcn_rcpf(e[0]); r[1] = __builtin_amdgcn_rcpf(e[1]); r[2] = __builtin_amdgcn_rcpf(e[2]); r[3] = __builtin_amdgcn_rcpf(e[3]);
    return x * r;
}
__device__ __forceinline__ unsigned gate4_u8_t(const f32x4 t) {
    f32x4 e; e[0] = __builtin_amdgcn_exp2f(t[0]); e[1] = __builtin_amdgcn_exp2f(t[1]); e[2] = __builtin_amdgcn_exp2f(t[2]); e[3] = __builtin_amdgcn_exp2f(t[3]);
    e = e + 0.0039177277f;
    unsigned w = __builtin_amdgcn_cvt_pk_u8_f32(__builtin_amdgcn_rcpf(e[0]), 0, 0u);
    w = __builtin_amdgcn_cvt_pk_u8_f32(__builtin_amdgcn_rcpf(e[1]), 1, w);
    w = __builtin_amdgcn_cvt_pk_u8_f32(__builtin_amdgcn_rcpf(e[2]), 2, w);
    w = __builtin_amdgcn_cvt_pk_u8_f32(__builtin_amdgcn_rcpf(e[3]), 3, w);
    return w;
}
template <int CTRL> __device__ __forceinline__ float dpp_f(float v) { return __int_as_float(__builtin_amdgcn_update_dpp(0, __float_as_int(v), CTRL, 0xF, 0xF, false)); }
__device__ __forceinline__ float row16_sum(float v) { v += dpp_f<0xB1>(v); v += dpp_f<0x4E>(v); v += dpp_f<0x141>(v); v += dpp_f<0x140>(v); return v; }
__device__ __forceinline__ float wave_sum(float v) {
    v = row16_sum(v);
    const float a = __int_as_float(__builtin_amdgcn_readlane(__float_as_int(v), 0)), b = __int_as_float(__builtin_amdgcn_readlane(__float_as_int(v), 16)),
                c = __int_as_float(__builtin_amdgcn_readlane(__float_as_int(v), 32)), d = __int_as_float(__builtin_amdgcn_readlane(__float_as_int(v), 48));
    return (a + b) + (c + d);
}
__device__ __forceinline__ u32x4 pack8(const f32x4 a, const f32x4 b) { u32x4 w; w.x = cvt_pk_bf16(a[0], a[1]); w.y = cvt_pk_bf16(a[2], a[3]); w.z = cvt_pk_bf16(b[0], b[1]); w.w = cvt_pk_bf16(b[2], b[3]); return w; }
__device__ __forceinline__ void unpack8(const u32x4 w, f32x4& a, f32x4& b) { a = (f32x4){bf_lo(w.x), bf_hi(w.x), bf_lo(w.y), bf_hi(w.y)}; b = (f32x4){bf_lo(w.z), bf_hi(w.z), bf_lo(w.w), bf_hi(w.w)}; }

#define XB_TMO      128
#define XB_XCNT(j)  (256  + 64 * (j))
#define XB_XSUB(j)  (1280 + 64 * (j))
#define XB_XGEN(j)  (2304 + 64 * (j))
#define XB_TOP      3328
#define XB_TOPGEN   3392
#define XCD_BAR_WORDS 3456
#define XB_SPIN_CAP (1u << 18)
__device__ __forceinline__ unsigned xb_ld(unsigned* p)              { return __hip_atomic_load(p, __ATOMIC_RELAXED, __HIP_MEMORY_SCOPE_AGENT); }
__device__ __forceinline__ unsigned xb_add(unsigned* p, unsigned v) { return __hip_atomic_fetch_add(p, v, __ATOMIC_RELAXED, __HIP_MEMORY_SCOPE_AGENT); }
__device__ __forceinline__ unsigned xb_xcc_id() { return (unsigned)__builtin_amdgcn_s_getreg((3 << 11) | 20) & 0xFu; }
#define XB_SPIN(cond, bar) do { unsigned _sp = 0; while (cond) { __builtin_amdgcn_s_sleep(1); \
    if ((++_sp & 255u) == 0u) { if (xb_ld(&(bar)[XB_TMO])) break; if (_sp > XB_SPIN_CAP) { atomicAdd(&(bar)[XB_TMO], 1u); break; } } } } while (0)
struct XcdBarrier { unsigned* bar; unsigned x; volatile LAS unsigned* st; };
__device__ __forceinline__ XcdBarrier xcd_barrier_post(unsigned* bar, volatile LAS unsigned* st) {
    XcdBarrier b; b.bar = bar; b.x = xb_xcc_id(); b.st = st;
    if (threadIdx.x == 0) (void)xb_add(&bar[XB_XCNT(b.x)], 1u);
    return b;
}
__device__ __forceinline__ void xcd_barrier_complete(unsigned* bar, unsigned x, unsigned& nloc, unsigned& nx) {
    const unsigned G = gridDim.x * gridDim.y * gridDim.z;
    unsigned sum, cnt, mine, sp = 0u;
    for (;;) {
        sum = 0u; cnt = 0u; mine = 0u;
#pragma unroll
        for (unsigned j = 0; j < 16; ++j) { const unsigned c = xb_ld(&bar[XB_XCNT(j)]); sum += c; cnt += (c > 0u) ? 1u : 0u; mine = (j == x) ? c : mine; }
        if (sum == G) break;
        __builtin_amdgcn_s_sleep(1);
        if ((++sp & 255u) == 0u) { if (xb_ld(&bar[XB_TMO])) break; if (sp > XB_SPIN_CAP) { atomicAdd(&bar[XB_TMO], 1u); break; } }
    }
    nloc = mine > 0u ? mine : 1u; nx = cnt > 0u ? cnt : 1u;
}
__device__ __forceinline__ void xcd_barrier(const XcdBarrier& b) {
    asm volatile("s_waitcnt vmcnt(0)" ::: "memory");
    __syncthreads();
    if (threadIdx.x == 0) {
        unsigned* bar = b.bar;
        __builtin_amdgcn_s_waitcnt(0);
        unsigned nloc = b.st[0], nx = b.st[1];
        if (nloc == 0u) { xcd_barrier_complete(bar, b.x, nloc, nx); b.st[0] = nloc; b.st[1] = nx; }
        const unsigned old = xb_add(&bar[XB_XSUB(b.x)], 1u);
        const unsigned gen = old / nloc;
        if (old + 1u == (gen + 1u) * nloc) {
            __builtin_amdgcn_fence(__ATOMIC_RELEASE, "agent");
            asm volatile("s_waitcnt vmcnt(0)" ::: "memory");
            const unsigned og = xb_add(&bar[XB_TOP], 1u);
            const unsigned tg = og / nx;
            if (og + 1u == (tg + 1u) * nx) xb_add(&bar[XB_TOPGEN], 1u);
            else XB_SPIN(xb_ld(&bar[XB_TOPGEN]) == tg, bar);
            __builtin_amdgcn_fence(__ATOMIC_ACQUIRE, "agent");
            xb_add(&bar[XB_XGEN(b.x)], 1u);
            asm volatile("s_waitcnt vmcnt(0)" ::: "memory");
        } else {
            XB_SPIN(xb_ld(&bar[XB_XGEN(b.x)]) == gen, bar);
            __builtin_amdgcn_fence(__ATOMIC_ACQUIRE, "agent");
            asm volatile("s_waitcnt vmcnt(0)" ::: "memory");
        }
    }
    __syncthreads();
}

namespace gs {
constexpr int BM = 256, BK = 64, HALF = 128, HTB = HALF * BK * 2, STAGE_BYTES = 8 * HTB;
__device__ __forceinline__ int lds_byte(int r, int c) { const int st = (r >> 4) * 2 + (c >> 5), rr = r & 15, cc = c & 31, ob = rr * 64 + cc * 2; return st * 1024 + (ob ^ (((ob >> 9) & 1) << 5)); }
__device__ __forceinline__ void stage_rc(int b, int& R, int& C) { const int st = b / 1024, sb = b % 1024, swz = sb ^ (((sb >> 9) & 1) << 5); R = (st >> 1) * 16 + swz / 64; C = (st & 1) * 32 + (swz % 64) / 2; }
__device__ __forceinline__ int perm32(int rho) { const int n = rho >> 4, i = rho & 15; return 8 * (i >> 2) + 4 * n + (i & 3); }
__device__ __forceinline__ int xcd_remap(int L, int nwg) { const int q = nwg >> 3, r = nwg & 7, xcd = L & 7, off = L >> 3; return (xcd < r ? xcd * (q + 1) : r * (q + 1) + (xcd - r) * q) + off; }
__device__ __forceinline__ void tile_order(int wgid, int nM, int nN, int& pm, int& pn) { const int nig = 8 * nN, gid = wgid / nig, fm = gid * 8, gsz = (nM - fm) < 8 ? (nM - fm) : 8; pm = fm + ((wgid % nig) % gsz); pn = (wgid % nig) / gsz; }

struct Unit { int pm, pn, kind, aux; };
struct Ops { const char* A; const char* B; unsigned lda, ldb; int nt; const int* rows; };

template <class Epi, class Sched, bool GATHER>
__device__ __forceinline__ void gemm_stream(LAS unsigned char* lds, const int tid, const Sched& S, const Epi& E) {
    const int wid = __builtin_amdgcn_readfirstlane(tid >> 6), lane = tid & 63, wr = wid >> 2, wc = wid & 3, fr = lane & 15, fq = lane >> 4;
    const unsigned ldsw = (unsigned)wid * 1024u;
    const int aoff = lds_byte(wr * 64 + fr, fq * 8), boff = lds_byte(wc * 32 + fr, fq * 8);
    Unit cur, nxt; int ui = 0;
    if (!S.next(0, cur)) return;
    unsigned vA0[2], vA1[2], vB[2];
    const char* cA; const char* cB; size_t hA, hB; int nt;
#define GS_SETOFF(u) do { Ops _o; S.ops((u), _o); cA = _o.A; cB = _o.B; nt = _o.nt; hB = (size_t)HALF * _o.ldb; hA = GATHER ? (size_t)0 : (size_t)HALF * _o.lda; \
        _Pragma("unroll") for (int _i = 0; _i < 2; ++_i) { int _R, _C; stage_rc(tid * 16 + _i * 8192, _R, _C); const int _Rb = (_R & ~31) + perm32(_R & 31); \
        if constexpr (GATHER) { vA0[_i] = (unsigned)_o.rows[_R] * _o.lda + (unsigned)_C * 2u; vA1[_i] = (unsigned)_o.rows[HALF + _R] * _o.lda + (unsigned)_C * 2u; } \
        else { vA0[_i] = (unsigned)_R * _o.lda + (unsigned)_C * 2u; vA1[_i] = 0u; } \
        vB[_i] = (unsigned)_Rb * _o.ldb + (unsigned)_C * 2u; } } while (0)
#define GS_SA(b, h) (((b) * 2 + (h)) * HTB)
#define GS_SB(b, h) ((4 + (b) * 2 + (h)) * HTB)
#define GS_STAGE(bufoff, gbase, voff) do { _Pragma("unroll") for (int _i = 0; _i < 2; ++_i) \
        __builtin_amdgcn_global_load_lds((const unsigned*)((const char*)(gbase) + (voff)[_i]), (LAS unsigned*)(lds + (bufoff) + ldsw + _i * 8192), 16, 0, 0); } while (0)
#define GS_STAGE_A1(bufoff, gbase) do { if constexpr (GATHER) { GS_STAGE(bufoff, gbase, vA1); } else { GS_STAGE(bufoff, (gbase) + hA, vA0); } } while (0)
#define GS_LDA(dst, b, h) do { _Pragma("unroll") for (int m = 0; m < 4; ++m) _Pragma("unroll") for (int k = 0; k < 2; ++k) dst[m][k] = *(const LAS bf16x8*)(lds + GS_SA(b, h) + aoff + m * 2048 + k * 1024); } while (0)
#define GS_LDB(dst, b, h) do { _Pragma("unroll") for (int n = 0; n < 2; ++n) _Pragma("unroll") for (int k = 0; k < 2; ++k) dst[n][k] = *(const LAS bf16x8*)(lds + GS_SB(b, h) + boff + n * 2048 + k * 1024); } while (0)
#define GS_MMA(ai, bj, At, Bt) do { __builtin_amdgcn_s_setprio(1); _Pragma("unroll") for (int m = 0; m < 4; ++m) _Pragma("unroll") for (int n = 0; n < 2; ++n) _Pragma("unroll") for (int k = 0; k < 2; ++k) { \
        if constexpr (Epi::I8) acc[ai][bj][m][n] = __builtin_bit_cast(f32x4, __builtin_amdgcn_mfma_i32_16x16x64_i8(__builtin_bit_cast(i32x4, Bt[n][k]), __builtin_bit_cast(i32x4, At[m][k]), __builtin_bit_cast(i32x4, acc[ai][bj][m][n]), 0, 0, 0)); \
        else acc[ai][bj][m][n] = __builtin_amdgcn_mfma_f32_16x16x32_bf16(Bt[n][k], At[m][k], acc[ai][bj][m][n], 0, 0, 0); } __builtin_amdgcn_s_setprio(0); } while (0)
#define GS_WAIT_V(n) asm volatile("s_waitcnt vmcnt(" #n ")" ::: "memory")
#define GS_WAIT_L(n) asm volatile("s_waitcnt lgkmcnt(" #n ")" ::: "memory")
#define GS_BAR __builtin_amdgcn_s_barrier()
#define GS_SCHED __builtin_amdgcn_sched_barrier(0)
    f32x4 acc[2][2][4][2];
#pragma unroll
    for (int a = 0; a < 2; ++a)
#pragma unroll
        for (int b = 0; b < 2; ++b)
#pragma unroll
            for (int m = 0; m < 4; ++m)
#pragma unroll
                for (int n = 0; n < 2; ++n) acc[a][b][m][n] = (f32x4){0.f, 0.f, 0.f, 0.f};
    bf16x8 At[4][2], B0[2][2], B1[2][2];
    GS_SETOFF(cur);
    const size_t kstep = (size_t)(BK * 2);
    GS_STAGE(GS_SB(0, 0), cB, vB); GS_STAGE(GS_SB(0, 1), cB + hB, vB); GS_STAGE(GS_SA(0, 0), cA, vA0); GS_STAGE_A1(GS_SA(0, 1), cA);
    if (wr == 1) GS_BAR;
    GS_WAIT_V(2); GS_BAR;
    GS_STAGE(GS_SB(1, 0), cB + kstep, vB); GS_STAGE(GS_SA(1, 0), cA + kstep, vA0); GS_STAGE(GS_SB(1, 1), cB + hB + kstep, vB);
    GS_WAIT_V(6); GS_BAR;
    for (;;) {
        const bool has_next = S.next(ui + 1, nxt);
        const int ntc = nt;
        for (int t = 0; t < ntc; t += 2) {
            const bool last = (t == ntc - 2);
            GS_LDB(B0, 0, 0); GS_LDB(B1, 0, 1); GS_SCHED; GS_LDA(At, 0, 0); GS_STAGE_A1(GS_SA(1, 1), cA + (size_t)(t + 1) * kstep);
            const char* a2; const char* b2;
            if (last) { if (has_next) { GS_SETOFF(nxt); } a2 = cA; b2 = cB; }
            else { a2 = cA + (size_t)(t + 2) * kstep; b2 = cB + (size_t)(t + 2) * kstep; }
            const char* a3 = a2 + kstep; const char* b3 = b2 + kstep;
            GS_WAIT_V(8); GS_WAIT_L(0); GS_BAR; GS_MMA(0, 0, At, B0); GS_MMA(0, 1, At, B1); GS_BAR; GS_SCHED;
            GS_LDA(At, 0, 1); GS_STAGE(GS_SB(0, 0), b2, vB); GS_STAGE(GS_SB(0, 1), b2 + hB, vB); GS_STAGE(GS_SA(0, 0), a2, vA0);
            GS_WAIT_V(8); GS_WAIT_L(0); GS_BAR; GS_MMA(1, 0, At, B0); GS_MMA(1, 1, At, B1); GS_BAR; GS_SCHED;
            GS_LDB(B0, 1, 0); GS_LDB(B1, 1, 1); GS_SCHED; GS_LDA(At, 1, 0); GS_STAGE_A1(GS_SA(0, 1), a2);
            GS_WAIT_V(8); GS_WAIT_L(0); GS_BAR; GS_MMA(0, 0, At, B0); GS_MMA(0, 1, At, B1); GS_BAR; GS_SCHED;
            GS_LDA(At, 1, 1); GS_STAGE(GS_SB(1, 0), b3, vB); GS_STAGE(GS_SB(1, 1), b3 + hB, vB); GS_STAGE(GS_SA(1, 0), a3, vA0);
            GS_WAIT_V(8); GS_WAIT_L(0); GS_BAR; GS_MMA(1, 0, At, B0); GS_MMA(1, 1, At, B1); GS_BAR; GS_SCHED;
        }
        if (wr == 0) GS_BAR;
        bool keep = false;
        if constexpr (Epi::KEEPS) keep = E.scale(acc, cur, wr, wc, fr, fq);
        else E(acc, cur, wr, wc, fr, fq);
        if (!has_next) break;
        if (!keep) {
#pragma unroll
        for (int a = 0; a < 2; ++a)
#pragma unroll
            for (int b = 0; b < 2; ++b)
#pragma unroll
                for (int m = 0; m < 4; ++m)
#pragma unroll
                    for (int n = 0; n < 2; ++n) acc[a][b][m][n] = (f32x4){0.f, 0.f, 0.f, 0.f};
        }
        cur = nxt; ++ui;
        if (wr == 1) GS_BAR;
    }
    GS_WAIT_V(0);
    GS_BAR;
#undef GS_SETOFF
#undef GS_SA
#undef GS_SB
#undef GS_STAGE
#undef GS_STAGE_A1
#undef GS_LDA
#undef GS_LDB
#undef GS_MMA
#undef GS_WAIT_V
#undef GS_WAIT_L
#undef GS_BAR
#undef GS_SCHED
}
}

struct Params {
    const float* in[31];
    float* out;
    unsigned char* ws;
    long long ph_lo, ph_hi;
};
enum { I_X = 0, I_C, I_CTX, I_CCTX, I_WMOD, I_BMOD, I_N1G, I_N2G, I_WIN, I_SGUNG, I_SGUW, I_SGUB, I_CONVW, I_LAMRE, I_LAMIM, I_LOGDT, I_BRE, I_BIM, I_CRE, I_CIM, I_S5D,
       I_GLUW, I_GLUB, I_WBR, I_WOUT, I_RW, I_RB, I_EWG, I_EWU, I_EWD, I_FNG };

struct Frame {
    LAS unsigned char* lds;
    int tid, lane, wave, blk;
};

__device__ __forceinline__ float wave_max(float v) {
    v = fmaxf(v, dpp_f<0xB1>(v)); v = fmaxf(v, dpp_f<0x4E>(v)); v = fmaxf(v, dpp_f<0x141>(v)); v = fmaxf(v, dpp_f<0x140>(v));
    const float a = __int_as_float(__builtin_amdgcn_readlane(__float_as_int(v), 0)), b = __int_as_float(__builtin_amdgcn_readlane(__float_as_int(v), 16)),
                c = __int_as_float(__builtin_amdgcn_readlane(__float_as_int(v), 32)), d = __int_as_float(__builtin_amdgcn_readlane(__float_as_int(v), 48));
    return fmaxf(fmaxf(a, b), fmaxf(c, d));
}
__device__ __forceinline__ unsigned q8x4(const f32x4 v, const float inv) {
    const unsigned a = __float_as_uint(__builtin_fmaf(v[0], inv, 12582912.0f)), b = __float_as_uint(__builtin_fmaf(v[1], inv, 12582912.0f));
    const unsigned c = __float_as_uint(__builtin_fmaf(v[2], inv, 12582912.0f)), d = __float_as_uint(__builtin_fmaf(v[3], inv, 12582912.0f));
    return __builtin_amdgcn_perm(__builtin_amdgcn_perm(d, c, 0x0c0c0400u), __builtin_amdgcn_perm(b, a, 0x0c0c0400u), 0x05040100u);
}
__device__ __forceinline__ void tr_item(const float* src, int ld_src, int k0, int c0, bf16_t* dst, int ld_dst, int r0, LAS float* scr, int lane) {
    f32x4 t[8];
#pragma unroll
    for (int i = 0; i < 8; ++i) t[i] = *(const f32x4*)(src + (size_t)(k0 + 8 * i + (lane >> 3)) * ld_src + c0 + 4 * (lane & 7));
#pragma unroll
    for (int i = 0; i < 8; ++i) { LAS float* d = scr + (8 * i + (lane >> 3)) * 33 + 4 * (lane & 7); d[0] = t[i][0]; d[1] = t[i][1]; d[2] = t[i][2]; d[3] = t[i][3]; }
    asm volatile("s_waitcnt lgkmcnt(0)" ::: "memory");
    const int c = lane & 7;
    float sv[4][8];
#pragma unroll
    for (int j = 0; j < 4; ++j) { const LAS float* s = scr + (8 * c) * 33 + (lane >> 3) + 8 * j;
#pragma unroll
        for (int i = 0; i < 8; ++i) sv[j][i] = s[i * 33]; }
#pragma unroll
    for (int j = 0; j < 4; ++j) { const int n = (lane >> 3) + 8 * j;
        u32x4 o; o.x = cvt_pk_bf16(sv[j][0], sv[j][1]); o.y = cvt_pk_bf16(sv[j][2], sv[j][3]); o.z = cvt_pk_bf16(sv[j][4], sv[j][5]); o.w = cvt_pk_bf16(sv[j][6], sv[j][7]);
        *(u32x4*)(dst + (size_t)(r0 + n) * ld_dst + k0 + 8 * c) = o; }
    asm volatile("s_waitcnt lgkmcnt(0)" ::: "memory");
}
__device__ __forceinline__ void tr_item_i8(const float* src, int ld_src, int k0, int c0, signed char* dst, int ld_dst, int r0, const unsigned* cmax_c0, float* scale_out, LAS float* scr, int lane) {
    f32x4 t[8];
#pragma unroll
    for (int i = 0; i < 8; ++i) t[i] = *(const f32x4*)(src + (size_t)(k0 + 8 * i + (lane >> 3)) * ld_src + c0 + 4 * (lane & 7));
#pragma unroll
    for (int i = 0; i < 8; ++i) { LAS float* d = scr + (8 * i + (lane >> 3)) * 33 + 4 * (lane & 7); d[0] = t[i][0]; d[1] = t[i][1]; d[2] = t[i][2]; d[3] = t[i][3]; }
    asm volatile("s_waitcnt lgkmcnt(0)" ::: "memory");
    const int n = lane & 31, hf = lane >> 5;
    const float cm = fmaxf(__uint_as_float(cmax_c0[n]), 1e-30f), inv = 127.0f / cm;
    if (scale_out && hf == 0) scale_out[n] = cm * (1.0f / 127.0f);
    u32x4 o[2];
#pragma unroll
    for (int h = 0; h < 2; ++h) {
        unsigned w[4];
#pragma unroll
        for (int x = 0; x < 4; ++x) { const LAS float* sp = scr + (32 * hf + 16 * h + 4 * x) * 33 + n; w[x] = q8x4((f32x4){sp[0], sp[33], sp[66], sp[99]}, inv); }
        o[h] = (u32x4){w[0], w[1], w[2], w[3]}; }
    *(u32x4*)(dst + (size_t)(r0 + n) * ld_dst + k0 + 32 * hf) = o[0]; *(u32x4*)(dst + (size_t)(r0 + n) * ld_dst + k0 + 32 * hf + 16) = o[1];
    asm volatile("s_waitcnt lgkmcnt(0)" ::: "memory");
}
__device__ __forceinline__ void colmax_win(const Params& p, const Frame& F) {
    unsigned* cmax = (unsigned*)(p.ws + OFF_CMAXW);
    for (int it = F.blk * NWAVE + F.wave; it < 768; it += NBLK * NWAVE) {
        const int l = it / 384, rem = it % 384, kb = rem / 24, cb = rem % 24;
        const float* src = p.in[I_WIN] + ((size_t)l * 1024 + 64 * kb) * 6144 + cb * 256 + 4 * F.lane;
        f32x4 m = (f32x4){0.f, 0.f, 0.f, 0.f};
#pragma unroll 16
        for (int i = 0; i < 64; ++i) { const f32x4 v = *(const f32x4*)(src + (size_t)i * 6144); m[0] = fmaxf(m[0], fabsf(v[0])); m[1] = fmaxf(m[1], fabsf(v[1])); m[2] = fmaxf(m[2], fabsf(v[2])); m[3] = fmaxf(m[3], fabsf(v[3])); }
        unsigned* dst = cmax + l * 6144 + cb * 256 + 4 * F.lane;
        atomicMax(dst + 0, __float_as_uint(m[0])); atomicMax(dst + 1, __float_as_uint(m[1])); atomicMax(dst + 2, __float_as_uint(m[2])); atomicMax(dst + 3, __float_as_uint(m[3]));
    }
}
__device__ __forceinline__ int win_col(int n) {
    if (n < 1536 || n >= 2560) return n;
    const int j = (n - 1536) >> 8, q = (n - 1536) & 255;
    return (q < 128) ? (1536 + 128 * j + q) : (2048 + 128 * j + (q - 128));
}
__device__ __forceinline__ void convert_mix(const Params& p, const Frame& F, int l, int part, int wslot, int nwslots) {
    LAS float* scr = (LAS float*)(F.lds + F.wave * 16384);
    bf16_t* WinT = (bf16_t*)(p.ws + OFF_WIN); bf16_t* WbrT = (bf16_t*)(p.ws + OFF_WBR); bf16_t* WoutT = (bf16_t*)(p.ws + OFF_WOUT); bf16_t* GluT = (bf16_t*)(p.ws + OFF_GLU);
    const int nit = part == 0 ? 3200 : (part == 1 ? 1280 : 4480);
    for (int it0 = wslot; it0 < nit; it0 += nwslots) {
        int r = part == 0 ? (it0 < 3072 ? it0 : it0 + 1280) : (part == 1 ? it0 + 3072 : it0);
        if (r < 3072) { const int kb = r / 192, nb = r % 192, oc = win_col(32 * nb);
            tr_item_i8(p.in[I_WIN] + (size_t)l * 1024 * 6144, 6144, 64 * kb, oc, (signed char*)WinT, 1024, 32 * nb, (const unsigned*)(p.ws + OFF_CMAXW) + l * 6144 + oc, kb == 0 ? (float*)(p.ws + OFF_SWIN) + l * 6144 + 32 * nb : nullptr, scr, F.lane); continue; }
        r -= 3072;
        if (r < 768) { const int br = r / 256, rem = r % 256, kb = rem / 32, nb = rem % 32; tr_item(p.in[I_WBR] + ((size_t)l * 3 + br) * 512 * 1024, 1024, 64 * kb, 32 * nb, WbrT + (size_t)br * 1024 * 512, 512, 32 * nb, scr, F.lane); continue; }
        r -= 768;
        if (r < 512) { const int kb = r / 32, nb = r % 32; tr_item(p.in[I_WOUT] + (size_t)l * 1024 * 1024, 1024, 64 * kb, 32 * nb, WoutT, 1024, 32 * nb, scr, F.lane); continue; }
        r -= 512;
        { const int kb = r / 16, nb = r % 16; tr_item(p.in[I_GLUW] + (size_t)l * 512 * 512, 512, 64 * kb, 32 * nb, GluT, 512, 32 * nb, scr, F.lane); }
    }
}
__device__ __forceinline__ void convert_experts(const Params& p, const Frame& F, int l, int slot, int nslots, int parts) {
    LAS float* scr = (LAS float*)(F.lds + 65536 + F.wave * 8448);
    LAS unsigned* cmx = (LAS unsigned*)(F.lds + 65536 + 8 * 8448);
    signed char* Wgu = (signed char*)(p.ws + OFF_WGU); bf16_t* Wd = (bf16_t*)(p.ws + OFF_WD); float* swgu = (float*)(p.ws + OFF_SWGU);
    const int lane = F.lane;
    if (parts & 1)
    for (int st = slot; st < 512; st += nslots) {
        const int e = st >> 5, nb = st & 31, n0 = 32 * nb, t = n0 >> 8, qq = n0 & 255, c0 = 128 * t + (qq & 127);
        const float* src = (qq < 128 ? p.in[I_EWG] : p.in[I_EWU]) + ((size_t)l * 16 + e) * 1024 * 512;
        __syncthreads();
        if (F.tid < 32) cmx[F.tid] = 0u;
        __syncthreads();
        f32x4 t0[8], t1[8];
#pragma unroll
        for (int i = 0; i < 8; ++i) { t0[i] = *(const f32x4*)(src + (size_t)(128 * F.wave + 8 * i + (lane >> 3)) * 512 + c0 + 4 * (lane & 7)); t1[i] = *(const f32x4*)(src + (size_t)(128 * F.wave + 64 + 8 * i + (lane >> 3)) * 512 + c0 + 4 * (lane & 7)); }
        f32x4 m = (f32x4){0.f, 0.f, 0.f, 0.f};
#pragma unroll
        for (int i = 0; i < 8; ++i) {
#pragma unroll
            for (int j = 0; j < 4; ++j) m[j] = fmaxf(m[j], fmaxf(fabsf(t0[i][j]), fabsf(t1[i][j]))); }
#pragma unroll
        for (int j = 0; j < 4; ++j) __hip_atomic_fetch_max(cmx + 4 * (lane & 7) + j, __float_as_uint(m[j]), __ATOMIC_RELAXED, __HIP_MEMORY_SCOPE_WORKGROUP);
        __syncthreads();
        const int n = lane & 31, hf = lane >> 5;
        const float cm = fmaxf(__uint_as_float(cmx[n]), 1e-30f), inv = 127.0f / cm;
        if (F.wave == 0 && hf == 0) swgu[e * 1024 + n0 + n] = cm * (1.0f / 127.0f);
#pragma unroll
        for (int tt = 0; tt < 2; ++tt) {
#pragma unroll
            for (int i = 0; i < 8; ++i) { LAS float* d = scr + (8 * i + (lane >> 3)) * 33 + 4 * (lane & 7); const f32x4 v = tt == 0 ? t0[i] : t1[i]; d[0] = v[0]; d[1] = v[1]; d[2] = v[2]; d[3] = v[3]; }
            asm volatile("s_waitcnt lgkmcnt(0)" ::: "memory");
            u32x4 o[2];
#pragma unroll
            for (int h = 0; h < 2; ++h) { unsigned w[4];
#pragma unroll
                for (int x = 0; x < 4; ++x) { const LAS float* sp = scr + (32 * hf + 16 * h + 4 * x) * 33 + n; w[x] = q8x4((f32x4){sp[0], sp[33], sp[66], sp[99]}, inv); }
                o[h] = (u32x4){w[0], w[1], w[2], w[3]}; }
            signed char* dp = Wgu + ((size_t)e * 1024 + n0 + n) * 1024 + 128 * F.wave + 64 * tt + 32 * hf;
            *(u32x4*)dp = o[0]; *(u32x4*)(dp + 16) = o[1];
            asm volatile("s_waitcnt lgkmcnt(0)" ::: "memory");
        }
    }
    if (parts & 2)
    for (int it = slot * NWAVE + F.wave; it < 4096; it += nslots * NWAVE) {
        const int e = it / 256, rem = it % 256, kb = rem / 32, nb = rem % 32;
        tr_item(p.in[I_EWD] + ((size_t)l * 16 + e) * 512 * 1024, 1024, 64 * kb, 32 * nb, Wd + (size_t)e * 1024 * 512, 512, 32 * nb, scr, F.lane);
    }
}

__device__ __forceinline__ void mod_items(const Params& p, const Frame& F) {
    LAS float* sc = (LAS float*)F.lds;
    LAS float* red = (LAS float*)(F.lds + 17 * 1024 * 4);
    float* mod = (float*)(p.ws + OFF_MOD);
    bool staged = false;
    __syncthreads();
    for (int it = F.blk; it < 384; it += NBLK) {
        if (!staged) {
            f32x4 tv[9];
#pragma unroll
            for (int x = 0; x < 8; ++x) tv[x] = *(const f32x4*)(p.in[I_C] + (F.tid + x * NTHR) * 4);
            tv[8] = *(const f32x4*)(p.in[I_CCTX] + (F.tid & 255) * 4);
#pragma unroll
            for (int x = 0; x < 9; ++x) { const int i = (x < 8 ? F.tid + x * NTHR : 4096 + (F.tid & 255)) * 4;
                if (x < 8 || F.tid < 256) *(LAS f32x4*)(sc + i) = (f32x4){siluf_(tv[x][0]), siluf_(tv[x][1]), siluf_(tv[x][2]), siluf_(tv[x][3])}; }
            staged = true;
        }
        __syncthreads();
        const int l = it / 192, n0 = (it % 192) * 32, ks = F.tid >> 5, cn = F.tid & 31;
        const float* w = p.in[I_WMOD] + (size_t)l * 1024 * 6144 + n0 + cn;
        float a[17];
#pragma unroll
        for (int mi = 0; mi < 17; ++mi) a[mi] = 0.f;
        for (int k0 = ks * 64; k0 < ks * 64 + 64; k0 += 16) { float wv[16];
#pragma unroll
            for (int x = 0; x < 16; ++x) wv[x] = w[(size_t)(k0 + x) * 6144];
#pragma unroll
            for (int x = 0; x < 16; ++x) {
#pragma unroll
                for (int mi = 0; mi < 17; ++mi) a[mi] += sc[mi * 1024 + k0 + x] * wv[x]; } }
#pragma unroll
        for (int mi = 0; mi < 17; ++mi) red[(ks * 17 + mi) * 32 + cn] = a[mi];
        __syncthreads();
        for (int i = F.tid; i < 17 * 32; i += NTHR) { const int mi = i >> 5, c2 = i & 31; float s = 0.f;
#pragma unroll
            for (int q = 0; q < 16; ++q) s += red[(q * 17 + mi) * 32 + c2];
            mod[((size_t)l * 17 + mi) * 6144 + n0 + c2] = s + p.in[I_BMOD][l * 6144 + n0 + c2]; }
    }
    __syncthreads();
}

__device__ __forceinline__ void s5_build_job(const Params& p, const Frame& F, int l, int job) {
    const int g = job >> 2, q = job & 3, tid = F.tid;
    LAS f32x2* ap = (LAS f32x2*)F.lds;
    LAS f32x2* bb = (LAS f32x2*)(F.lds + 34816);
    LAS f32x2* cc = (LAS f32x2*)(F.lds + 34816 + 16384);
    LAS f32x2* fz = (LAS f32x2*)(F.lds + 34816 + 32768);
    LAS float* kt = (LAS float*)(F.lds + 69632);
    LAS float* dvs = (LAS float*)(F.lds + 34816 + 32768 + 1024);
    __syncthreads();
    {
        const int pp = tid & 63, d = tid >> 8, tq = (tid >> 6) & 3, gi = (l * 2 + d) * 32 + g;
        const float ldt = p.in[I_LOGDT][gi], lr = p.in[I_LAMRE][gi * 64 + pp], li = p.in[I_LAMIM][gi * 64 + pp];
        if (tid < 16) dvs[tid] = p.in[I_S5D][l * 512 + g * 16 + tid];
        const float dt = expf(ldt), t0 = 8.0f * (float)tq;
        float sn, cs; const float m1 = expf(lr * dt); sincosf(li * dt, &sn, &cs); const float a1r = m1 * cs, a1i = m1 * sn;
        const float m0 = expf(lr * dt * t0); sincosf(li * dt * t0, &sn, &cs); float cr = m0 * cs, ci = m0 * sn;
        if (tq == 0) ap[(d * 33) * 64 + pp] = (f32x2){1.0f, 0.0f};
#pragma unroll
        for (int s_ = 1; s_ <= 8; ++s_) { const float nr = cr * a1r - ci * a1i, ni = cr * a1i + ci * a1r; cr = nr; ci = ni; ap[(d * 33 + 8 * tq + s_) * 64 + pp] = (f32x2){cr, ci}; }
    }
    if (tid < 128) {
        const int d = tid >> 6, pp = tid & 63, gi = (l * 2 + d) * 32 + g;
        const float dt = expf(p.in[I_LOGDT][gi]), lr = p.in[I_LAMRE][gi * 64 + pp], li = p.in[I_LAMIM][gi * 64 + pp];
        const float mag = expf(lr * dt); float sn, cs; sincosf(li * dt, &sn, &cs);
        const float abr = mag * cs, abi = mag * sn, den = lr * lr + li * li, nr = abr - 1.0f;
        fz[tid] = (f32x2){(nr * lr + abi * li) / den, (abi * lr - nr * li) / den};
    }
    __syncthreads();
    if (q == 0 && tid < 128) { const int d = tid >> 6, pp = tid & 63; const f32x2 a = ap[(d * 33 + 32) * 64 + pp]; float* aq = (float*)(p.ws + OFF_AQ) + ((((size_t)l * 2 + d) * 32 + g) * 64 + pp) * 2; aq[0] = a.x; aq[1] = a.y; }
#pragma unroll
    for (int it = 0; it < 4; ++it) { const int i = tid + it * NTHR;
        { const int d = i >> 10, pp = (i >> 4) & 63, h = i & 15; const size_t gi = ((((size_t)l * 2 + d) * 32 + g) * 64 + pp) * 16 + h;
          const float br = p.in[I_BRE][gi], bi = p.in[I_BIM][gi]; const f32x2 f = fz[d * 64 + pp]; bb[i] = (f32x2){f.x * br - f.y * bi, f.x * bi + f.y * br}; }
        { const int d = i >> 10, h = (i >> 6) & 15, pp = i & 63; const size_t gi = ((((size_t)l * 2 + d) * 32 + g) * 16 + h) * 64 + pp; cc[i] = (f32x2){p.in[I_CRE][gi], p.in[I_CIM][gi]}; }
    }
    __syncthreads();
    {
        const int hh = F.lane & 15, kg = F.lane >> 4;
        u32x4 bfr[2][4];
#pragma unroll
        for (int d = 0; d < 2; ++d)
#pragma unroll
            for (int ks = 0; ks < 4; ++ks) { unsigned w[4]; f32x2 bq[4];
#pragma unroll
                for (int jp = 0; jp < 4; ++jp) bq[jp] = bb[(d * 64 + 16 * ks + 4 * kg + jp) * 16 + hh];
#pragma unroll
                for (int jp = 0; jp < 4; ++jp) w[jp] = cvt_pk_bf16(bq[jp].x, bq[jp].y);
                bfr[d][ks] = (u32x4){w[0], w[1], w[2], w[3]}; }
        for (int tile = F.wave; tile < 64; tile += NWAVE) {
            const int d = tile >> 5, tau = tile & 31;
            f32x4 o = (f32x4){0.f, 0.f, 0.f, 0.f};
#pragma unroll
            for (int ks = 0; ks < 4; ++ks) { unsigned w[4];
                f32x2 cq[4], aq[4];
#pragma unroll
                for (int jp = 0; jp < 4; ++jp) { const int pp = 16 * ks + 4 * kg + jp; cq[jp] = cc[(d * 16 + hh) * 64 + pp]; aq[jp] = ap[(d * 33 + tau) * 64 + pp]; }
#pragma unroll
                for (int jp = 0; jp < 4; ++jp) { const f32x2 c = cq[jp], av = aq[jp];
                    w[jp] = cvt_pk_bf16(c.x * av.x - c.y * av.y, -(c.x * av.y + c.y * av.x)); }
                const u32x4 af = (u32x4){w[0], w[1], w[2], w[3]};
                o = __builtin_amdgcn_mfma_f32_16x16x32_bf16(__builtin_bit_cast(bf16x8, af), __builtin_bit_cast(bf16x8, d == 0 ? bfr[0][ks] : bfr[1][ks]), o, 0, 0, 0); }
#pragma unroll
            for (int r = 0; r < 4; ++r) kt[((d * 32 + tau) * 16 + 4 * kg + r) * 16 + hh] = o[r];
        }
    }
    __syncthreads();
    {
        bf16_t* WE = (bf16_t*)(p.ws + OFF_WE) + (size_t)g * 256 * 512;
        const int d = q >> 1, c = q & 1;
        for (int pc = tid; pc < 64 * 64; pc += NTHR) {
            const int pp = pc >> 6, col0 = (pc & 63) * 8, j = col0 >> 4, h0 = col0 & 15;
            const f32x2 a = ap[(d * 33 + (d == 0 ? 31 - j : j)) * 64 + pp];
            float v[8];
#pragma unroll
            for (int x = 0; x < 8; ++x) { const f32x2 b = bb[(d * 64 + pp) * 16 + h0 + x]; v[x] = c == 0 ? (a.x * b.x - a.y * b.y) : (a.x * b.y + a.y * b.x); }
            u32x4 o; o.x = cvt_pk_bf16(v[0], v[1]); o.y = cvt_pk_bf16(v[2], v[3]); o.z = cvt_pk_bf16(v[4], v[5]); o.w = cvt_pk_bf16(v[6], v[7]);
            *(u32x4*)(WE + (size_t)(64 * q + pp) * 512 + col0) = o;
        }
    }
    {
        bf16_t* TW = (bf16_t*)(p.ws + OFF_TW) + (size_t)g * 512 * 768;
        for (int pc = tid; pc < 128 * 96; pc += NTHR) {
            const int rl = pc / 96, cp = pc % 96, rr = 128 * q + rl, i = rr >> 4, h = rr & 15, col0 = cp * 8;
            float v[8];
            if (col0 < 512) {
                const int j = col0 >> 4, h0 = col0 & 15;
#pragma unroll
                for (int x = 0; x < 8; ++x) {
                    const int hp = h0 + x; float val;
                    if (i > j) val = kt[((0 * 32 + (i - j)) * 16 + h) * 16 + hp];
                    else if (i < j) val = kt[((1 * 32 + (j - i)) * 16 + h) * 16 + hp];
                    else val = kt[((0 * 32 + 0) * 16 + h) * 16 + hp] + kt[((1 * 32 + 0) * 16 + h) * 16 + hp] + (h == hp ? dvs[h] : 0.f);
                    v[x] = val;
                }
            } else {
                const int n0 = col0 - 512, d = n0 >> 7, c = (n0 >> 6) & 1, p0 = n0 & 63, tau = d == 0 ? i + 1 : 32 - i;
#pragma unroll
                for (int x = 0; x < 8; ++x) { const f32x2 cv = cc[(d * 16 + h) * 64 + p0 + x], a = ap[(d * 33 + tau) * 64 + p0 + x];
                    v[x] = c == 0 ? (cv.x * a.x - cv.y * a.y) : -(cv.x * a.y + cv.y * a.x); }
            }
            u32x4 o; o.x = cvt_pk_bf16(v[0], v[1]); o.y = cvt_pk_bf16(v[2], v[3]); o.z = cvt_pk_bf16(v[4], v[5]); o.w = cvt_pk_bf16(v[6], v[7]);
            *(u32x4*)(TW + (size_t)rr * 768 + col0) = o;
        }
    }
    __syncthreads();
}

__device__ __forceinline__ bf16_t* hrow_ptr(const Params& p, int r) { return (bf16_t*)(p.ws + OFF_HB) + (size_t)r * D; }
__device__ __forceinline__ f32x4 bf4(const u32x2 w) { return (f32x4){bf_lo(w.x), bf_hi(w.x), bf_lo(w.y), bf_hi(w.y)}; }
__device__ __forceinline__ int mod_index(int r) { return r < TLAT ? (r >> 11) : 16; }

__device__ __forceinline__ void phase_norm1(const Params& p, const Frame& F, int l, bool dry = false) {
    const float* mod = (const float*)(p.ws + OFF_MOD);
    signed char* Xq = (signed char*)(p.ws + (dry ? 422 * MiB : OFF_XN)); float* sxa = (float*)(p.ws + (dry ? 460 * MiB : OFF_SXA));
    const bf16_t* Y = (const bf16_t*)(p.ws + OFF_Y);
    const int* pos = (const int*)(p.ws + OFF_POS);
    const int lane = F.lane, row0 = F.blk * 144 + F.wave * 18;
    int mypos = 0; if (l == 1 && lane < 36) mypos = pos[2 * row0 + lane];
    f32x4 ch[4], mg[4], ms[4], m2[4]; u32x2 ca[4], cb[4]; int cmi = -1;
#define N1_LOAD(rr, H, A, B) do { const int r_ = (rr); \
        if (l == 0) { const float* src_ = (r_ < TLAT) ? (p.in[I_X] + (size_t)r_ * D) : (p.in[I_CTX] + (size_t)(r_ - TLAT) * D); \
            _Pragma("unroll") for (int j = 0; j < 4; ++j) { H[j] = *(const f32x4*)(src_ + 4 * lane + 256 * j); A[j] = (u32x2){0u, 0u}; B[j] = (u32x2){0u, 0u}; } } \
        else { const bf16_t* hp_ = hrow_ptr(p, r_); const int q_ = 2 * (r_ - row0); \
            const bf16_t* y0_ = Y + (size_t)__builtin_amdgcn_readlane(mypos, q_) * D; const bf16_t* y1_ = Y + (size_t)__builtin_amdgcn_readlane(mypos, q_ + 1) * D; \
            _Pragma("unroll") for (int jj = 0; jj < 2; ++jj) { const int k_ = 8 * lane + 512 * jj; const u32x4 h_ = *(const u32x4*)(hp_ + k_), a_ = *(const u32x4*)(y0_ + k_), b_ = *(const u32x4*)(y1_ + k_); \
                H[2 * jj] = bf4((u32x2){h_.x, h_.y}); H[2 * jj + 1] = bf4((u32x2){h_.z, h_.w}); A[2 * jj] = (u32x2){a_.x, a_.y}; A[2 * jj + 1] = (u32x2){a_.z, a_.w}; B[2 * jj] = (u32x2){b_.x, b_.y}; B[2 * jj + 1] = (u32x2){b_.z, b_.w}; } } } while (0)
#define N1_K(j) (l == 0 ? 4 * lane + 256 * (j) : 8 * lane + 512 * ((j) >> 1) + 4 * ((j) & 1))
    N1_LOAD(row0, ch, ca, cb);
    for (int i = 0; i < 18; ++i) {
        const int r = row0 + i, mi = mod_index(r);
        f32x4 nh[4]; u32x2 na[4], nb[4];
        if (i + 1 < 18) N1_LOAD(r + 1, nh, na, nb);
        f32x4 v[4];
        if (mi != cmi) { cmi = mi; const float* gn = p.in[I_N1G] + l * D; const float* sh = mod + ((size_t)l * 17 + mi) * 6144; const float* sc = sh + 1024;
            const float* g2 = mod + ((size_t)(l > 0 ? l - 1 : 0) * 17 + mi) * 6144 + 5120;
#pragma unroll
            for (int j = 0; j < 4; ++j) { const int k = N1_K(j); mg[j] = *(const f32x4*)(gn + k) * (1.0f + *(const f32x4*)(sc + k)); ms[j] = *(const f32x4*)(sh + k); m2[j] = *(const f32x4*)(g2 + k); } }
        if (l == 0) {
#pragma unroll
            for (int j = 0; j < 4; ++j) v[j] = ch[j];
        } else {
            bf16_t* hp = dry ? (bf16_t*)(p.ws + 350 * MiB) + (size_t)r * D : hrow_ptr(p, r);
#pragma unroll
            for (int j = 0; j < 4; ++j) {
                const f32x4 gg = m2[j]; const u32x2 a = ca[j], b = cb[j];
                const f32x4 sm = (f32x4){bf_lo(a.x) + bf_lo(b.x), bf_hi(a.x) + bf_hi(b.x), bf_lo(a.y) + bf_lo(b.y), bf_hi(a.y) + bf_hi(b.y)};
                v[j] = ch[j] + gg * sm;
            }
#pragma unroll
            for (int jj = 0; jj < 2; ++jj) *(u32x4*)(hp + 8 * lane + 512 * jj) = pack8(v[2 * jj], v[2 * jj + 1]);
        }
        float ss = 0.f;
#pragma unroll
        for (int j = 0; j < 4; ++j) ss += (v[j][0] * v[j][0] + v[j][1] * v[j][1]) + (v[j][2] * v[j][2] + v[j][3] * v[j][3]);
        const float rs = __builtin_amdgcn_rsqf(wave_sum(ss) * (1.0f / D) + EPS);
        float am = 0.f;
#pragma unroll
        for (int j = 0; j < 4; ++j) { v[j] = v[j] * rs * mg[j] + ms[j]; am = fmaxf(am, fmaxf(fmaxf(fabsf(v[j][0]), fabsf(v[j][1])), fmaxf(fabsf(v[j][2]), fabsf(v[j][3])))); }
        am = fmaxf(wave_max(am), 1e-30f);
        const float inv = 127.0f * __builtin_amdgcn_rcpf(am);
#pragma unroll
        for (int jj = 0; jj < 2; ++jj) { const unsigned q0 = q8x4(v[2 * jj], inv), q1 = q8x4(v[2 * jj + 1], inv);
            if (l == 0) { *(unsigned*)(Xq + (size_t)r * D + 4 * lane + 512 * jj) = q0; *(unsigned*)(Xq + (size_t)r * D + 4 * lane + 512 * jj + 256) = q1; }
            else *(u32x2*)(Xq + (size_t)r * D + 8 * lane + 512 * jj) = (u32x2){q0, q1}; }
        if (lane == 0) sxa[r] = am * (1.0f / 127.0f);
#pragma unroll
        for (int j = 0; j < 4; ++j) { ch[j] = nh[j]; ca[j] = na[j]; cb[j] = nb[j]; }
    }
#undef N1_LOAD
#undef N1_K
}

__device__ __forceinline__ void phase_final(const Params& p, const Frame& F) {
    const float* mod = (const float*)(p.ws + OFF_MOD);
    const bf16_t* Y = (const bf16_t*)(p.ws + OFF_Y);
    const int* pos = (const int*)(p.ws + OFF_POS);
    const int lane = F.lane, row0 = F.blk * 128 + F.wave * 16;
    int mypos = 0; if (lane < 32) mypos = pos[2 * row0 + lane];
    f32x4 ch[4], m2[4], fg[4]; u32x2 ca[4], cb[4]; int cmi = -1;
#pragma unroll
    for (int j = 0; j < 4; ++j) fg[j] = *(const f32x4*)(p.in[I_FNG] + 4 * lane + 256 * j);
#define FN_LOAD(rr, H, A, B) do { const int r_ = (rr); const bf16_t* hp_ = hrow_ptr(p, r_); const int q_ = 2 * (r_ - row0); \
        const bf16_t* y0_ = Y + (size_t)__builtin_amdgcn_readlane(mypos, q_) * D; const bf16_t* y1_ = Y + (size_t)__builtin_amdgcn_readlane(mypos, q_ + 1) * D; \
        _Pragma("unroll") for (int j = 0; j < 4; ++j) { const int k_ = 4 * lane + 256 * j; H[j] = bf4(*(const u32x2*)(hp_ + k_)); A[j] = *(const u32x2*)(y0_ + k_); B[j] = *(const u32x2*)(y1_ + k_); } } while (0)
    FN_LOAD(row0, ch, ca, cb);
    for (int i = 0; i < 16; ++i) {
        const int r = row0 + i, mi = r >> 11;
        f32x4 nh[4]; u32x2 na[4], nb[4];
        if (i + 1 < 16) FN_LOAD(r + 1, nh, na, nb);
        float* hp = p.out + (size_t)r * D;
        if (mi != cmi) { cmi = mi; const float* g2 = mod + ((size_t)1 * 17 + mi) * 6144 + 5120;
#pragma unroll
            for (int j = 0; j < 4; ++j) m2[j] = *(const f32x4*)(g2 + 4 * lane + 256 * j); }
        f32x4 v[4]; float ss = 0.f;
#pragma unroll
        for (int j = 0; j < 4; ++j) {
            const int k = 4 * lane + 256 * j; const f32x4 gg = m2[j]; const u32x2 a = ca[j], b = cb[j];
            const f32x4 sm = (f32x4){bf_lo(a.x) + bf_lo(b.x), bf_hi(a.x) + bf_hi(b.x), bf_lo(a.y) + bf_lo(b.y), bf_hi(a.y) + bf_hi(b.y)};
            v[j] = ch[j] + gg * sm;
            ss += (v[j][0] * v[j][0] + v[j][1] * v[j][1]) + (v[j][2] * v[j][2] + v[j][3] * v[j][3]);
        }
        const float rs = __builtin_amdgcn_rsqf(wave_sum(ss) * (1.0f / D) + EPS);
#pragma unroll
        for (int j = 0; j < 4; ++j) { const int k = 4 * lane + 256 * j; *(f32x4*)(hp + k) = v[j] * rs * fg[j]; }
#pragma unroll
        for (int j = 0; j < 4; ++j) { ch[j] = nh[j]; ca[j] = na[j]; cb[j] = nb[j]; }
    }
#undef FN_LOAD
}

#define EPI_FENCE() asm volatile("" ::: "memory")
#define OPAQUE_S(x) asm volatile("" : "+s"(x))
struct SchedB {
    const char* Xn; const char* W; int l, c;
    __device__ __forceinline__ bool next(int i, gs::Unit& u) const {
        const int L = i * NBLK + c, nmain = (l == 0 ? 144 : 128) * 24, ntot = nmain + (l == 0 ? 0 : 32);
        if (L >= ntot) return false;
        int pm, pn;
        if (L < nmain) { gs::tile_order(gs::xcd_remap(L, nmain), l == 0 ? 144 : 128, 24, pm, pn); }
        else { const int x = L - nmain; pm = 128 + (x >> 1); pn = 10 + (x & 1); }
        u.pm = pm; u.pn = pn; u.kind = 0; u.aux = 0;
        return true;
    }
    __device__ __forceinline__ void ops(const gs::Unit& u, gs::Ops& o) const { o.A = Xn + (size_t)u.pm * 256 * 1024; o.B = W + (size_t)u.pn * 256 * 1024; o.lda = 1024; o.ldb = 1024; o.nt = 8; o.rows = nullptr; }
};
struct EpiB {
    static constexpr bool KEEPS = false, I8 = true;
    bf16_t *U, *V, *Bb, *P, *Ux; unsigned char* G8; const float* sxa; const float* swin;
    __device__ __forceinline__ void operator()(const f32x4 (&acc)[2][2][4][2], const gs::Unit& u, int wr, int wc, int fr, int fq) const {
        const int pn = u.pn, r0 = u.pm * 256 + wr * 64 + fr, c0 = wc * 32 + 8 * fq;
        f32x4 sw[2][2]; float sx[2][4];
#pragma unroll
        for (int bj = 0; bj < 2; ++bj) { sw[bj][0] = *(const f32x4*)(swin + pn * 256 + bj * 128 + c0); sw[bj][1] = *(const f32x4*)(swin + pn * 256 + bj * 128 + c0 + 4); }
#pragma unroll
        for (int ai = 0; ai < 2; ++ai)
#pragma unroll
            for (int m = 0; m < 4; ++m) sx[ai][m] = sxa[r0 + ai * 128 + m * 16];
#define DQ(ai, bj, m, n) (__builtin_convertvector(__builtin_bit_cast(i32x4, acc[ai][bj][m][n]), f32x4) * (sw[bj][n] * sx[ai][m]))
        if (pn < 6) {
            size_t z1 = 0, z2 = 0, z3 = 0; OPAQUE_S(z1); OPAQUE_S(z2); OPAQUE_S(z3); bf16_t *u_ = U + z1, *v_ = V + z2, *b_ = Bb + z3;
            bf16_t* O = pn < 2 ? u_ : (pn < 4 ? v_ : b_); const bool act = pn < 4; const int cb = (pn & 1) * 256 + c0;
#pragma unroll
            for (int ai = 0; ai < 2; ++ai)
#pragma unroll
                for (int m = 0; m < 4; ++m) { bf16_t* rowp = O + (size_t)(r0 + ai * 128 + m * 16) * 512 + cb;
#pragma unroll
                    for (int bj = 0; bj < 2; ++bj) { f32x4 v0 = DQ(ai, bj, m, 0), v1 = DQ(ai, bj, m, 1);
                        if (act) { v0 = gelu4(v0); v1 = gelu4(v1); }
                        *(u32x4*)(rowp + bj * 128) = pack8(v0, v1); }
                    EPI_FENCE(); }
        } else if (pn < 10) {
            const int cb = (pn - 6) * 128 + c0;
#pragma unroll
            for (int ai = 0; ai < 2; ++ai)
#pragma unroll
                for (int m = 0; m < 4; ++m) {
                    *(u32x4*)(P + (size_t)(r0 + ai * 128 + m * 16) * 512 + cb) = pack8(DQ(ai, 0, m, 0) * DQ(ai, 1, m, 0), DQ(ai, 0, m, 1) * DQ(ai, 1, m, 1));
                    EPI_FENCE(); }
        } else if (pn >= 12) {
            const int cb = (pn - 12) * 256 + wc * 64 + fq * 16;
#pragma unroll
            for (int ai = 0; ai < 2; ++ai)
#pragma unroll
                for (int m = 0; m < 4; ++m) { unsigned char* rowp = G8 + (size_t)(r0 + ai * 128 + m * 16) * 3072 + cb; unsigned wq[2][2];
#pragma unroll
                    for (int bj = 0; bj < 2; ++bj)
#pragma unroll
                        for (int n = 0; n < 2; ++n) wq[bj][n] = gate4_u8_t(__builtin_convertvector(__builtin_bit_cast(i32x4, acc[ai][bj][m][n]), f32x4) * (sw[bj][n] * (sx[ai][m] * -1.44269504089f)) + (-8.0f));
                    *(u32x4*)rowp = (u32x4){wq[0][0], wq[0][1], wq[1][0], wq[1][1]};
                    EPI_FENCE(); }
        } else {
#pragma unroll
            for (int ai = 0; ai < 2; ++ai)
#pragma unroll
                for (int m = 0; m < 4; ++m) { const int r = r0 + ai * 128 + m * 16, ch = r >> 5, ii = r & 31;
#pragma unroll
                    for (int bj = 0; bj < 2; ++bj) { const int cch = (pn - 10) * 256 + bj * 128 + c0, g = cch >> 4, h0 = cch & 15;
                        *(u32x4*)(Ux + ((size_t)g * NCHP + ch) * 768 + ii * 16 + h0) = pack8(DQ(ai, bj, m, 0), DQ(ai, bj, m, 1)); }
                    EPI_FENCE(); }
        }
#undef DQ
    }
};
struct SchedE {
    const char* Ux; const char* WE; int c;
    __device__ __forceinline__ bool next(int i, gs::Unit& u) const {
        const int L = i * NBLK + c; if (L >= 160) return false;
        u.pm = L % 5; u.pn = 0; u.kind = 0; u.aux = L / 5;
        return true;
    }
    __device__ __forceinline__ void ops(const gs::Unit& u, gs::Ops& o) const { o.A = Ux + ((size_t)u.aux * NCHP + u.pm * 256) * 1536; o.B = WE + (size_t)u.aux * 256 * 1024; o.lda = 1536; o.ldb = 1024; o.nt = 8; o.rows = nullptr; }
};
struct EpiE {
    static constexpr bool KEEPS = false, I8 = false;
    float* E;
    __device__ __forceinline__ void operator()(const f32x4 (&acc)[2][2][4][2], const gs::Unit& u, int wr, int wc, int fr, int fq) const {
        const int g = u.aux, m0 = u.pm * 256 + wr * 64 + fr, c0 = wc * 32 + 8 * fq;
#pragma unroll
        for (int ai = 0; ai < 2; ++ai)
#pragma unroll
            for (int m = 0; m < 4; ++m) { const int mm = m0 + ai * 128 + m * 16;
                if (mm < NCH) { float* rowp = E + ((size_t)g * NCH + mm) * 256 + c0;
#pragma unroll
                    for (int bj = 0; bj < 2; ++bj) { *(f32x4*)(rowp + bj * 128) = acc[ai][bj][m][0]; *(f32x4*)(rowp + bj * 128 + 4) = acc[ai][bj][m][1]; } }
                EPI_FENCE(); }
    }
};
struct SchedY {
    const char* Ux; const char* TW; int l, c;
    __device__ __forceinline__ bool next(int i, gs::Unit& u) const {
        const int npm = l == 0 ? 5 : 4, ntot = 32 * npm * 2, L = i * NBLK + c; if (L >= ntot) return false;
        const int g = L / (npm * 2), rem = L % (npm * 2);
        u.pm = rem >> 1; u.pn = rem & 1; u.kind = 0; u.aux = g;
        return true;
    }
    __device__ __forceinline__ void ops(const gs::Unit& u, gs::Ops& o) const { o.A = Ux + ((size_t)u.aux * NCHP + u.pm * 256) * 1536; o.B = TW + ((size_t)u.aux * 512 + u.pn * 256) * 1536; o.lda = 1536; o.ldb = 1536; o.nt = 12; o.rows = nullptr; }
};
struct EpiY {
    static constexpr bool KEEPS = false, I8 = false;
    bf16_t* Z;
    __device__ __forceinline__ void operator()(const f32x4 (&acc)[2][2][4][2], const gs::Unit& u, int wr, int wc, int fr, int fq) const {
        const int g = u.aux, m0 = u.pm * 256 + wr * 64 + fr, c0 = u.pn * 256 + wc * 32 + 8 * fq;
#pragma unroll
        for (int ai = 0; ai < 2; ++ai)
#pragma unroll
            for (int m = 0; m < 4; ++m) { const int mm = m0 + ai * 128 + m * 16;
                if (mm < NCH) {
#pragma unroll
                    for (int bj = 0; bj < 2; ++bj) { const int cn = c0 + bj * 128, ii = cn >> 4, h0 = cn & 15; const f32x4 v0 = gelu4(acc[ai][bj][m][0]), v1 = gelu4(acc[ai][bj][m][1]);
                        *(u32x4*)(Z + ((size_t)mm * 32 + ii) * 512 + g * 16 + h0) = pack8(v0, v1); } }
                EPI_FENCE(); }
    }
};
struct SchedF {
    const char* Z; const char* W; int l, c;
    __device__ __forceinline__ bool next(int i, gs::Unit& u) const {
        const int nM = l == 0 ? 144 : 128, ntot = nM * 2, L = i * NBLK + c; if (L >= ntot) return false;
        int pm, pn; gs::tile_order(gs::xcd_remap(L, ntot), nM, 2, pm, pn);
        u.pm = pm; u.pn = pn; u.kind = 0; u.aux = 0;
        return true;
    }
    __device__ __forceinline__ void ops(const gs::Unit& u, gs::Ops& o) const { o.A = Z + (size_t)u.pm * 256 * 1024; o.B = W + (size_t)u.pn * 256 * 1024; o.lda = 1024; o.ldb = 1024; o.nt = 8; o.rows = nullptr; }
};
struct EpiF {
    static constexpr bool KEEPS = false, I8 = false;
    const bf16_t* Z; bf16_t* Yc; const float* gb;
    __device__ __forceinline__ void operator()(const f32x4 (&acc)[2][2][4][2], const gs::Unit& u, int wr, int wc, int fr, int fq) const {
        const int r0 = u.pm * 256 + wr * 64 + fr, c0 = u.pn * 256 + wc * 32 + 8 * fq;
        f32x4 gbv[2][2];
#pragma unroll
        for (int bj = 0; bj < 2; ++bj) { gbv[bj][0] = *(const f32x4*)(gb + c0 + bj * 128); gbv[bj][1] = *(const f32x4*)(gb + c0 + bj * 128 + 4); }
#pragma unroll
        for (int ai = 0; ai < 2; ++ai)
#pragma unroll
            for (int mh = 0; mh < 2; ++mh) {
                u32x4 zw[4];
#pragma unroll
                for (int x = 0; x < 4; ++x) zw[x] = *(const u32x4*)(Z + (size_t)(r0 + ai * 128 + (mh * 2 + (x >> 1)) * 16) * 512 + c0 + (x & 1) * 128);
#pragma unroll
                for (int x = 0; x < 4; ++x) { const int m = mh * 2 + (x >> 1), bj = x & 1; const size_t ro = (size_t)(r0 + ai * 128 + m * 16) * 512 + c0;
                    f32x4 z0, z1; unpack8(zw[x], z0, z1);
                    f32x4 v0 = acc[ai][bj][m][0] + gbv[bj][0], v1 = acc[ai][bj][m][1] + gbv[bj][1];
#pragma unroll
                    for (int j = 0; j < 4; ++j) { v0[j] = z0[j] * sigmoidf_(v0[j]); v1[j] = z1[j] * sigmoidf_(v1[j]); }
                    *(u32x4*)(Yc + ro + bj * 128) = pack8(v0, v1); }
                EPI_FENCE(); }
    }
};
struct SchedG {
    const char* Y0; const char* Y1; const char* Y2; const char* Wbr; int l, c;
    __device__ __forceinline__ bool next(int i, gs::Unit& u) const {
        const int nM = l == 0 ? 144 : 128, ntile = nM * 4, tl = i / 3, s = i % 3, L = tl * NBLK + c; if (L >= ntile) return false;
        int pm, pn; gs::tile_order(gs::xcd_remap(L, ntile), nM, 4, pm, pn);
        u.pm = pm; u.pn = pn; u.kind = s; u.aux = 0;
        return true;
    }
    __device__ __forceinline__ void ops(const gs::Unit& u, gs::Ops& o) const {
        const int br = u.kind;
        size_t z1 = 0, z2 = 0, z3 = 0; OPAQUE_S(z1); OPAQUE_S(z2); OPAQUE_S(z3); const char *y0_ = Y0 + z1, *y1_ = Y1 + z2, *y2_ = Y2 + z3; const char* y = br == 0 ? y0_ : (br == 1 ? y1_ : y2_);
        o.A = y + (size_t)u.pm * 256 * 1024; o.B = Wbr + ((size_t)br * 1024 + u.pn * 256) * 1024; o.lda = 1024; o.ldb = 1024; o.nt = 8; o.rows = nullptr;
    }
};
__device__ __forceinline__ void u8x8_to_f32(const u32x2 w, f32x4& a, f32x4& b) {
    a = (f32x4){(float)(w.x & 255u), (float)((w.x >> 8) & 255u), (float)((w.x >> 16) & 255u), (float)(w.x >> 24)};
    b = (f32x4){(float)(w.y & 255u), (float)((w.y >> 8) & 255u), (float)((w.y >> 16) & 255u), (float)(w.y >> 24)};
    a = a + 0.5f; b = b + 0.5f;
}
struct EpiG {
    static constexpr bool KEEPS = true, I8 = false;
    const unsigned char* G8; bf16_t* merged;
    __device__ __forceinline__ bool scale(f32x4 (&acc)[2][2][4][2], const gs::Unit& u, int wr, int wc, int fr, int fq) const {
        const int s = u.kind, r0 = u.pm * 256 + wr * 64 + fr, c0 = u.pn * 256 + wc * 32 + 8 * fq;
        const unsigned char* gp = G8 + (size_t)r0 * 3072 + s * 1024 + u.pn * 256 + wc * 64 + fq * 16;
#pragma unroll
        for (int ai = 0; ai < 2; ++ai) {
            u32x4 ga4[4], gb4[4];
#pragma unroll
            for (int m = 0; m < 4; ++m) { const size_t o = (size_t)(ai * 128 + m * 16) * 3072; ga4[m] = *(const u32x4*)(gp + o); if (s < 2) gb4[m] = *(const u32x4*)(gp + o + 1024); }
#pragma unroll
            for (int x = 0; x < 8; ++x) { const int m = x >> 1, bj = x & 1;
                const u32x2 gax = bj == 0 ? (u32x2){ga4[m].x, ga4[m].y} : (u32x2){ga4[m].z, ga4[m].w};
                f32x4 n0, n1; u8x8_to_f32(gax, n0, n1);
                if (s < 2) { const u32x2 gbx = bj == 0 ? (u32x2){gb4[m].x, gb4[m].y} : (u32x2){gb4[m].z, gb4[m].w}; f32x4 d0, d1; u8x8_to_f32(gbx, d0, d1);
#pragma unroll
                    for (int j = 0; j < 4; ++j) { n0[j] *= __builtin_amdgcn_rcpf(d0[j]); n1[j] *= __builtin_amdgcn_rcpf(d1[j]); } }
                if (s == 2) { n0 = n0 * (1.0f / 256.0f); n1 = n1 * (1.0f / 256.0f); }
                acc[ai][bj][m][0] *= n0; acc[ai][bj][m][1] *= n1;
                if (s == 2) *(u32x4*)(merged + (size_t)(r0 + ai * 128 + m * 16) * 1024 + c0 + bj * 128) = pack8(acc[ai][bj][m][0], acc[ai][bj][m][1]); }
            EPI_FENCE(); }
        return s < 2;
    }
};
struct SchedH {
    const char* A; const char* W; int l, c;
    __device__ __forceinline__ bool next(int i, gs::Unit& u) const {
        const int nM = l == 0 ? 144 : 128, ntot = nM * 4, L = i * NBLK + c; if (L >= ntot) return false;
        int pm, pn; gs::tile_order(gs::xcd_remap(L, ntot), nM, 4, pm, pn);
        u.pm = pm; u.pn = pn; u.kind = 0; u.aux = 0;
        return true;
    }
    __device__ __forceinline__ void ops(const gs::Unit& u, gs::Ops& o) const { o.A = A + (size_t)u.pm * 256 * 2048; o.B = W + (size_t)u.pn * 256 * 2048; o.lda = 2048; o.ldb = 2048; o.nt = 16; o.rows = nullptr; }
};
template <int LZ> struct EpiH {
    static constexpr bool KEEPS = false, I8 = false;
    const float* xin; const float* cin; bf16_t* Hb; const float* mod;
    __device__ __forceinline__ void operator()(const f32x4 (&acc)[2][2][4][2], const gs::Unit& u, int wr, int wc, int fr, int fq) const {
        const int rt = u.pm * 256, c0 = u.pn * 256 + wc * 32 + 8 * fq;
        const bool lat = rt < TLAT; const int mi = lat ? (rt >> 11) : 16;
        size_t z1 = 0, z2 = 0; OPAQUE_S(z1); OPAQUE_S(z2);
        const float* base = lat ? (xin + z1 + (size_t)rt * D) : (cin + z2 + (size_t)(rt - TLAT) * D);
        bf16_t* hb = Hb + (size_t)rt * D;
        const float* g1 = mod + (size_t)mi * 6144 + 2048 + c0;
        f32x4 g1v[2][2];
#pragma unroll
        for (int bj = 0; bj < 2; ++bj) { g1v[bj][0] = *(const f32x4*)(g1 + bj * 128); g1v[bj][1] = *(const f32x4*)(g1 + bj * 128 + 4); }
#pragma unroll
        for (int ai = 0; ai < 2; ++ai)
#pragma unroll
            for (int m = 0; m < 4; ++m) {
                f32x4 hv[2][2]; const size_t rb_ = (size_t)(wr * 64 + fr + ai * 128 + m * 16) * D + c0;
#pragma unroll
                for (int bj = 0; bj < 2; ++bj) { const size_t ro = rb_ + bj * 128;
                    if constexpr (LZ == 1) { hv[bj][0] = *(const f32x4*)(base + ro); hv[bj][1] = *(const f32x4*)(base + ro + 4); }
                    else unpack8(*(const u32x4*)(hb + ro), hv[bj][0], hv[bj][1]); }
#pragma unroll
                for (int bj = 0; bj < 2; ++bj) { const size_t ro = rb_ + bj * 128;
                    *(u32x4*)(hb + ro) = pack8(hv[bj][0] + g1v[bj][0] * acc[ai][bj][m][0], hv[bj][1] + g1v[bj][1] * acc[ai][bj][m][1]); }
                EPI_FENCE(); }
    }
};
struct SchedK {
    const char* Xn2; const char* Wgu; const int* rowl; const LAS int* toff; int c;
    __device__ __forceinline__ bool next(int i, gs::Unit& u) const {
        const int nt_ = __builtin_amdgcn_readfirstlane(toff[16]), ntot = nt_ * 4, L = i * NBLK + c; if (L >= ntot) return false;
        const int w = gs::xcd_remap(L, ntot), mt = w >> 2; int e = 0;
        { const int ln = (int)__builtin_amdgcn_mbcnt_hi(~0u, __builtin_amdgcn_mbcnt_lo(~0u, 0u)), tv = toff[ln < 16 ? ln : 16];
          e = __builtin_popcountll(__ballot(ln >= 1 && ln < 16 && tv <= mt)); }
        u.pm = mt; u.pn = w & 3; u.kind = 0; u.aux = e;
        return true;
    }
    __device__ __forceinline__ void ops(const gs::Unit& u, gs::Ops& o) const { o.A = Xn2; o.B = Wgu + ((size_t)u.aux * 1024 + u.pn * 256) * 1024; o.lda = 1024; o.ldb = 1024; o.nt = 8; o.rows = rowl + u.pm * 256; }
};
struct EpiK {
    static constexpr bool KEEPS = false, I8 = true;
    bf16_t* He; const float* sxs; const float* swgu;
    __device__ __forceinline__ void operator()(const f32x4 (&acc)[2][2][4][2], const gs::Unit& u, int wr, int wc, int fr, int fq) const {
        const int r0 = u.pm * 256 + wr * 64 + fr, c0 = u.pn * 128 + wc * 32 + 8 * fq, t0 = u.aux * 1024 + u.pn * 256 + wc * 32 + 8 * fq;
        f32x4 sw[2][2]; float sx[2][4];
#pragma unroll
        for (int bj = 0; bj < 2; ++bj) { sw[bj][0] = *(const f32x4*)(swgu + t0 + bj * 128); sw[bj][1] = *(const f32x4*)(swgu + t0 + bj * 128 + 4); }
#pragma unroll
        for (int ai = 0; ai < 2; ++ai)
#pragma unroll
            for (int m = 0; m < 4; ++m) sx[ai][m] = sxs[r0 + ai * 128 + m * 16];
#define DQ(ai, bj, m, n) (__builtin_convertvector(__builtin_bit_cast(i32x4, acc[ai][bj][m][n]), f32x4) * (sw[bj][n] * sx[ai][m]))
#pragma unroll
        for (int ai = 0; ai < 2; ++ai)
#pragma unroll
            for (int m = 0; m < 4; ++m) { f32x4 v0 = DQ(ai, 0, m, 0), v1 = DQ(ai, 0, m, 1); const f32x4 u0 = DQ(ai, 1, m, 0), u1 = DQ(ai, 1, m, 1);
#pragma unroll
                for (int j = 0; j < 4; ++j) { v0[j] = siluf_(v0[j]) * u0[j]; v1[j] = siluf_(v1[j]) * u1[j]; }
                *(u32x4*)(He + (size_t)(r0 + ai * 128 + m * 16) * 512 + c0) = pack8(v0, v1);
                EPI_FENCE(); }
#undef DQ
    }
};
struct SchedL {
    const char* He; const char* Wd; const LAS int* toff; int c;
    __device__ __forceinline__ bool next(int i, gs::Unit& u) const {
        const int nt_ = __builtin_amdgcn_readfirstlane(toff[16]), ntot = nt_ * 4, L = i * NBLK + c; if (L >= ntot) return false;
        const int w = gs::xcd_remap(L, ntot), mt = w >> 2; int e = 0;
        { const int ln = (int)__builtin_amdgcn_mbcnt_hi(~0u, __builtin_amdgcn_mbcnt_lo(~0u, 0u)), tv = toff[ln < 16 ? ln : 16];
          e = __builtin_popcountll(__ballot(ln >= 1 && ln < 16 && tv <= mt)); }
        u.pm = mt; u.pn = w & 3; u.kind = 0; u.aux = e;
        return true;
    }
    __device__ __forceinline__ void ops(const gs::Unit& u, gs::Ops& o) const { o.A = He + (size_t)u.pm * 256 * 1024; o.B = Wd + ((size_t)u.aux * 1024 + u.pn * 256) * 1024; o.lda = 1024; o.ldb = 1024; o.nt = 8; o.rows = nullptr; }
};
struct EpiL {
    static constexpr bool KEEPS = false, I8 = false;
    bf16_t* Y; const float* wl;
    __device__ __forceinline__ void operator()(const f32x4 (&acc)[2][2][4][2], const gs::Unit& u, int wr, int wc, int fr, int fq) const {
        const int r0 = u.pm * 256 + wr * 64 + fr, c0 = u.pn * 256 + wc * 32 + 8 * fq;
        float wv[2][4];
#pragma unroll
        for (int ai = 0; ai < 2; ++ai)
#pragma unroll
            for (int m = 0; m < 4; ++m) wv[ai][m] = wl[r0 + ai * 128 + m * 16];
#pragma unroll
        for (int ai = 0; ai < 2; ++ai)
#pragma unroll
            for (int m = 0; m < 4; ++m) { const int r = r0 + ai * 128 + m * 16; const float w = wv[ai][m];
#pragma unroll
                for (int bj = 0; bj < 2; ++bj) *(u32x4*)(Y + (size_t)r * 1024 + c0 + bj * 128) = pack8(acc[ai][bj][m][0] * w, acc[ai][bj][m][1] * w);
                EPI_FENCE(); }
    }
};

__device__ __forceinline__ void phase_sgu(const Params& p, const Frame& F, int l) {
    bf16_t* U = (bf16_t*)(p.ws + OFF_U); const bf16_t* V = (const bf16_t*)(p.ws + OFF_V);
    const bf16_t* W16 = (const bf16_t*)(p.ws + OFF_SGUW16) + (size_t)l * 4 * 128 * 128;
    LAS float* mu = (LAS float*)F.lds; LAS float* rsd = mu + 128;
    LAS unsigned char* Vn = F.lds + 1024;
    LAS unsigned char* Wl = F.lds + 1024 + 128 * 264;
    const int nchunk = l == 0 ? 288 : 256, tid = F.tid, lane = F.lane, wave = F.wave;
    const float* gam = p.in[I_SGUNG] + l * 512;
    const int vk = tid >> 2, vpart = tid & 3;
    for (int un = 0; un < 2; ++un) {
        int cu, hd0, hd1;
        if (un == 0) { cu = F.blk; hd0 = 0; hd1 = 4; if (cu >= nchunk) continue; }
        else { const int x = F.blk - 128; if (x < 0 || 256 + (x >> 2) >= nchunk) continue; cu = 256 + (x >> 2); hd0 = x & 3; hd1 = hd0 + 1; }
        const int r0 = cu * 128;
        __syncthreads();
        {
            u32x4 w16[16];
#pragma unroll
            for (int x = 0; x < 16; ++x) w16[x] = *(const u32x4*)(V + (size_t)(r0 + wave * 16 + x) * 512 + lane * 8);
#pragma unroll
            for (int x = 0; x < 16; ++x) { const int k = wave * 16 + x; f32x4 a, b; unpack8(w16[x], a, b);
                const float sm = wave_sum((a[0] + a[1]) + (a[2] + a[3]) + (b[0] + b[1]) + (b[2] + b[3])), mean = sm * (1.0f / 512.0f);
                a = a - mean; b = b - mean;
                const float q = wave_sum((a[0] * a[0] + a[1] * a[1]) + (a[2] * a[2] + a[3] * a[3]) + (b[0] * b[0] + b[1] * b[1]) + (b[2] * b[2] + b[3] * b[3]));
                if (lane == 0) { mu[k] = mean; rsd[k] = 1.0f / sqrtf(q * (1.0f / 512.0f) + EPS); } }
        }
        u32x4 pv[4], pw[4]; f32x4 pg[4][2];
#define SGU_PREFETCH(hd_) do { _Pragma("unroll") for (int x = 0; x < 4; ++x) { pv[x] = *(const u32x4*)(V + (size_t)(r0 + vk) * 512 + (hd_) * 128 + vpart * 32 + x * 8); \
            pw[x] = *(const u32x4*)(W16 + (size_t)(hd_) * 16384 + (tid + x * 512) * 8); \
            pg[x][0] = *(const f32x4*)(gam + (hd_) * 128 + vpart * 32 + x * 8); pg[x][1] = *(const f32x4*)(gam + (hd_) * 128 + vpart * 32 + x * 8 + 4); } } while (0)
        SGU_PREFETCH(hd0);
        for (int hd = hd0; hd < hd1; ++hd) {
            __syncthreads();
            { const float m_ = mu[vk], r_ = rsd[vk];
#pragma unroll
              for (int x = 0; x < 4; ++x) { const int c = vpart * 32 + x * 8;
                  f32x4 a, b; unpack8(pv[x], a, b); const f32x4 ga = pg[x][0], gb = pg[x][1];
                  a = (a - m_) * r_ * ga; b = (b - m_) * r_ * gb;
                  u32x2 o0, o1; o0.x = cvt_pk_bf16(a[0], a[1]); o0.y = cvt_pk_bf16(a[2], a[3]); o1.x = cvt_pk_bf16(b[0], b[1]); o1.y = cvt_pk_bf16(b[2], b[3]);
                  *(LAS u32x2*)(Vn + vk * 264 + c * 2) = o0; *(LAS u32x2*)(Vn + vk * 264 + c * 2 + 8) = o1;
                  const int e8 = (tid + x * 512) * 8, qq = e8 >> 7, kk = e8 & 127; *(LAS u32x4*)(Wl + qq * 272 + kk * 2) = pw[x]; } }
            if (hd + 1 < hd1) SGU_PREFETCH(hd + 1);
            const int kg = lane >> 4, cl = wave * 16 + (lane & 15);
            u32x4 uw4[4];
            const size_t uoff = (size_t)(r0 + (lane & 15) + 16 * (kg & 1)) * 512 + hd * 128 + wave * 16 + 4 * (kg & 2);
#pragma unroll
            for (int qp = 0; qp < 4; ++qp) uw4[qp] = *(const u32x4*)(U + uoff + (size_t)(32 * qp) * 512);
            const float* bs = p.in[I_SGUB] + ((size_t)l * 4 + hd) * 128;
            float bqv[8];
#pragma unroll
            for (int qt = 0; qt < 8; ++qt) bqv[qt] = bs[qt * 16 + (lane & 15)];
            __syncthreads();
            f32x4 o[8];
#pragma unroll
            for (int qt = 0; qt < 8; ++qt) o[qt] = (f32x4){0.f, 0.f, 0.f, 0.f};
#pragma unroll
            for (int ks = 0; ks < 4; ++ks) {
                bf16x8 af, bfv[8];
#pragma unroll
                for (int j = 0; j < 8; ++j) af[j] = (short)*(const LAS bf16_t*)(Vn + (ks * 32 + kg * 8 + j) * 264 + cl * 2);
#pragma unroll
                for (int qt = 0; qt < 8; ++qt) bfv[qt] = *(const LAS bf16x8*)(Wl + (qt * 16 + (lane & 15)) * 272 + (ks * 32 + kg * 8) * 2);
                __builtin_amdgcn_sched_barrier(0);
#pragma unroll
                for (int qt = 0; qt < 8; ++qt) o[qt] = __builtin_amdgcn_mfma_f32_16x16x32_bf16(af, bfv[qt], o[qt], 0, 0, 0);
                __builtin_amdgcn_sched_barrier(0);
            }
#pragma unroll
            for (int qp = 0; qp < 4; ++qp) {
                u32x2 ua = (u32x2){uw4[qp].x, uw4[qp].y}, ub = (u32x2){uw4[qp].z, uw4[qp].w};
                { const auto r0_ = __builtin_amdgcn_permlane16_swap(ua.x, ub.x, false, false); ua.x = r0_[0]; ub.x = r0_[1];
                  const auto r1_ = __builtin_amdgcn_permlane16_swap(ua.y, ub.y, false, false); ua.y = r1_[0]; ub.y = r1_[1]; }
                u32x2 oa, ob; { const int qt = 2 * qp; const float bq = bqv[qt];
                    oa.x = cvt_pk_bf16(bf_lo(ua.x) * (o[qt][0] + bq), bf_hi(ua.x) * (o[qt][1] + bq)); oa.y = cvt_pk_bf16(bf_lo(ua.y) * (o[qt][2] + bq), bf_hi(ua.y) * (o[qt][3] + bq)); }
                { const int qt = 2 * qp + 1; const float bq = bqv[qt];
                    ob.x = cvt_pk_bf16(bf_lo(ub.x) * (o[qt][0] + bq), bf_hi(ub.x) * (o[qt][1] + bq)); ob.y = cvt_pk_bf16(bf_lo(ub.y) * (o[qt][2] + bq), bf_hi(ub.y) * (o[qt][3] + bq)); }
                { const auto r0_ = __builtin_amdgcn_permlane16_swap(oa.x, ob.x, false, false); oa.x = r0_[0]; ob.x = r0_[1];
                  const auto r1_ = __builtin_amdgcn_permlane16_swap(oa.y, ob.y, false, false); oa.y = r1_[0]; ob.y = r1_[1]; }
                *(u32x4*)(U + uoff + (size_t)(32 * qp) * 512) = (u32x4){oa.x, oa.y, ob.x, ob.y}; }
        }
#undef SGU_PREFETCH
    }
    __syncthreads();
}
__device__ __forceinline__ void phase_conv(const Params& p, const Frame& F, int l) {
    bf16_t* Bb = (bf16_t*)(p.ws + OFF_BB); const bf16_t* P = (const bf16_t*)(p.ws + OFF_P);
    const float* cw = p.in[I_CONVW] + l * 3 * 512;
    const int nrows = l == 0 ? TALL : TLAT, npc = nrows * 64;
    const int c = (F.tid & 63) * 8;
    const f32x4 w0a = *(const f32x4*)(cw + c), w0b = *(const f32x4*)(cw + c + 4), w1a = *(const f32x4*)(cw + 512 + c), w1b = *(const f32x4*)(cw + 512 + c + 4), w2a = *(const f32x4*)(cw + 1024 + c), w2b = *(const f32x4*)(cw + 1024 + c + 4);
    const int nv = 352, vb0 = F.blk < 160 ? F.blk : 160 + 2 * (F.blk - 160), nvb = F.blk < 160 ? 1 : 2;
    for (int vb = vb0; vb < vb0 + nvb; ++vb)
    for (int it = vb * NTHR + F.tid; it < npc; it += 2 * nv * NTHR) {
        const int it2 = it + nv * NTHR; const bool two = it2 < npc;
        const int r = it >> 6, r2 = two ? (it2 >> 6) : r;
        const int s = r < TLAT ? (r & 63) : ((r - TLAT) & 255), smax = r < TLAT ? 63 : 255, s2 = r2 < TLAT ? (r2 & 63) : ((r2 - TLAT) & 255), smax2 = r2 < TLAT ? 63 : 255;
        const u32x4 zero = (u32x4){0u, 0u, 0u, 0u};
        const u32x4 xc = *(const u32x4*)(P + (size_t)r * 512 + c), xp = s > 0 ? *(const u32x4*)(P + (size_t)(r - 1) * 512 + c) : zero, xn = s < smax ? *(const u32x4*)(P + (size_t)(r + 1) * 512 + c) : zero, xb = *(const u32x4*)(Bb + (size_t)r * 512 + c);
        const u32x4 yc = *(const u32x4*)(P + (size_t)r2 * 512 + c), yp = s2 > 0 ? *(const u32x4*)(P + (size_t)(r2 - 1) * 512 + c) : zero, yn = s2 < smax2 ? *(const u32x4*)(P + (size_t)(r2 + 1) * 512 + c) : zero, yb = *(const u32x4*)(Bb + (size_t)r2 * 512 + c);
        { f32x4 x0, x1, pa, pb, na, nb, b0, b1; unpack8(xc, x0, x1); unpack8(xp, pa, pb); unpack8(xn, na, nb); unpack8(xb, b0, b1);
          *(u32x4*)(Bb + (size_t)r * 512 + c) = pack8(b0 * (w0a * pa + w1a * x0 + w2a * na), b1 * (w0b * pb + w1b * x1 + w2b * nb)); }
        if (two) { f32x4 x0, x1, pa, pb, na, nb, b0, b1; unpack8(yc, x0, x1); unpack8(yp, pa, pb); unpack8(yn, na, nb); unpack8(yb, b0, b1);
          *(u32x4*)(Bb + (size_t)r2 * 512 + c) = pack8(b0 * (w0a * pa + w1a * x0 + w2a * na), b1 * (w0b * pb + w1b * x1 + w2b * nb)); }
    }
}
__device__ __forceinline__ void phase_scan(const Params& p, const Frame& F, int l) {
    if (F.blk >= 128) return;
    const int T = F.blk * NTHR + F.tid, pp = T & 63, g = (T >> 6) & 31, b = (T >> 11) & 15, dir = T >> 15;
    const float* E = (const float*)(p.ws + OFF_E) + (size_t)g * NCH * 256 + dir * 128 + pp;
    bf16_t* Ux = (bf16_t*)(p.ws + OFF_UX) + (size_t)g * NCHP * 768 + 512 + dir * 128 + pp;
    const float* aq = (const float*)(p.ws + OFF_AQ) + ((((size_t)l * 2 + dir) * 32 + g) * 64 + pp) * 2;
    const float ar = aq[0], ai = aq[1];
    float sr = 0.f, si = 0.f;
#define SCAN_M(st) (dir == 0 ? ((st) < 8 ? (1024 + b * 8 + (st)) : (b * 64 + ((st) - 8))) : ((st) < 8 ? (1024 + b * 8 + (7 - (st))) : (b * 64 + (71 - (st)))))
    for (int sb = 0; sb < 72; sb += 24) {
        float er[24], ei[24];
#pragma unroll
        for (int x = 0; x < 24; ++x) { const int m = SCAN_M(sb + x); er[x] = E[(size_t)m * 256]; ei[x] = E[(size_t)m * 256 + 64]; }
#pragma unroll
        for (int x = 0; x < 24; ++x) { const int m = SCAN_M(sb + x);
            Ux[(size_t)m * 768] = (bf16_t)(cvt_pk_bf16_f(sr, 0.f) & 0xffffu); Ux[(size_t)m * 768 + 64] = (bf16_t)(cvt_pk_bf16_f(si, 0.f) & 0xffffu);
            const float nr = ar * sr - ai * si + er[x], ni = ar * si + ai * sr + ei[x]; sr = nr; si = ni; }
    }
#undef SCAN_M
}
__device__ __forceinline__ void phase_router(const Params& p, const Frame& F, int l) {
    const float* mod = (const float*)(p.ws + OFF_MOD);
    signed char* Xq2 = (signed char*)(p.ws + OFF_XN); float* sx2 = (float*)(p.ws + OFF_SX2);
    LAS float* rw = (LAS float*)F.lds;
    LAS int* lsel = (LAS int*)(F.lds + 133632);
    LAS int* lrk = lsel + 288;
    LAS float* lgs = (LAS float*)(lrk + 288);
    int* sel = (int*)(p.ws + OFF_SEL); float* wsel = (float*)(p.ws + OFF_WSEL); int* lrank = (int*)(p.ws + OFF_LRANK); int* cnt = (int*)(p.ws + OFF_CNT);
    const int NR = l == 0 ? 144 : 128, RW = NR / 8, lane = F.lane;
    __syncthreads();
    { f32x4 wt[8];
#pragma unroll
      for (int x = 0; x < 8; ++x) wt[x] = *(const f32x4*)(p.in[I_RW] + (F.tid + x * NTHR) * 4);
#pragma unroll
      for (int x = 0; x < 8; ++x) { const int i = (F.tid + x * NTHR) * 4, kk = i >> 4, e = i & 15;
          const int k = 4 * ((kk & 511) >> 3) + 256 * (2 * (kk >> 9) + ((kk >> 2) & 1)) + (kk & 3);
          rw[e * 1024 + k] = wt[x][0]; rw[(e + 1) * 1024 + k] = wt[x][1]; rw[(e + 2) * 1024 + k] = wt[x][2]; rw[(e + 3) * 1024 + k] = wt[x][3]; } }
    __syncthreads();
    float rb[16];
#pragma unroll
    for (int e = 0; e < 16; ++e) rb[e] = p.in[I_RB][e];
    const int row0 = F.blk * NR + F.wave * RW;
    f32x4 chA[4], chB[4], mg[4], ms[4]; int cmi = -1;
#define RT_K(j) (8 * lane + 512 * ((j) >> 1) + 4 * ((j) & 1))
#define RT_LOAD(rr, H) do { const bf16_t* hp_ = hrow_ptr(p, (rr)); _Pragma("unroll") for (int jj = 0; jj < 2; ++jj) { const u32x4 w_ = *(const u32x4*)(hp_ + 8 * lane + 512 * jj); \
            H[2 * jj] = bf4((u32x2){w_.x, w_.y}); H[2 * jj + 1] = bf4((u32x2){w_.z, w_.w}); } } while (0)
#define RT_NORM(rr, V) do { const int r_ = (rr), mi_ = mod_index(r_); float ss_ = 0.f; \
        _Pragma("unroll") for (int j = 0; j < 4; ++j) ss_ += (V[j][0] * V[j][0] + V[j][1] * V[j][1]) + (V[j][2] * V[j][2] + V[j][3] * V[j][3]); \
        const float rs_ = __builtin_amdgcn_rsqf(wave_sum(ss_) * (1.0f / D) + EPS); \
        if (mi_ != cmi) { cmi = mi_; const float* gn_ = p.in[I_N2G] + l * D; const float* sh_ = mod + ((size_t)l * 17 + mi_) * 6144 + 3072; const float* sc_ = sh_ + 1024; \
            _Pragma("unroll") for (int j = 0; j < 4; ++j) { const int k_ = RT_K(j); mg[j] = *(const f32x4*)(gn_ + k_) * (1.0f + *(const f32x4*)(sc_ + k_)); ms[j] = *(const f32x4*)(sh_ + k_); } } \
        float am_ = 0.f; \
        _Pragma("unroll") for (int j = 0; j < 4; ++j) { V[j] = V[j] * rs_ * mg[j] + ms[j]; am_ = fmaxf(am_, fmaxf(fmaxf(fabsf(V[j][0]), fabsf(V[j][1])), fmaxf(fabsf(V[j][2]), fabsf(V[j][3])))); } \
        am_ = fmaxf(wave_max(am_), 1e-30f); const float inv_ = 127.0f * __builtin_amdgcn_rcpf(am_); \
        _Pragma("unroll") for (int jj = 0; jj < 2; ++jj) *(u32x2*)(Xq2 + (size_t)r_ * D + 8 * lane + 512 * jj) = (u32x2){q8x4(V[2 * jj], inv_), q8x4(V[2 * jj + 1], inv_)}; \
        if (lane == 0) sx2[r_] = am_ * (1.0f / 127.0f); } while (0)
#define RT_REDUCE(SX, LX) do { float k8_[8], k4_[4], k2_[2]; \
        _Pragma("unroll") for (int q = 0; q < 8; ++q) { const float keep = b3 ? SX[q + 8] : SX[q], send = b3 ? SX[q] : SX[q + 8]; k8_[q] = keep + dpp_f<0x128>(send); } \
        _Pragma("unroll") for (int q = 0; q < 4; ++q) { const float keep = b2 ? k8_[q + 4] : k8_[q], send = b2 ? k8_[q] : k8_[q + 4]; k4_[q] = keep + dpp_f<0x141>(send); } \
        _Pragma("unroll") for (int q = 0; q < 2; ++q) { const float keep = b1 ? k4_[q + 2] : k4_[q], send = b1 ? k4_[q] : k4_[q + 2]; k2_[q] = keep + dpp_f<0x4E>(send); } \
        { const float keep = b0 ? k2_[1] : k2_[0], send = b0 ? k2_[0] : k2_[1]; LX = keep + dpp_f<0xB1>(send); } } while (0)
    const bool b3 = (lane & 8) != 0, b2 = (lane & 4) != 0, b1 = (lane & 2) != 0, b0 = (lane & 1) != 0;
    RT_LOAD(row0, chA); RT_LOAD(row0 + 1, chB);
    for (int i = 0; i < RW; i += 2) {
        const int lr_ = F.wave * RW + i, r = row0 + i;
        f32x4 nA[4], nB[4];
        if (i + 2 < RW) { RT_LOAD(r + 2, nA); RT_LOAD(r + 3, nB); }
        RT_NORM(r, chA); RT_NORM(r + 1, chB);
        float sxA[16], sxB[16]; f32x4 wq[2][4];
#pragma unroll
        for (int j = 0; j < 4; ++j) wq[0][j] = *(const LAS f32x4*)(rw + 4 * lane + 256 * j);
#pragma unroll
        for (int e = 0; e < 16; ++e) { f32x4 a4 = (f32x4){0.f, 0.f, 0.f, 0.f}, c4 = (f32x4){0.f, 0.f, 0.f, 0.f};
            if (e < 15) {
#pragma unroll
                for (int j = 0; j < 4; ++j) wq[(e + 1) & 1][j] = *(const LAS f32x4*)(rw + (e + 1) * 1024 + 4 * lane + 256 * j); }
            __builtin_amdgcn_sched_barrier(0);
#pragma unroll
            for (int j = 0; j < 4; ++j) { a4 += chA[j] * wq[e & 1][j]; c4 += chB[j] * wq[e & 1][j]; }
            sxA[e] = (a4[0] + a4[1]) + (a4[2] + a4[3]); sxB[e] = (c4[0] + c4[1]) + (c4[2] + c4[3]);
            __builtin_amdgcn_sched_barrier(0); }
        float lxA, lxB; RT_REDUCE(sxA, lxA); RT_REDUCE(sxB, lxB);
        lxA += __shfl_xor(lxA, 16); lxB += __shfl_xor(lxB, 16); lxA += __shfl_xor(lxA, 32); lxB += __shfl_xor(lxB, 32);
        if (lane < 16) { lgs[lr_ * 16 + lane] = lxA; lgs[(lr_ + 1) * 16 + lane] = lxB; }
#pragma unroll
        for (int j = 0; j < 4; ++j) { chA[j] = nA[j]; chB[j] = nB[j]; }
    }
#undef RT_LOAD
#undef RT_K
#undef RT_NORM
#undef RT_REDUCE
    asm volatile("s_waitcnt lgkmcnt(0)" ::: "memory");
    if (lane < RW) {
        const int lr_ = F.wave * RW + lane, r = row0 + lane;
        float sc_[16], bi[16];
#pragma unroll
        for (int e = 0; e < 16; ++e) { sc_[e] = 1.0f / (1.0f + expf(-lgs[lr_ * 16 + e])); bi[e] = sc_[e] + rb[e]; }
        int bg = 0; float bgs = -1e30f;
#pragma unroll
        for (int gq = 0; gq < 4; ++gq) { float m1 = -1e30f, m2 = -1e30f;
#pragma unroll
            for (int j = 0; j < 4; ++j) { const float x = bi[gq * 4 + j]; if (x > m1) { m2 = m1; m1 = x; } else if (x > m2) m2 = x; }
            const float gsum = m1 + m2; if (gsum > bgs) { bgs = gsum; bg = gq; } }
        float c4[4], s4[4];
#pragma unroll
        for (int j = 0; j < 4; ++j) { c4[j] = bg == 0 ? bi[j] : (bg == 1 ? bi[4 + j] : (bg == 2 ? bi[8 + j] : bi[12 + j])); s4[j] = bg == 0 ? sc_[j] : (bg == 1 ? sc_[4 + j] : (bg == 2 ? sc_[8 + j] : sc_[12 + j])); }
        int i1 = 0; float b1v = c4[0], w1 = s4[0];
#pragma unroll
        for (int j = 1; j < 4; ++j) if (c4[j] > b1v) { i1 = j; b1v = c4[j]; w1 = s4[j]; }
        int i2 = -1; float b2v = -1e30f, w2 = 0.f;
#pragma unroll
        for (int j = 0; j < 4; ++j) if (j != i1 && (i2 < 0 || c4[j] > b2v)) { i2 = j; b2v = c4[j]; w2 = s4[j]; }
        const float inv = 1.0f / (w1 + w2);
        const int e0 = bg * 4 + i1, e1 = bg * 4 + i2; sel[2 * r] = e0; sel[2 * r + 1] = e1; wsel[2 * r] = w1 * inv; wsel[2 * r + 1] = w2 * inv; lsel[2 * lr_] = e0; lsel[2 * lr_ + 1] = e1;
    }
    __syncthreads();
    int me = -1, myrank = 0;
    if (F.tid < 320) {
        me = F.tid < 2 * NR ? lsel[F.tid] : -1; int wc = 0;
        const unsigned long long below = (1ull << lane) - 1ull;
#pragma unroll
        for (int e = 0; e < 16; ++e) { const unsigned long long m = __ballot(me == e); if (me == e) myrank = __builtin_popcountll(m & below); if (lane == e) wc = __builtin_popcountll(m); }
        if (lane < 16) lrk[F.wave * 16 + lane] = wc;
    }
    __syncthreads();
    if (F.tid < 2 * NR) { int c = myrank;
#pragma unroll
        for (int w = 0; w < 4; ++w) c += (w < F.wave) ? lrk[w * 16 + me] : 0;
        lrank[2 * (F.blk * NR) + F.tid] = c; }
    if (F.tid >= 496) { const int e = F.tid - 496; cnt[F.blk * 16 + e] = (lrk[e] + lrk[16 + e]) + (lrk[32 + e] + lrk[48 + e]) + lrk[64 + e]; }
}
__device__ __forceinline__ void phase_lists(const Params& p, const Frame& F, int l) {
    LAS int* part = (LAS int*)F.lds;
    LAS int* tot = part + 512;
    LAS int* base = tot + 16;
    LAS int* toff = base + 16;
    const int* cnt = (const int*)(p.ws + OFF_CNT); const int* sel = (const int*)(p.ws + OFF_SEL); const float* wsel = (const float*)(p.ws + OFF_WSEL); const int* lrank = (const int*)(p.ws + OFF_LRANK);
    int* pos = (int*)(p.ws + OFF_POS); int* rowl = (int*)(p.ws + OFF_ROWL); float* wl = (float*)(p.ws + OFF_WL); int* seg = (int*)(p.ws + OFF_SEG);
    float* sxs = (float*)(p.ws + OFF_SXS); const float* sx2 = (const float*)(p.ws + OFF_SX2);
    const int NR = l == 0 ? 144 : 128;
    __syncthreads();
    { const int e = F.tid & 15, pt = F.tid >> 4; int s = 0, sb = 0;
      int cv[8];
#pragma unroll
      for (int j = 0; j < 8; ++j) cv[j] = cnt[(pt * 8 + j) * 16 + e];
#pragma unroll
      for (int j = 0; j < 8; ++j) { s += cv[j]; if (pt * 8 + j < F.blk) sb += cv[j]; }
      part[pt * 16 + e] = s; part[512 + 64 + pt * 16 + e] = sb; }
    __syncthreads();
    if (F.tid < 16) { int s = 0, sb = 0;
#pragma unroll
        for (int pt = 0; pt < 32; ++pt) { s += part[pt * 16 + F.tid]; sb += part[576 + pt * 16 + F.tid]; }
        tot[F.tid] = s; base[F.tid] = sb; }
    __syncthreads();
    if (F.tid == 0) { int o = 0, tv[16];
#pragma unroll
        for (int e = 0; e < 16; ++e) tv[e] = tot[e];
#pragma unroll
        for (int e = 0; e < 16; ++e) { toff[e] = o; o += (tv[e] + 255) >> 8; }
        toff[16] = o; }
    __syncthreads();
    if (F.blk == 0 && F.tid < 17) seg[F.tid] = toff[F.tid];
    for (int i = F.tid; i < 2 * NR; i += NTHR) { const int idx = 2 * (F.blk * NR) + i, e = sel[idx], ps = toff[e] * 256 + base[e] + lrank[idx]; pos[idx] = ps; rowl[ps] = idx >> 1; wl[ps] = wsel[idx]; sxs[ps] = sx2[idx >> 1]; }
    if (F.blk < 16) { const int e = F.blk, lo = toff[e] * 256 + tot[e], hi = toff[e + 1] * 256; for (int i = lo + F.tid; i < hi; i += NTHR) { rowl[i] = 0; wl[i] = 0.f; sxs[i] = 0.f; } }
    __syncthreads();
}
__device__ __forceinline__ void load_toff(const Params& p, const Frame& F) {
    LAS int* toff = (LAS int*)(F.lds + LDS_CTL_OFF + 64);
    __syncthreads();
    if (F.tid < 17) toff[F.tid] = ((const int*)(p.ws + OFF_SEG))[F.tid];
    __syncthreads();
}

#define OPAQUE_V(x) asm volatile("" : "+v"(x))
#define PHASE_ENTER() Frame F; { int t_ = threadIdx.x; OPAQUE_V(t_); F.tid = t_; F.lane = t_ & 63; F.wave = __builtin_amdgcn_readfirstlane(t_ >> 6); int b_ = blockIdx.x; OPAQUE_S(b_); F.blk = b_; F.lds = (LAS unsigned char*)lds_raw; } \
    size_t wz_ = 0; OPAQUE_S(wz_); unsigned char* ws = p.ws + wz_; int l = l0; OPAQUE_S(l); (void)l; (void)ws
__global__ void __launch_bounds__(NTHR, 2) fwd_kernel(Params p) {
    extern __shared__ __attribute__((aligned(16))) unsigned char lds_raw[];
    for (int u = threadIdx.x; u < (LDS_BYTES - LDS_CTL_OFF) / 4; u += NTHR) ((LAS unsigned*)((LAS unsigned char*)lds_raw + LDS_CTL_OFF))[u] = 0u;
    __syncthreads();
#if !MK_LAUNCH_PER_PHASE
    XcdBarrier bar = xcd_barrier_post((unsigned*)(p.ws + OFF_CTL), (volatile LAS unsigned*)((LAS unsigned char*)lds_raw + LDS_CTL_OFF));
#define GRID_BAR() xcd_barrier(bar)
#else
#define GRID_BAR() do { } while (0)
#endif
    const int lo = (int)p.ph_lo, hi = (int)p.ph_hi;
#define IN(k) (lo <= (k) && (k) < hi)
#define SEAM(k) do { if (IN(k) && IN((k) + 1)) { GRID_BAR(); if ((REPEAT_MASK >> 16) & 1) GRID_BAR(); } } while (0)
#ifndef NPASS
#define NPASS 1
#endif
    for (int pass_ = 0; pass_ < NPASS; ++pass_) {
    if (pass_ > 0) GRID_BAR();
    if (PH_ON(0) && IN(0)) {
        const int l0 = 0;
        REP(0) { PHASE_ENTER();
        { bf16_t* w16 = (bf16_t*)(ws + OFF_SGUW16); const int i8 = (F.blk * NTHR + F.tid) * 8;
          for (int i = i8; i < 262144; i += NBLK * NTHR * 8) { const f32x4 a = *(const f32x4*)(p.in[I_SGUW] + i), b = *(const f32x4*)(p.in[I_SGUW] + i + 4); *(u32x4*)(w16 + i) = pack8(a, b); } }
        mod_items(p, F);
        if (F.blk >= 128) s5_build_job(p, F, 0, 255 - F.blk);
        __syncthreads();
        if (F.blk < 128) { colmax_win(p, F); convert_mix(p, F, 0, 1, F.blk * NWAVE + F.wave, 128 * NWAVE); } }
    }
    SEAM(0);
    for (int l0 = 0; l0 < DEPTH; ++l0) {
        const int pb = 1 + 12 * l0;
        if (PH_ON(1) && IN(pb + 0)) {
            for (int rep_ = 0; rep_ < 1 + (((REPEAT_MASK >> 1) & 1) && l0 == 0 ? 1 : 0); ++rep_) { PHASE_ENTER();
            if (l == 1) convert_mix(p, F, 1, 1, F.blk * NWAVE + F.wave, NBLK * NWAVE);
            else convert_mix(p, F, 0, 0, F.blk * NWAVE + F.wave, NBLK * NWAVE);
            if (((REPEAT_MASK >> 18) & 1) && l == 1) phase_norm1(p, F, l, true);
            phase_norm1(p, F, l); }
        }
        SEAM(pb + 0);
        if (PH_ON(2) && IN(pb + 1)) {
            REP(2) { PHASE_ENTER();
            SchedB S{(const char*)(ws + OFF_XN), (const char*)(ws + OFF_WIN), l, F.blk};
            EpiB E{(bf16_t*)(ws + OFF_U), (bf16_t*)(ws + OFF_V), (bf16_t*)(ws + OFF_BB), (bf16_t*)(ws + OFF_P), (bf16_t*)(ws + OFF_UX), ws + OFF_G8, (const float*)(ws + OFF_SXA), (const float*)(ws + OFF_SWIN) + (size_t)l * 6144};
            gs::gemm_stream<EpiB, SchedB, false>(F.lds, F.tid, S, E); }
        }
        SEAM(pb + 1);
        if (PH_ON(3) && IN(pb + 2)) {
            REP(3) { PHASE_ENTER(); SchedE S{(const char*)(ws + OFF_UX), (const char*)(ws + OFF_WE), F.blk}; EpiE E{(float*)(ws + OFF_E)}; gs::gemm_stream<EpiE, SchedE, false>(F.lds, F.tid, S, E); }
            { PHASE_ENTER(); phase_conv(p, F, l); }
        }
        SEAM(pb + 2);
        if (PH_ON(4) && IN(pb + 3)) { REP(4) { PHASE_ENTER(); phase_scan(p, F, l); } { PHASE_ENTER(); phase_sgu(p, F, l); } }
        SEAM(pb + 3);
        if (PH_ON(5) && IN(pb + 4)) REP(5) { PHASE_ENTER(); SchedY S{(const char*)(ws + OFF_UX), (const char*)(ws + OFF_TW), l, F.blk}; EpiY E{(bf16_t*)(ws + OFF_V)}; gs::gemm_stream<EpiY, SchedY, false>(F.lds, F.tid, S, E); }
        SEAM(pb + 4);
        if (PH_ON(6) && IN(pb + 5)) REP(6) { PHASE_ENTER(); SchedF S{(const char*)(ws + OFF_V), (const char*)(ws + OFF_GLU), l, F.blk}; EpiF E{(const bf16_t*)(ws + OFF_V), (bf16_t*)(ws + OFF_P), p.in[I_GLUB] + l * 512}; gs::gemm_stream<EpiF, SchedF, false>(F.lds, F.tid, S, E); }
        SEAM(pb + 5);
        if (PH_ON(7) && IN(pb + 6)) {
            REP(7) { PHASE_ENTER();
            SchedG S{(const char*)(ws + OFF_U), (const char*)(ws + OFF_BB), (const char*)(ws + OFF_P), (const char*)(ws + OFF_WBR), l, F.blk};
            EpiG E{ws + OFF_G8, (bf16_t*)(ws + OFF_MERGED)};
            gs::gemm_stream<EpiG, SchedG, false>(F.lds, F.tid, S, E); }
            if (l0 == 0) {
                PHASE_ENTER();
                if (F.blk >= 64 && F.blk < 192) s5_build_job(p, F, 1, F.blk - 64);
                __syncthreads();
                if (F.blk >= 64) convert_mix(p, F, 1, 0, (F.blk - 64) * NWAVE + F.wave, 192 * NWAVE);
            }
        }
        SEAM(pb + 6);
        if (PH_ON(8) && IN(pb + 7)) {
            for (int rep_ = 0; rep_ < 1 + (((REPEAT_MASK >> 8) & 1) && l0 == 0 ? 1 : 0); ++rep_) { PHASE_ENTER();
            SchedH S{(const char*)(ws + OFF_MERGED), (const char*)(ws + OFF_WOUT), l, F.blk};
            if (l == 0) { EpiH<1> E{p.in[I_X], p.in[I_CTX], (bf16_t*)(ws + OFF_HB), (const float*)(ws + OFF_MOD) + (size_t)l * 17 * 6144}; gs::gemm_stream<EpiH<1>, SchedH, false>(F.lds, F.tid, S, E); }
            else { EpiH<0> E{p.in[I_X], p.in[I_CTX], (bf16_t*)(ws + OFF_HB), (const float*)(ws + OFF_MOD) + (size_t)l * 17 * 6144}; gs::gemm_stream<EpiH<0>, SchedH, false>(F.lds, F.tid, S, E); } }
            { PHASE_ENTER(); if (l == 0 && F.blk >= 64) convert_experts(p, F, 0, F.blk - 64, NBLK - 64, 3); }
        }
        SEAM(pb + 7);
        if (PH_ON(9) && IN(pb + 8)) { REP(9) { PHASE_ENTER(); phase_router(p, F, l); } REP(10) { PHASE_ENTER(); if (l == 1) convert_experts(p, F, l, F.blk, NBLK, 1); } }
        SEAM(pb + 8);
        if (PH_ON(10) && IN(pb + 9)) REP(13) { PHASE_ENTER(); phase_lists(p, F, l); }
        SEAM(pb + 9);
        if (PH_ON(11) && IN(pb + 10)) {
            REP(11) { PHASE_ENTER();
            load_toff(p, F);
            SchedK S{(const char*)(ws + OFF_XN), (const char*)(ws + OFF_WGU), (const int*)(ws + OFF_ROWL), (const LAS int*)(F.lds + LDS_CTL_OFF + 64), F.blk};
            EpiK E{(bf16_t*)(ws + OFF_HE), (const float*)(ws + OFF_SXS), (const float*)(ws + OFF_SWGU)};
            gs::gemm_stream<EpiK, SchedK, true>(F.lds, F.tid, S, E); }
            { PHASE_ENTER(); if (l == 1) { const int r = (__builtin_amdgcn_readfirstlane(((const LAS int*)(F.lds + LDS_CTL_OFF + 64))[16]) * 4) & 255;
                if (r == 0 || r > 128) convert_experts(p, F, 1, F.blk, NBLK, 2); else if (F.blk >= r) convert_experts(p, F, 1, F.blk - r, NBLK - r, 2); } }
        }
        SEAM(pb + 10);
        if (PH_ON(12) && IN(pb + 11)) {
            REP(12) { PHASE_ENTER();
            load_toff(p, F);
            SchedL S{(const char*)(ws + OFF_HE), (const char*)(ws + OFF_WD), (const LAS int*)(F.lds + LDS_CTL_OFF + 64), F.blk};
            EpiL E{(bf16_t*)(ws + OFF_Y), (const float*)(ws + OFF_WL)};
            gs::gemm_stream<EpiL, SchedL, false>(F.lds, F.tid, S, E); }
        }
        SEAM(pb + 11);
    }
    if (PH_ON(13) && IN(25)) { const int l0 = 1; REP(17) { PHASE_ENTER(); phase_final(p, F); } }
    }
#undef IN
#undef SEAM
}


extern "C" void kernel_launch(void* const* d_in, const int* in_sizes, int n_in, void* d_out, int out_size, void* d_ws, size_t ws_size, hipStream_t stream) {
    static int ready = 0;
    if (ready == 0) {
        if (n_in != 31 || out_size != TLAT * D || ws_size < WS_END) { fprintf(stderr, "kernel_launch: unexpected shapes (n_in %d out %d ws %zu)\n", n_in, out_size, ws_size); ready = -1; return; }
        if (hipFuncSetAttribute((const void*)fwd_kernel, hipFuncAttributeMaxDynamicSharedMemorySize, LDS_BYTES) != hipSuccess) { fprintf(stderr, "kernel_launch: hipFuncSetAttribute failed\n"); ready = -1; return; }
        int per_cu = 0;
        if (hipOccupancyMaxActiveBlocksPerMultiprocessor(&per_cu, (const void*)fwd_kernel, NTHR, LDS_BYTES) != hipSuccess || per_cu < 1) fprintf(stderr, "kernel_launch: occupancy query says %d\n", per_cu);
        (void)hipGetLastError();
        ready = 1;
    }
    if (ready < 0) return;
    (void)hipMemsetAsync((char*)d_ws + OFF_CTL, 0, CTL_ZERO_BYTES, stream);
    Params p{};
    for (int i = 0; i < 31; ++i) p.in[i] = (const float*)d_in[i];
    p.out = (float*)d_out; p.ws = (unsigned char*)d_ws;
#if MK_LAUNCH_PER_PHASE
    for (int ph = 0; ph < 26; ++ph) { p.ph_lo = ph; p.ph_hi = ph + 1; hipLaunchKernelGGL(fwd_kernel, dim3(NBLK), dim3(NTHR), LDS_BYTES, stream, p); }
#else
    p.ph_lo = 0; p.ph_hi = 26;
    hipLaunchKernelGGL(fwd_kernel, dim3(NBLK), dim3(NTHR), LDS_BYTES, stream, p);
#endif
}
```

```cpp
#include <hip/hip_runtime.h>
#include <cstdio>
#include <cstdint>

#ifndef MK_LAUNCH_PER_PHASE
#define MK_LAUNCH_PER_PHASE 0
#endif

#ifndef PHASE_MASK
#define PHASE_MASK 0xFFFF
#endif
#define PH_ON(k) (((PHASE_MASK) >> (k)) & 1)
#ifndef REPEAT_MASK
#define REPEAT_MASK 0
#endif
#define REP(k) for (int rep_ = 0; rep_ < 1 + ((REPEAT_MASK >> (k)) & 1); ++rep_)
#define LAS __attribute__((address_space(3)))
#define GAS __attribute__((address_space(1)))
typedef unsigned short bf16_t;
typedef short bf16x8 __attribute__((ext_vector_type(8)));
typedef float f32x4 __attribute__((ext_vector_type(4)));
typedef float f32x2 __attribute__((ext_vector_type(2)));
typedef unsigned u32x4 __attribute__((ext_vector_type(4)));
typedef unsigned u32x2 __attribute__((ext_vector_type(2)));
typedef int i32x4 __attribute__((ext_vector_type(4)));

constexpr int D = 1024, TLAT = 32768, TCTX = 4096, TALL = 36864, DEPTH = 2;
constexpr int NBLK = 256, NTHR = 512, NWAVE = 8;
constexpr int NCH = 1152, NCHP = 1280, SQ = 32;
constexpr float EPS = 1e-6f;
constexpr int MAXROWS = 77824;

constexpr size_t MiB = 1u << 20;
constexpr size_t OFF_CTL = 0, CTL_ZERO_BYTES = 65536 + 4096;
constexpr size_t OFF_FGCNT = OFF_CTL + 65536;
constexpr size_t OFF_YCCNT = OFF_FGCNT + 16 * 64;
constexpr size_t OFF_CMAXW = OFF_CTL + 16384;
constexpr size_t OFF_SXA = OFF_CTL + 393216;
constexpr size_t OFF_SWIN = OFF_CTL + 655360;
constexpr size_t OFF_SWGU = OFF_CTL + 720896;
constexpr size_t OFF_SX2 = OFF_CTL + 786432;
constexpr size_t OFF_SXS = 21 * MiB + 512 * 1024;
constexpr size_t OFF_SGUW16 = OFF_CTL + 131072;
constexpr size_t OFF_MOD = 1 * MiB;
constexpr size_t OFF_MISC = 2 * MiB;
constexpr size_t OFF_AQ = OFF_MISC;
constexpr size_t OFF_CNT = OFF_MISC + 64 * 1024;
constexpr size_t OFF_SEG = OFF_MISC + 80 * 1024;
constexpr size_t OFF_SEL = OFF_MISC + 128 * 1024;
constexpr size_t OFF_WSEL = OFF_MISC + 448 * 1024;
constexpr size_t OFF_LRANK = OFF_MISC + 768 * 1024;
constexpr size_t OFF_POS = OFF_MISC + 1088 * 1024;
constexpr size_t OFF_ROWL = OFF_MISC + 1408 * 1024;
constexpr size_t OFF_WL = OFF_MISC + 1728 * 1024;
constexpr size_t OFF_WIN = 4 * MiB;
constexpr size_t OFF_WBR = 16 * MiB;
constexpr size_t OFF_WOUT = 19 * MiB;
constexpr size_t OFF_GLU = 21 * MiB;
constexpr size_t OFF_WE = 22 * MiB;
constexpr size_t OFF_TW = 30 * MiB;
constexpr size_t OFF_HB = 54 * MiB;
constexpr size_t OFF_XN = 126 * MiB;
constexpr size_t OFF_U = 198 * MiB;
constexpr size_t OFF_V = 234 * MiB;
constexpr size_t OFF_BB = 270 * MiB;
constexpr size_t OFF_P = 306 * MiB;
constexpr size_t OFF_UX = 342 * MiB;
constexpr size_t OFF_G8 = 402 * MiB;
constexpr size_t WS_END = 510 * MiB;
constexpr size_t OFF_MERGED = OFF_XN;
constexpr size_t OFF_E = OFF_XN + 36 * MiB;
constexpr size_t OFF_Y = 198 * MiB;
constexpr size_t OFF_YSC = OFF_Y + 80 * MiB;
constexpr size_t OFF_HE = 350 * MiB;
constexpr size_t OFF_WGU = 426 * MiB;
constexpr size_t OFF_WD = 458 * MiB;
static_assert(OFF_Y + (size_t)MAXROWS * 1024 * 2 <= OFF_HE && OFF_HE + (size_t)MAXROWS * 512 * 2 <= OFF_WGU && OFF_WD + (size_t)16 * 1024 * 512 * 2 <= WS_END && OFF_G8 + (size_t)TALL * 3072 <= WS_END, "overlay map");

constexpr int RING_BYTES = 131072;
constexpr int LDS_CTL_OFF = 159744;
constexpr int LDS_BYTES = 160768;

__device__ __forceinline__ unsigned cvt_pk_bf16(float lo, float hi) { unsigned r; asm volatile("v_cvt_pk_bf16_f32 %0, %1, %2" : "=v"(r) : "v"(lo), "v"(hi)); return r; }
__device__ __forceinline__ unsigned cvt_pk_bf16_f(float lo, float hi) { unsigned r; asm("v_cvt_pk_bf16_f32 %0, %1, %2" : "=v"(r) : "v"(lo), "v"(hi)); return r; }
__device__ __forceinline__ float bf_lo(unsigned w) { return __uint_as_float(w << 16); }
__device__ __forceinline__ float bf_hi(unsigned w) { return __uint_as_float(w & 0xffff0000u); }
__device__ __forceinline__ float bf1(bf16_t b) { return __uint_as_float(((unsigned)b) << 16); }
__device__ __forceinline__ float sigmoidf_(float x) { return __builtin_amdgcn_rcpf(1.0f + __builtin_amdgcn_exp2f(-1.44269504089f * x)); }
__device__ __forceinline__ float siluf_(float x) { return x * sigmoidf_(x); }
__device__ __forceinline__ float geluf_(float x) { return x * sigmoidf_(1.59576912161f * x * (1.0f + 0.044715f * x * x)); }
__device__ __forceinline__ f32x4 gelu4(const f32x4 x) {
    const f32x4 t = x * (x * x * (-0.10294324f) + (-2.30220821f));
    f32x4 e; e[0] = __builtin_amdgcn_exp2f(t[0]); e[1] = __builtin_amdgcn_exp2f(t[1]); e[2] = __builtin_amdgcn_exp2f(t[2]); e[3] = __builtin_amdgcn_exp2f(t[3]);
    e = e + 1.0f;
    f32x4 r; r[0] = __builtin_amdgcn_rcpf(e[0]); r[1] = __builtin_amdgcn_rcpf(e[1]); r[2] = __builtin_amdgcn_rcpf(e[2]); r[3] = __builtin_amdgcn_rcpf(e[3]);
    return x * r;
}
__device__ __forceinline__ f32x4 sig4_t(const f32x4 t) {
    f32x4 e; e[0] = __builtin_amdgcn_exp2f(t[0]); e[1] = __builtin_amdgcn_exp2f(t[1]); e[2] = __builtin_amdgcn_exp2f(t[2]); e[3] = __builtin_amdgcn_exp2f(t[3]);
    e = e + 1.0f;
    f32x4 r; r[0] = __builtin_amdgcn_rcpf(e[0]); r[1] = __builtin_amdgcn_rcpf(e[1]); r[2] = __builtin_amdgcn_rcpf(e[2]); r[3] = __builtin_amdgcn_rcpf(e[3]);
    return r;
}
__device__ __forceinline__ unsigned gate4_f8_t(const f32x4 t) {
    f32x4 e; e[0] = __builtin_amdgcn_exp2f(fminf(t[0], 7.8f)); e[1] = __builtin_amdgcn_exp2f(fminf(t[1], 7.8f)); e[2] = __builtin_amdgcn_exp2f(fminf(t[2], 7.8f)); e[3] = __builtin_amdgcn_exp2f(fminf(t[3], 7.8f));
    e = e + 1.0f;
    int w = __builtin_amdgcn_cvt_pk_fp8_f32(e[0], e[1], 0, false);
    w = __builtin_amdgcn_cvt_pk_fp8_f32(e[2], e[3], w, true);
    return (unsigned)w;
}
template <int CTRL> __device__ __forceinline__ float dpp_f(float v) { return __int_as_float(__builtin_amdgcn_update_dpp(0, __float_as_int(v), CTRL, 0xF, 0xF, false)); }
__device__ __forceinline__ float row16_sum(float v) { v += dpp_f<0xB1>(v); v += dpp_f<0x4E>(v); v += dpp_f<0x141>(v); v += dpp_f<0x140>(v); return v; }
__device__ __forceinline__ float wave_sum(float v) {
    v = row16_sum(v);
    const float a = __int_as_float(__builtin_amdgcn_readlane(__float_as_int(v), 0)), b = __int_as_float(__builtin_amdgcn_readlane(__float_as_int(v), 16)),
                c = __int_as_float(__builtin_amdgcn_readlane(__float_as_int(v), 32)), d = __int_as_float(__builtin_amdgcn_readlane(__float_as_int(v), 48));
    return (a + b) + (c + d);
}
__device__ __forceinline__ u32x4 pack8(const f32x4 a, const f32x4 b) { u32x4 w; w.x = cvt_pk_bf16(a[0], a[1]); w.y = cvt_pk_bf16(a[2], a[3]); w.z = cvt_pk_bf16(b[0], b[1]); w.w = cvt_pk_bf16(b[2], b[3]); return w; }
__device__ __forceinline__ void unpack8(const u32x4 w, f32x4& a, f32x4& b) { a = (f32x4){bf_lo(w.x), bf_hi(w.x), bf_lo(w.y), bf_hi(w.y)}; b = (f32x4){bf_lo(w.z), bf_hi(w.z), bf_lo(w.w), bf_hi(w.w)}; }

#define XB_TMO      128
#define XB_XCNT(j)  (256  + 64 * (j))
#define XB_XSUB(j)  (1280 + 64 * (j))
#define XB_XGEN(j)  (2304 + 64 * (j))
#define XB_TOP      3328
#define XB_TOPGEN   3392
#define XCD_BAR_WORDS 3456
#define XB_SPIN_CAP (1u << 18)
__device__ __forceinline__ unsigned xb_ld(unsigned* p)              { return __hip_atomic_load(p, __ATOMIC_RELAXED, __HIP_MEMORY_SCOPE_AGENT); }
__device__ __forceinline__ unsigned xb_add(unsigned* p, unsigned v) { return __hip_atomic_fetch_add(p, v, __ATOMIC_RELAXED, __HIP_MEMORY_SCOPE_AGENT); }
__device__ __forceinline__ unsigned xb_xcc_id() { return (unsigned)__builtin_amdgcn_s_getreg((3 << 11) | 20) & 0xFu; }
#define XB_SPIN(cond, bar) do { unsigned _sp = 0; while (cond) { __builtin_amdgcn_s_sleep(1); \
    if ((++_sp & 255u) == 0u) { if (xb_ld(&(bar)[XB_TMO])) break; if (_sp > XB_SPIN_CAP) { atomicAdd(&(bar)[XB_TMO], 1u); break; } } } } while (0)
struct XcdBarrier { unsigned* bar; unsigned x; volatile LAS unsigned* st; };
__device__ __forceinline__ XcdBarrier xcd_barrier_post(unsigned* bar, volatile LAS unsigned* st) {
    XcdBarrier b; b.bar = bar; b.x = xb_xcc_id(); b.st = st;
    if (threadIdx.x == 0) (void)xb_add(&bar[XB_XCNT(b.x)], 1u);
    return b;
}
__device__ __forceinline__ void xcd_barrier_complete(unsigned* bar, unsigned x, unsigned& nloc, unsigned& nx) {
    const unsigned G = gridDim.x * gridDim.y * gridDim.z;
    unsigned sum, cnt, mine, sp = 0u;
    for (;;) {
        sum = 0u; cnt = 0u; mine = 0u;
#pragma unroll
        for (unsigned j = 0; j < 16; ++j) { const unsigned c = xb_ld(&bar[XB_XCNT(j)]); sum += c; cnt += (c > 0u) ? 1u : 0u; mine = (j == x) ? c : mine; }
        if (sum == G) break;
        __builtin_amdgcn_s_sleep(1);
        if ((++sp & 255u) == 0u) { if (xb_ld(&bar[XB_TMO])) break; if (sp > XB_SPIN_CAP) { atomicAdd(&bar[XB_TMO], 1u); break; } }
    }
    nloc = mine > 0u ? mine : 1u; nx = cnt > 0u ? cnt : 1u;
}
__device__ __forceinline__ void xcd_barrier(const XcdBarrier& b) {
    asm volatile("s_waitcnt vmcnt(0)" ::: "memory");
    __syncthreads();
    if (threadIdx.x == 0) {
        unsigned* bar = b.bar;
        __builtin_amdgcn_s_waitcnt(0);
        unsigned nloc = b.st[0], nx = b.st[1];
        if (nloc == 0u) { xcd_barrier_complete(bar, b.x, nloc, nx); b.st[0] = nloc; b.st[1] = nx; }
        const unsigned old = xb_add(&bar[XB_XSUB(b.x)], 1u);
        const unsigned gen = old / nloc;
        if (old + 1u == (gen + 1u) * nloc) {
            __builtin_amdgcn_fence(__ATOMIC_RELEASE, "agent");
            asm volatile("s_waitcnt vmcnt(0)" ::: "memory");
            const unsigned og = xb_add(&bar[XB_TOP], 1u);
            const unsigned tg = og / nx;
            if (og + 1u == (tg + 1u) * nx) xb_add(&bar[XB_TOPGEN], 1u);
            else XB_SPIN(xb_ld(&bar[XB_TOPGEN]) == tg, bar);
            __builtin_amdgcn_fence(__ATOMIC_ACQUIRE, "agent");
            xb_add(&bar[XB_XGEN(b.x)], 1u);
            asm volatile("s_waitcnt vmcnt(0)" ::: "memory");
        } else {
            XB_SPIN(xb_ld(&bar[XB_XGEN(b.x)]) == gen, bar);
            __builtin_amdgcn_fence(__ATOMIC_ACQUIRE, "agent");
            asm volatile("s_waitcnt vmcnt(0)" ::: "memory");
        }
    }
    __syncthreads();
}

__device__ __forceinline__ void store16_wt(void* p, const u32x4 v) { asm volatile("global_store_dwordx4 %0, %1, off sc1\n\ts_nop 3" :: "v"(p), "v"(v) : "memory"); }
__device__ __forceinline__ void spin_count_ge(unsigned* p, unsigned target) {
    unsigned sp = 0u;
    while (xb_ld(p) < target) { __builtin_amdgcn_s_sleep(1); if (++sp > (1u << 22)) break; }
}
__device__ __forceinline__ void acquire_agent() { __builtin_amdgcn_fence(__ATOMIC_ACQUIRE, "agent"); asm volatile("s_waitcnt vmcnt(0)" ::: "memory"); }

namespace gs {
constexpr int BM = 256, BK = 64, HALF = 128, HTB = HALF * BK * 2, STAGE_BYTES = 8 * HTB;
__device__ __forceinline__ int lds_byte(int r, int c) { const int st = (r >> 4) * 2 + (c >> 5), rr = r & 15, cc = c & 31, ob = rr * 64 + cc * 2; return st * 1024 + (ob ^ (((ob >> 9) & 1) << 5)); }
__device__ __forceinline__ void stage_rc(int b, int& R, int& C) { const int st = b / 1024, sb = b % 1024, swz = sb ^ (((sb >> 9) & 1) << 5); R = (st >> 1) * 16 + swz / 64; C = (st & 1) * 32 + (swz % 64) / 2; }
__device__ __forceinline__ int perm32(int rho) { const int n = rho >> 4, i = rho & 15; return 8 * (i >> 2) + 4 * n + (i & 3); }
__device__ __forceinline__ int xcd_remap(int L, int nwg) { const int q = nwg >> 3, r = nwg & 7, xcd = L & 7, off = L >> 3; return (xcd < r ? xcd * (q + 1) : r * (q + 1) + (xcd - r) * q) + off; }
__device__ __forceinline__ void tile_order(int wgid, int nM, int nN, int& pm, int& pn) { const int nig = 8 * nN, gid = wgid / nig, fm = gid * 8, gsz = (nM - fm) < 8 ? (nM - fm) : 8; pm = fm + ((wgid % nig) % gsz); pn = (wgid % nig) / gsz; }

struct Unit { int pm, pn, kind, aux; };
struct Ops { const char* A; const char* B; unsigned lda, ldb; int nt; const int* rows; };

template <class Epi, class Sched, bool GATHER>
__device__ __forceinline__ void gemm_stream(LAS unsigned char* lds, const int tid, const Sched& S, const Epi& E) {
    const int wid = __builtin_amdgcn_readfirstlane(tid >> 6), lane = tid & 63, wr = wid >> 2, wc = wid & 3, fr = lane & 15, fq = lane >> 4;
    const unsigned ldsw = (unsigned)wid * 1024u;
    const int aoff = lds_byte(wr * 64 + fr, fq * 8), boff = lds_byte(wc * 32 + fr, fq * 8);
    Unit cur, nxt; int ui = 0;
    if (!S.next(0, cur)) return;
    if constexpr (Sched::POLLS) __builtin_amdgcn_s_barrier();
    unsigned vA0[2], vA1[2], vB[2];
    const char* cA; const char* cB; size_t hA, hB; int nt;
#define GS_SETOFF(u) do { Ops _o; S.ops((u), _o); cA = _o.A; cB = _o.B; nt = _o.nt; hB = (size_t)HALF * _o.ldb; hA = GATHER ? (size_t)0 : (Sched::ABLK ? (size_t)(HALF / 16) * Sched::ABLK : (size_t)HALF * _o.lda); \
        _Pragma("unroll") for (int _i = 0; _i < 2; ++_i) { int _R, _C; stage_rc(tid * 16 + _i * 8192, _R, _C); const int _Rb = (_R & ~31) + perm32(_R & 31); \
        if constexpr (GATHER) { vA0[_i] = (unsigned)_o.rows[_R] * _o.lda + (unsigned)_C * 2u; vA1[_i] = (unsigned)_o.rows[HALF + _R] * _o.lda + (unsigned)_C * 2u; } \
        else { vA0[_i] = Sched::ABLK ? ((unsigned)_R >> 4) * Sched::ABLK + ((unsigned)_C >> 5) * 1024u + ((unsigned)_R & 15u) * 64u + ((unsigned)_C & 31u) * 2u : (unsigned)_R * _o.lda + (unsigned)_C * 2u; vA1[_i] = 0u; } \
        vB[_i] = (unsigned)_Rb * _o.ldb + (unsigned)_C * 2u; } } while (0)
#define GS_SA(b, h) (((b) * 2 + (h)) * HTB)
#define GS_SB(b, h) ((4 + (b) * 2 + (h)) * HTB)
#define GS_STAGE(bufoff, gbase, voff) do { _Pragma("unroll") for (int _i = 0; _i < 2; ++_i) \
        __builtin_amdgcn_global_load_lds((const unsigned*)((const char*)(gbase) + (voff)[_i]), (LAS unsigned*)(lds + (bufoff) + ldsw + _i * 8192), 16, 0, 0); } while (0)
#define GS_STAGE_A1(bufoff, gbase) do { if constexpr (GATHER) { GS_STAGE(bufoff, gbase, vA1); } else { GS_STAGE(bufoff, (gbase) + hA, vA0); } } while (0)
#define GS_LDA(dst, b, h) do { _Pragma("unroll") for (int m = 0; m < 4; ++m) _Pragma("unroll") for (int k = 0; k < 2; ++k) dst[m][k] = *(const LAS bf16x8*)(lds + GS_SA(b, h) + aoff + m * 2048 + k * 1024); } while (0)
#define GS_LDB(dst, b, h) do { _Pragma("unroll") for (int n = 0; n < 2; ++n) _Pragma("unroll") for (int k = 0; k < 2; ++k) dst[n][k] = *(const LAS bf16x8*)(lds + GS_SB(b, h) + boff + n * 2048 + k * 1024); } while (0)
#define GS_MMA(ai, bj, At, Bt) do { __builtin_amdgcn_s_setprio(1); _Pragma("unroll") for (int m = 0; m < 4; ++m) _Pragma("unroll") for (int n = 0; n < 2; ++n) _Pragma("unroll") for (int k = 0; k < 2; ++k) { \
        if constexpr (Epi::I8) acc[ai][bj][m][n] = __builtin_bit_cast(f32x4, __builtin_amdgcn_mfma_i32_16x16x64_i8(__builtin_bit_cast(i32x4, Bt[n][k]), __builtin_bit_cast(i32x4, At[m][k]), __builtin_bit_cast(i32x4, acc[ai][bj][m][n]), 0, 0, 0)); \
        else acc[ai][bj][m][n] = __builtin_amdgcn_mfma_f32_16x16x32_bf16(Bt[n][k], At[m][k], acc[ai][bj][m][n], 0, 0, 0); } __builtin_amdgcn_s_setprio(0); } while (0)
#define GS_WAIT_V(n) asm volatile("s_waitcnt vmcnt(" #n ")" ::: "memory")
#define GS_WAIT_L(n) asm volatile("s_waitcnt lgkmcnt(" #n ")" ::: "memory")
#define GS_BAR __builtin_amdgcn_s_barrier()
#define GS_SCHED __builtin_amdgcn_sched_barrier(0)
    f32x4 acc[2][2][4][2];
#pragma unroll
    for (int a = 0; a < 2; ++a)
#pragma unroll
        for (int b = 0; b < 2; ++b)
#pragma unroll
            for (int m = 0; m < 4; ++m)
#pragma unroll
                for (int n = 0; n < 2; ++n) acc[a][b][m][n] = (f32x4){0.f, 0.f, 0.f, 0.f};
    bf16x8 At[4][2], B0[2][2], B1[2][2];
    GS_SETOFF(cur);
    const size_t kstep = (size_t)(BK * 2);
    constexpr size_t kstepA = Sched::ABLK ? (size_t)2048 : (size_t)(BK * 2);
    GS_STAGE(GS_SB(0, 0), cB, vB); GS_STAGE(GS_SB(0, 1), cB + hB, vB); GS_STAGE(GS_SA(0, 0), cA, vA0); GS_STAGE_A1(GS_SA(0, 1), cA);
    if (wr == 1) GS_BAR;
    GS_WAIT_V(2); GS_BAR;
    GS_STAGE(GS_SB(1, 0), cB + kstep, vB); GS_STAGE(GS_SA(1, 0), cA + kstepA, vA0); GS_STAGE(GS_SB(1, 1), cB + hB + kstep, vB);
    GS_WAIT_V(6); GS_BAR;
    for (;;) {
        const bool has_next = S.next(ui + 1, nxt);
        const int ntc = nt;
        for (int t = 0; t < ntc; t += 2) {
            const bool last = (t == ntc - 2);
            GS_LDB(B0, 0, 0); GS_LDB(B1, 0, 1); GS_SCHED; GS_LDA(At, 0, 0); GS_STAGE_A1(GS_SA(1, 1), cA + (size_t)(t + 1) * kstepA);
            const char* a2; const char* b2;
            if (last) { if (has_next) { GS_SETOFF(nxt); } a2 = cA; b2 = cB; }
            else { a2 = cA + (size_t)(t + 2) * kstepA; b2 = cB + (size_t)(t + 2) * kstep; }
            const char* a3 = a2 + kstepA; const char* b3 = b2 + kstep;
            GS_WAIT_V(8); GS_WAIT_L(0); GS_BAR; GS_MMA(0, 0, At, B0); GS_MMA(0, 1, At, B1); GS_BAR; GS_SCHED;
            GS_LDA(At, 0, 1); GS_STAGE(GS_SB(0, 0), b2, vB); GS_STAGE(GS_SB(0, 1), b2 + hB, vB); GS_STAGE(GS_SA(0, 0), a2, vA0);
            GS_WAIT_V(8); GS_WAIT_L(0); GS_BAR; GS_MMA(1, 0, At, B0); GS_MMA(1, 1, At, B1); GS_BAR; GS_SCHED;
            GS_LDB(B0, 1, 0); GS_LDB(B1, 1, 1); GS_SCHED; GS_LDA(At, 1, 0); GS_STAGE_A1(GS_SA(0, 1), a2);
            GS_WAIT_V(8); GS_WAIT_L(0); GS_BAR; GS_MMA(0, 0, At, B0); GS_MMA(0, 1, At, B1); GS_BAR; GS_SCHED;
            GS_LDA(At, 1, 1); GS_STAGE(GS_SB(1, 0), b3, vB); GS_STAGE(GS_SB(1, 1), b3 + hB, vB); GS_STAGE(GS_SA(1, 0), a3, vA0);
            GS_WAIT_V(8); GS_WAIT_L(0); GS_BAR; GS_MMA(1, 0, At, B0); GS_MMA(1, 1, At, B1); GS_BAR; GS_SCHED;
        }
        if (wr == 0) GS_BAR;
        bool keep = false;
        if constexpr (Epi::KEEPS) keep = E.scale(acc, cur, wr, wc, fr, fq);
        else E(acc, cur, wr, wc, fr, fq);
        if (!has_next) break;
        if (!keep) {
#pragma unroll
        for (int a = 0; a < 2; ++a)
#pragma unroll
            for (int b = 0; b < 2; ++b)
#pragma unroll
                for (int m = 0; m < 4; ++m)
#pragma unroll
                    for (int n = 0; n < 2; ++n) acc[a][b][m][n] = (f32x4){0.f, 0.f, 0.f, 0.f};
        }
        cur = nxt; ++ui;
        if (wr == 1) GS_BAR;
    }
    GS_WAIT_V(0);
    GS_BAR;
#undef GS_SETOFF
#undef GS_SA
#undef GS_SB
#undef GS_STAGE
#undef GS_STAGE_A1
#undef GS_LDA
#undef GS_LDB
#undef GS_MMA
#undef GS_WAIT_V
#undef GS_WAIT_L
#undef GS_BAR
#undef GS_SCHED
}
}

struct Params {
    const float* in[31];
    float* out;
    unsigned char* ws;
    long long ph_lo, ph_hi;
};
enum { I_X = 0, I_C, I_CTX, I_CCTX, I_WMOD, I_BMOD, I_N1G, I_N2G, I_WIN, I_SGUNG, I_SGUW, I_SGUB, I_CONVW, I_LAMRE, I_LAMIM, I_LOGDT, I_BRE, I_BIM, I_CRE, I_CIM, I_S5D,
       I_GLUW, I_GLUB, I_WBR, I_WOUT, I_RW, I_RB, I_EWG, I_EWU, I_EWD, I_FNG };

struct Frame {
    LAS unsigned char* lds;
    int tid, lane, wave, blk;
};

__device__ __forceinline__ float wave_max(float v) {
    v = fmaxf(v, dpp_f<0xB1>(v)); v = fmaxf(v, dpp_f<0x4E>(v)); v = fmaxf(v, dpp_f<0x141>(v)); v = fmaxf(v, dpp_f<0x140>(v));
    const float a = __int_as_float(__builtin_amdgcn_readlane(__float_as_int(v), 0)), b = __int_as_float(__builtin_amdgcn_readlane(__float_as_int(v), 16)),
                c = __int_as_float(__builtin_amdgcn_readlane(__float_as_int(v), 32)), d = __int_as_float(__builtin_amdgcn_readlane(__float_as_int(v), 48));
    return fmaxf(fmaxf(a, b), fmaxf(c, d));
}
__device__ __forceinline__ unsigned q8x4u(const f32x4 v, const float inv) {
    const f32x4 t = v * inv + 12583040.0f;
    const unsigned a = __float_as_uint(t[0]), b = __float_as_uint(t[1]), c = __float_as_uint(t[2]), d = __float_as_uint(t[3]);
    return __builtin_amdgcn_perm(__builtin_amdgcn_perm(d, c, 0x0c0c0400u), __builtin_amdgcn_perm(b, a, 0x0c0c0400u), 0x05040100u);
}
#define YSC_IDX(b) ((((b) & ~7)) | (((b) & 3) << 1) | (((b) >> 2) & 1))
__device__ __forceinline__ f32x4 ysum4(const unsigned a, const unsigned b, const float sa, const float sb) {
    const float o = -128.0f * (sa + sb);
    return (f32x4){(float)(a & 255u) * sa + ((float)(b & 255u) * sb + o), (float)((a >> 8) & 255u) * sa + ((float)((b >> 8) & 255u) * sb + o),
                   (float)((a >> 16) & 255u) * sa + ((float)((b >> 16) & 255u) * sb + o), (float)(a >> 24) * sa + ((float)(b >> 24) * sb + o)};
}
__device__ __forceinline__ unsigned q8x4(const f32x4 v, const float inv) {
    const unsigned a = __float_as_uint(__builtin_fmaf(v[0], inv, 12582912.0f)), b = __float_as_uint(__builtin_fmaf(v[1], inv, 12582912.0f));
    const unsigned c = __float_as_uint(__builtin_fmaf(v[2], inv, 12582912.0f)), d = __float_as_uint(__builtin_fmaf(v[3], inv, 12582912.0f));
    return __builtin_amdgcn_perm(__builtin_amdgcn_perm(d, c, 0x0c0c0400u), __builtin_amdgcn_perm(b, a, 0x0c0c0400u), 0x05040100u);
}
__device__ __forceinline__ void tr_item(const float* src, int ld_src, int k0, int c0, bf16_t* dst, int ld_dst, int r0, LAS float* scr, int lane) {
    f32x4 t[8];
#pragma unroll
    for (int i = 0; i < 8; ++i) t[i] = *(const f32x4*)(src + (size_t)(k0 + 8 * i + (lane >> 3)) * ld_src + c0 + 4 * (lane & 7));
#pragma unroll
    for (int i = 0; i < 8; ++i) { LAS float* d = scr + (8 * i + (lane >> 3)) * 33 + 4 * (lane & 7); d[0] = t[i][0]; d[1] = t[i][1]; d[2] = t[i][2]; d[3] = t[i][3]; }
    asm volatile("s_waitcnt lgkmcnt(0)" ::: "memory");
    const int c = lane & 7;
    float sv[4][8];
#pragma unroll
    for (int j = 0; j < 4; ++j) { const LAS float* s = scr + (8 * c) * 33 + (lane >> 3) + 8 * j;
#pragma unroll
        for (int i = 0; i < 8; ++i) sv[j][i] = s[i * 33]; }
#pragma unroll
    for (int j = 0; j < 4; ++j) { const int n = (lane >> 3) + 8 * j;
        u32x4 o; o.x = cvt_pk_bf16(sv[j][0], sv[j][1]); o.y = cvt_pk_bf16(sv[j][2], sv[j][3]); o.z = cvt_pk_bf16(sv[j][4], sv[j][5]); o.w = cvt_pk_bf16(sv[j][6], sv[j][7]);
        *(u32x4*)(dst + (size_t)(r0 + n) * ld_dst + k0 + 8 * c) = o; }
    asm volatile("s_waitcnt lgkmcnt(0)" ::: "memory");
}
__device__ __forceinline__ void tr_item_i8(const float* src, int ld_src, int k0, int c0, signed char* dst, int ld_dst, int r0, const unsigned* cmax_c0, float* scale_out, LAS float* scr, int lane) {
    f32x4 t[8];
#pragma unroll
    for (int i = 0; i < 8; ++i) t[i] = *(const f32x4*)(src + (size_t)(k0 + 8 * i + (lane >> 3)) * ld_src + c0 + 4 * (lane & 7));
#pragma unroll
    for (int i = 0; i < 8; ++i) { LAS float* d = scr + (8 * i + (lane >> 3)) * 33 + 4 * (lane & 7); d[0] = t[i][0]; d[1] = t[i][1]; d[2] = t[i][2]; d[3] = t[i][3]; }
    asm volatile("s_waitcnt lgkmcnt(0)" ::: "memory");
    const int n = lane & 31, hf = lane >> 5;
    const float cm = fmaxf(__uint_as_float(cmax_c0[n]), 1e-30f), inv = 127.0f / cm;
    if (scale_out && hf == 0) scale_out[n] = cm * (1.0f / 127.0f);
    u32x4 o[2];
#pragma unroll
    for (int h = 0; h < 2; ++h) {
        unsigned w[4];
#pragma unroll
        for (int x = 0; x < 4; ++x) { const LAS float* sp = scr + (32 * hf + 16 * h + 4 * x) * 33 + n; w[x] = q8x4((f32x4){sp[0], sp[33], sp[66], sp[99]}, inv); }
        o[h] = (u32x4){w[0], w[1], w[2], w[3]}; }
    *(u32x4*)(dst + (size_t)(r0 + n) * ld_dst + k0 + 32 * hf) = o[0]; *(u32x4*)(dst + (size_t)(r0 + n) * ld_dst + k0 + 32 * hf + 16) = o[1];
    asm volatile("s_waitcnt lgkmcnt(0)" ::: "memory");
}
__device__ __forceinline__ void colmax_win(const Params& p, const Frame& F) {
    unsigned* cmax = (unsigned*)(p.ws + OFF_CMAXW);
    for (int it = F.blk * NWAVE + F.wave; it < 768; it += NBLK * NWAVE) {
        const int l = it / 384, rem = it % 384, kb = rem / 24, cb = rem % 24;
        const float* src = p.in[I_WIN] + ((size_t)l * 1024 + 64 * kb) * 6144 + cb * 256 + 4 * F.lane;
        f32x4 m = (f32x4){0.f, 0.f, 0.f, 0.f};
#pragma unroll 16
        for (int i = 0; i < 64; ++i) { const f32x4 v = *(const f32x4*)(src + (size_t)i * 6144); m[0] = fmaxf(m[0], fabsf(v[0])); m[1] = fmaxf(m[1], fabsf(v[1])); m[2] = fmaxf(m[2], fabsf(v[2])); m[3] = fmaxf(m[3], fabsf(v[3])); }
        unsigned* dst = cmax + l * 6144 + cb * 256 + 4 * F.lane;
        atomicMax(dst + 0, __float_as_uint(m[0])); atomicMax(dst + 1, __float_as_uint(m[1])); atomicMax(dst + 2, __float_as_uint(m[2])); atomicMax(dst + 3, __float_as_uint(m[3]));
    }
}
__device__ __forceinline__ int win_col(int n) {
    if (n < 1536 || n >= 2560) return n;
    const int j = (n - 1536) >> 8, q = (n - 1536) & 255;
    return (q < 128) ? (1536 + 128 * j + q) : (2048 + 128 * j + (q - 128));
}
__device__ __forceinline__ void convert_mix(const Params& p, const Frame& F, int l, int part, int wslot, int nwslots) {
    LAS float* scr = (LAS float*)(F.lds + F.wave * 16384);
    bf16_t* WinT = (bf16_t*)(p.ws + OFF_WIN); bf16_t* WbrT = (bf16_t*)(p.ws + OFF_WBR); bf16_t* WoutT = (bf16_t*)(p.ws + OFF_WOUT); bf16_t* GluT = (bf16_t*)(p.ws + OFF_GLU);
    const int nit = part == 0 ? 3200 : (part == 1 ? 1280 : 4480);
    for (int it0 = wslot; it0 < nit; it0 += nwslots) {
        int r = part == 0 ? (it0 < 3072 ? it0 : it0 + 1280) : (part == 1 ? it0 + 3072 : it0);
        if (r < 3072) { const int kb = r / 192, nb = r % 192, oc = win_col(32 * nb);
            tr_item_i8(p.in[I_WIN] + (size_t)l * 1024 * 6144, 6144, 64 * kb, oc, (signed char*)WinT, 1024, 32 * nb, (const unsigned*)(p.ws + OFF_CMAXW) + l * 6144 + oc, kb == 0 ? (float*)(p.ws + OFF_SWIN) + l * 6144 + 32 * nb : nullptr, scr, F.lane); continue; }
        r -= 3072;
        if (r < 768) { const int br = r / 256, rem = r % 256, kb = rem / 32, nb = rem % 32; tr_item(p.in[I_WBR] + ((size_t)l * 3 + br) * 512 * 1024, 1024, 64 * kb, 32 * nb, WbrT + (size_t)br * 1024 * 512, 512, 32 * nb, scr, F.lane); continue; }
        r -= 768;
        if (r < 512) { const int kb = r / 32, nb = r % 32; tr_item(p.in[I_WOUT] + (size_t)l * 1024 * 1024, 1024, 64 * kb, 32 * nb, WoutT, 1024, 32 * nb, scr, F.lane); continue; }
        r -= 512;
        { const int kb = r / 16, nb = r % 16; tr_item(p.in[I_GLUW] + (size_t)l * 512 * 512, 512, 64 * kb, 32 * nb, GluT, 512, 32 * nb, scr, F.lane); }
    }
}
__device__ __forceinline__ void convert_experts(const Params& p, const Frame& F, int l, int slot, int nslots, int parts) {
    LAS float* scr = (LAS float*)(F.lds + 65536 + F.wave * 8448);
    LAS unsigned* cmx = (LAS unsigned*)(F.lds + 65536 + 8 * 8448);
    signed char* Wgu = (signed char*)(p.ws + OFF_WGU); bf16_t* Wd = (bf16_t*)(p.ws + OFF_WD); float* swgu = (float*)(p.ws + OFF_SWGU);
    const int lane = F.lane;
    if (parts & 1)
    for (int st = slot; st < 512; st += nslots) {
        const int e = st >> 5, nb = st & 31, n0 = 32 * nb, t = n0 >> 8, qq = n0 & 255, c0 = 128 * t + (qq & 127);
        const float* src = (qq < 128 ? p.in[I_EWG] : p.in[I_EWU]) + ((size_t)l * 16 + e) * 1024 * 512;
        __syncthreads();
        if (F.tid < 32) cmx[F.tid] = 0u;
        __syncthreads();
        f32x4 t0[8], t1[8];
#pragma unroll
        for (int i = 0; i < 8; ++i) { t0[i] = *(const f32x4*)(src + (size_t)(128 * F.wave + 8 * i + (lane >> 3)) * 512 + c0 + 4 * (lane & 7)); t1[i] = *(const f32x4*)(src + (size_t)(128 * F.wave + 64 + 8 * i + (lane >> 3)) * 512 + c0 + 4 * (lane & 7)); }
        f32x4 m = (f32x4){0.f, 0.f, 0.f, 0.f};
#pragma unroll
        for (int i = 0; i < 8; ++i) {
#pragma unroll
            for (int j = 0; j < 4; ++j) m[j] = fmaxf(m[j], fmaxf(fabsf(t0[i][j]), fabsf(t1[i][j]))); }
#pragma unroll
        for (int j = 0; j < 4; ++j) __hip_atomic_fetch_max(cmx + 4 * (lane & 7) + j, __float_as_uint(m[j]), __ATOMIC_RELAXED, __HIP_MEMORY_SCOPE_WORKGROUP);
        __syncthreads();
        const int n = lane & 31, hf = lane >> 5;
        const float cm = fmaxf(__uint_as_float(cmx[n]), 1e-30f), inv = 127.0f / cm;
        if (F.wave == 0 && hf == 0) swgu[e * 1024 + n0 + n] = cm * (1.0f / 127.0f);
#pragma unroll
        for (int tt = 0; tt < 2; ++tt) {
#pragma unroll
            for (int i = 0; i < 8; ++i) { LAS float* d = scr + (8 * i + (lane >> 3)) * 33 + 4 * (lane & 7); const f32x4 v = tt == 0 ? t0[i] : t1[i]; d[0] = v[0]; d[1] = v[1]; d[2] = v[2]; d[3] = v[3]; }
            asm volatile("s_waitcnt lgkmcnt(0)" ::: "memory");
            u32x4 o[2];
#pragma unroll
            for (int h = 0; h < 2; ++h) { unsigned w[4];
#pragma unroll
                for (int x = 0; x < 4; ++x) { const LAS float* sp = scr + (32 * hf + 16 * h + 4 * x) * 33 + n; w[x] = q8x4((f32x4){sp[0], sp[33], sp[66], sp[99]}, inv); }
                o[h] = (u32x4){w[0], w[1], w[2], w[3]}; }
            signed char* dp = Wgu + ((size_t)e * 1024 + n0 + n) * 1024 + 128 * F.wave + 64 * tt + 32 * hf;
            *(u32x4*)dp = o[0]; *(u32x4*)(dp + 16) = o[1];
            asm volatile("s_waitcnt lgkmcnt(0)" ::: "memory");
        }
    }
    if (parts & 2)
    for (int it = slot * NWAVE + F.wave; it < 4096; it += nslots * NWAVE) {
        const int e = it / 256, rem = it % 256, kb = rem / 32, nb = rem % 32;
        tr_item(p.in[I_EWD] + ((size_t)l * 16 + e) * 512 * 1024, 1024, 64 * kb, 32 * nb, Wd + (size_t)e * 1024 * 512, 512, 32 * nb, scr, F.lane);
    }
}

__device__ __forceinline__ void mod_items(const Params& p, const Frame& F) {
    LAS float* sc = (LAS float*)F.lds;
    LAS float* red = (LAS float*)(F.lds + 17 * 1024 * 4);
    float* mod = (float*)(p.ws + OFF_MOD);
    bool staged = false;
    __syncthreads();
    for (int it = F.blk; it < 384; it += NBLK) {
        if (!staged) {
            f32x4 tv[9];
#pragma unroll
            for (int x = 0; x < 8; ++x) tv[x] = *(const f32x4*)(p.in[I_C] + (F.tid + x * NTHR) * 4);
            tv[8] = *(const f32x4*)(p.in[I_CCTX] + (F.tid & 255) * 4);
#pragma unroll
            for (int x = 0; x < 9; ++x) { const int i = (x < 8 ? F.tid + x * NTHR : 4096 + (F.tid & 255)) * 4;
                if (x < 8 || F.tid < 256) *(LAS f32x4*)(sc + i) = (f32x4){siluf_(tv[x][0]), siluf_(tv[x][1]), siluf_(tv[x][2]), siluf_(tv[x][3])}; }
            staged = true;
        }
        __syncthreads();
        const int l = it / 192, n0 = (it % 192) * 32, ks = F.tid >> 5, cn = F.tid & 31;
        const float* w = p.in[I_WMOD] + (size_t)l * 1024 * 6144 + n0 + cn;
        float a[17];
#pragma unroll
        for (int mi = 0; mi < 17; ++mi) a[mi] = 0.f;
        for (int k0 = ks * 64; k0 < ks * 64 + 64; k0 += 16) { float wv[16];
#pragma unroll
            for (int x = 0; x < 16; ++x) wv[x] = w[(size_t)(k0 + x) * 6144];
#pragma unroll
            for (int x = 0; x < 16; ++x) {
#pragma unroll
                for (int mi = 0; mi < 17; ++mi) a[mi] += sc[mi * 1024 + k0 + x] * wv[x]; } }
#pragma unroll
        for (int mi = 0; mi < 17; ++mi) red[(ks * 17 + mi) * 32 + cn] = a[mi];
        __syncthreads();
        for (int i = F.tid; i < 17 * 32; i += NTHR) { const int mi = i >> 5, c2 = i & 31; float s = 0.f;
#pragma unroll
            for (int q = 0; q < 16; ++q) s += red[(q * 17 + mi) * 32 + c2];
            mod[((size_t)l * 17 + mi) * 6144 + n0 + c2] = s + p.in[I_BMOD][l * 6144 + n0 + c2]; }
    }
    __syncthreads();
}

__device__ __forceinline__ void s5_build_job(const Params& p, const Frame& F, int l, int job) {
    const int g = job >> 2, q = job & 3, tid = F.tid;
    LAS f32x2* ap = (LAS f32x2*)F.lds;
    LAS f32x2* bb = (LAS f32x2*)(F.lds + 34816);
    LAS f32x2* cc = (LAS f32x2*)(F.lds + 34816 + 16384);
    LAS f32x2* fz = (LAS f32x2*)(F.lds + 34816 + 32768);
    LAS float* kt = (LAS float*)(F.lds + 69632);
    LAS float* dvs = (LAS float*)(F.lds + 34816 + 32768 + 1024);
    __syncthreads();
    {
        const int pp = tid & 63, d = tid >> 8, tq = (tid >> 6) & 3, gi = (l * 2 + d) * 32 + g;
        const float ldt = p.in[I_LOGDT][gi], lr = p.in[I_LAMRE][gi * 64 + pp], li = p.in[I_LAMIM][gi * 64 + pp];
        if (tid < 16) dvs[tid] = p.in[I_S5D][l * 512 + g * 16 + tid];
        const float dt = expf(ldt), t0 = 8.0f * (float)tq;
        float sn, cs; const float m1 = expf(lr * dt); sincosf(li * dt, &sn, &cs); const float a1r = m1 * cs, a1i = m1 * sn;
        const float m0 = expf(lr * dt * t0); sincosf(li * dt * t0, &sn, &cs); float cr = m0 * cs, ci = m0 * sn;
        if (tq == 0) { float one_ = 1.0f, zero_ = 0.0f; asm volatile("" : "+v"(one_), "+v"(zero_)); ap[(d * 33) * 64 + pp] = (f32x2){one_, zero_}; }
#pragma unroll
        for (int s_ = 1; s_ <= 8; ++s_) { const float nr = cr * a1r - ci * a1i, ni = cr * a1i + ci * a1r; cr = nr; ci = ni; ap[(d * 33 + 8 * tq + s_) * 64 + pp] = (f32x2){cr, ci}; }
    }
    if (tid < 128) {
        const int d = tid >> 6, pp = tid & 63, gi = (l * 2 + d) * 32 + g;
        const float dt = expf(p.in[I_LOGDT][gi]), lr = p.in[I_LAMRE][gi * 64 + pp], li = p.in[I_LAMIM][gi * 64 + pp];
        const float mag = expf(lr * dt); float sn, cs; sincosf(li * dt, &sn, &cs);
        const float abr = mag * cs, abi = mag * sn, den = lr * lr + li * li, nr = abr - 1.0f;
        fz[tid] = (f32x2){(nr * lr + abi * li) / den, (abi * lr - nr * li) / den};
    }
    __syncthreads();
    if (q == 0 && tid < 128) { const int d = tid >> 6, pp = tid & 63; const f32x2 a = ap[(d * 33 + 32) * 64 + pp]; float* aq = (float*)(p.ws + OFF_AQ) + ((((size_t)l * 2 + d) * 32 + g) * 64 + pp) * 2; aq[0] = a.x; aq[1] = a.y; }
#pragma unroll
    for (int it = 0; it < 4; ++it) { const int i = tid + it * NTHR;
        { const int d = i >> 10, pp = (i >> 4) & 63, h = i & 15; const size_t gi = ((((size_t)l * 2 + d) * 32 + g) * 64 + pp) * 16 + h;
          const float br = p.in[I_BRE][gi], bi = p.in[I_BIM][gi]; const f32x2 f = fz[d * 64 + pp]; bb[i] = (f32x2){f.x * br - f.y * bi, f.x * bi + f.y * br}; }
        { const int d = i >> 10, h = (i >> 6) & 15, pp = i & 63; const size_t gi = ((((size_t)l * 2 + d) * 32 + g) * 16 + h) * 64 + pp; cc[i] = (f32x2){p.in[I_CRE][gi], p.in[I_CIM][gi]}; }
    }
    __syncthreads();
    {
        const int hh = F.lane & 15, kg = F.lane >> 4;
        u32x4 bfr[2][4];
#pragma unroll
        for (int d = 0; d < 2; ++d)
#pragma unroll
            for (int ks = 0; ks < 4; ++ks) { unsigned w[4]; f32x2 bq[4];
#pragma unroll
                for (int jp = 0; jp < 4; ++jp) bq[jp] = bb[(d * 64 + 16 * ks + 4 * kg + jp) * 16 + hh];
#pragma unroll
                for (int jp = 0; jp < 4; ++jp) w[jp] = cvt_pk_bf16(bq[jp].x, bq[jp].y);
                bfr[d][ks] = (u32x4){w[0], w[1], w[2], w[3]}; }
        for (int tile = F.wave; tile < 64; tile += NWAVE) {
            const int d = tile >> 5, tau = tile & 31;
            f32x4 o = (f32x4){0.f, 0.f, 0.f, 0.f};
#pragma unroll
            for (int ks = 0; ks < 4; ++ks) { unsigned w[4];
                f32x2 cq[4], aq[4];
#pragma unroll
                for (int jp = 0; jp < 4; ++jp) { const int pp = 16 * ks + 4 * kg + jp; cq[jp] = cc[(d * 16 + hh) * 64 + pp]; aq[jp] = ap[(d * 33 + tau) * 64 + pp]; }
#pragma unroll
                for (int jp = 0; jp < 4; ++jp) { const f32x2 c = cq[jp], av = aq[jp];
                    w[jp] = cvt_pk_bf16(c.x * av.x - c.y * av.y, -(c.x * av.y + c.y * av.x)); }
                const u32x4 af = (u32x4){w[0], w[1], w[2], w[3]};
                o = __builtin_amdgcn_mfma_f32_16x16x32_bf16(__builtin_bit_cast(bf16x8, af), __builtin_bit_cast(bf16x8, d == 0 ? bfr[0][ks] : bfr[1][ks]), o, 0, 0, 0); }
#pragma unroll
            for (int r = 0; r < 4; ++r) kt[((d * 32 + tau) * 16 + 4 * kg + r) * 16 + hh] = o[r];
        }
    }
    __syncthreads();
    {
        bf16_t* WE = (bf16_t*)(p.ws + OFF_WE) + (size_t)g * 256 * 512;
        const int d = q >> 1, c = q & 1;
        for (int pc = tid; pc < 64 * 64; pc += NTHR) {
            const int pp = pc >> 6, col0 = (pc & 63) * 8, j = col0 >> 4, h0 = col0 & 15;
            const f32x2 a = ap[(d * 33 + (d == 0 ? 31 - j : j)) * 64 + pp];
            float v[8];
#pragma unroll
            for (int x = 0; x < 8; ++x) { const f32x2 b = bb[(d * 64 + pp) * 16 + h0 + x]; v[x] = c == 0 ? (a.x * b.x - a.y * b.y) : (a.x * b.y + a.y * b.x); }
            u32x4 o; o.x = cvt_pk_bf16(v[0], v[1]); o.y = cvt_pk_bf16(v[2], v[3]); o.z = cvt_pk_bf16(v[4], v[5]); o.w = cvt_pk_bf16(v[6], v[7]);
            *(u32x4*)(WE + (size_t)(64 * q + pp) * 512 + col0) = o;
        }
    }
    {
        bf16_t* TW = (bf16_t*)(p.ws + OFF_TW) + (size_t)g * 512 * 768;
        for (int pc = tid; pc < 128 * 96; pc += NTHR) {
            const int rl = pc / 96, cp = pc % 96, rr = 128 * q + rl, i = rr >> 4, h = rr & 15, col0 = cp * 8;
            float v[8];
            if (col0 < 512) {
                const int j = col0 >> 4, h0 = col0 & 15;
#pragma unroll
                for (int x = 0; x < 8; ++x) {
                    const int hp = h0 + x; float val;
                    if (i > j) val = kt[((0 * 32 + (i - j)) * 16 + h) * 16 + hp];
                    else if (i < j) val = kt[((1 * 32 + (j - i)) * 16 + h) * 16 + hp];
                    else val = kt[((0 * 32 + 0) * 16 + h) * 16 + hp] + kt[((1 * 32 + 0) * 16 + h) * 16 + hp] + (h == hp ? dvs[h] : 0.f);
                    v[x] = val;
                }
            } else {
                const int n0 = col0 - 512, d = n0 >> 7, c = (n0 >> 6) & 1, p0 = n0 & 63, tau = d == 0 ? i + 1 : 32 - i;
#pragma unroll
                for (int x = 0; x < 8; ++x) { const f32x2 cv = cc[(d * 16 + h) * 64 + p0 + x], a = ap[(d * 33 + tau) * 64 + p0 + x];
                    v[x] = c == 0 ? (cv.x * a.x - cv.y * a.y) : -(cv.x * a.y + cv.y * a.x); }
            }
            u32x4 o; o.x = cvt_pk_bf16(v[0], v[1]); o.y = cvt_pk_bf16(v[2], v[3]); o.z = cvt_pk_bf16(v[4], v[5]); o.w = cvt_pk_bf16(v[6], v[7]);
            *(u32x4*)(TW + (size_t)rr * 768 + col0) = o;
        }
    }
    __syncthreads();
}

__device__ __forceinline__ bf16_t* hrow_ptr(const Params& p, int r) { return (bf16_t*)(p.ws + OFF_HB) + (size_t)r * D; }
__device__ __forceinline__ f32x4 bf4(const u32x2 w) { return (f32x4){bf_lo(w.x), bf_hi(w.x), bf_lo(w.y), bf_hi(w.y)}; }
__device__ __forceinline__ int mod_index(int r) { return r < TLAT ? (r >> 11) : 16; }

__device__ __forceinline__ void phase_norm1(const Params& p, const Frame& F, int l, bool dry = false) {
    const float* mod = (const float*)(p.ws + OFF_MOD);
    signed char* Xq = (signed char*)(p.ws + (dry ? 422 * MiB : OFF_XN)); float* sxa = (float*)(p.ws + (dry ? 460 * MiB : OFF_SXA));
    const unsigned char* Y8 = p.ws + OFF_Y; const float* Ysc = (const float*)(p.ws + OFF_YSC);
    const int* pos = (const int*)(p.ws + OFF_POS);
    const int lane = F.lane, row0 = F.blk * 144 + F.wave * 18;
    int mypos = 0; if (l == 1 && lane < 36) mypos = pos[2 * row0 + lane];
    f32x4 ch[4], mg[4], ms[4], m2[4]; unsigned ca[4], cb[4]; float csa[2], csb[2]; int cmi = -1;
#define N1_LOAD(rr, H, A, B, SA, SB) do { const int r_ = (rr); \
        if (l == 0) { const float* src_ = (r_ < TLAT) ? (p.in[I_X] + (size_t)r_ * D) : (p.in[I_CTX] + (size_t)(r_ - TLAT) * D); \
            _Pragma("unroll") for (int j = 0; j < 4; ++j) { H[j] = *(const f32x4*)(src_ + 4 * lane + 256 * j); A[j] = 0u; B[j] = 0u; } SA[0] = SA[1] = SB[0] = SB[1] = 0.f; } \
        else { const bf16_t* hp_ = hrow_ptr(p, r_); const int q_ = 2 * (r_ - row0); \
            const size_t p0_ = (size_t)__builtin_amdgcn_readlane(mypos, q_), p1_ = (size_t)__builtin_amdgcn_readlane(mypos, q_ + 1); \
            _Pragma("unroll") for (int jj = 0; jj < 2; ++jj) { const int k_ = 8 * lane + 512 * jj; const u32x4 h_ = *(const u32x4*)(hp_ + k_); \
                const u32x2 a_ = *(const u32x2*)(Y8 + p0_ * 1024 + k_), b_ = *(const u32x2*)(Y8 + p1_ * 1024 + k_); \
                SA[jj] = Ysc[p0_ * 32 + YSC_IDX((lane >> 2) + 16 * jj)]; SB[jj] = Ysc[p1_ * 32 + YSC_IDX((lane >> 2) + 16 * jj)]; \
                H[2 * jj] = bf4((u32x2){h_.x, h_.y}); H[2 * jj + 1] = bf4((u32x2){h_.z, h_.w}); A[2 * jj] = a_.x; A[2 * jj + 1] = a_.y; B[2 * jj] = b_.x; B[2 * jj + 1] = b_.y; } } } while (0)
#define N1_K(j) (l == 0 ? 4 * lane + 256 * (j) : 8 * lane + 512 * ((j) >> 1) + 4 * ((j) & 1))
    N1_LOAD(row0, ch, ca, cb, csa, csb);
    for (int i = 0; i < 18; ++i) {
        const int r = row0 + i, mi = mod_index(r);
        f32x4 nh[4]; unsigned na[4], nb[4]; float nsa[2], nsb[2];
        if (i + 1 < 18) N1_LOAD(r + 1, nh, na, nb, nsa, nsb);
        f32x4 v[4];
        if (mi != cmi) { cmi = mi; const float* gn = p.in[I_N1G] + l * D; const float* sh = mod + ((size_t)l * 17 + mi) * 6144; const float* sc = sh + 1024;
            const float* g2 = mod + ((size_t)(l > 0 ? l - 1 : 0) * 17 + mi) * 6144 + 5120;
#pragma unroll
            for (int j = 0; j < 4; ++j) { const int k = N1_K(j); mg[j] = *(const f32x4*)(gn + k) * (1.0f + *(const f32x4*)(sc + k)); ms[j] = *(const f32x4*)(sh + k); m2[j] = *(const f32x4*)(g2 + k); } }
        if (l == 0) {
#pragma unroll
            for (int j = 0; j < 4; ++j) v[j] = ch[j];
        } else {
            bf16_t* hp = dry ? (bf16_t*)(p.ws + 350 * MiB) + (size_t)r * D : hrow_ptr(p, r);
#pragma unroll
            for (int j = 0; j < 4; ++j) {
                const f32x4 gg = m2[j];
                const f32x4 sm = ysum4(ca[j], cb[j], csa[j >> 1], csb[j >> 1]);
                v[j] = ch[j] + gg * sm;
            }
#pragma unroll
            for (int jj = 0; jj < 2; ++jj) *(u32x4*)(hp + 8 * lane + 512 * jj) = pack8(v[2 * jj], v[2 * jj + 1]);
        }
        float ss = 0.f;
#pragma unroll
        for (int j = 0; j < 4; ++j) ss += (v[j][0] * v[j][0] + v[j][1] * v[j][1]) + (v[j][2] * v[j][2] + v[j][3] * v[j][3]);
        const float rs = __builtin_amdgcn_rsqf(wave_sum(ss) * (1.0f / D) + EPS);
        float am = 0.f;
#pragma unroll
        for (int j = 0; j < 4; ++j) { v[j] = v[j] * rs * mg[j] + ms[j]; am = fmaxf(am, fmaxf(fmaxf(fabsf(v[j][0]), fabsf(v[j][1])), fmaxf(fabsf(v[j][2]), fabsf(v[j][3])))); }
        am = fmaxf(wave_max(am), 1e-30f);
        const float inv = 127.0f * __builtin_amdgcn_rcpf(am);
#pragma unroll
        for (int jj = 0; jj < 2; ++jj) { const unsigned q0 = q8x4(v[2 * jj], inv), q1 = q8x4(v[2 * jj + 1], inv);
            if (l == 0) { *(unsigned*)(Xq + (size_t)r * D + 4 * lane + 512 * jj) = q0; *(unsigned*)(Xq + (size_t)r * D + 4 * lane + 512 * jj + 256) = q1; }
            else *(u32x2*)(Xq + (size_t)r * D + 8 * lane + 512 * jj) = (u32x2){q0, q1}; }
        if (lane == 0) sxa[r] = am * (1.0f / 127.0f);
#pragma unroll
        for (int j = 0; j < 4; ++j) { ch[j] = nh[j]; ca[j] = na[j]; cb[j] = nb[j]; }
        csa[0] = nsa[0]; csa[1] = nsa[1]; csb[0] = nsb[0]; csb[1] = nsb[1];
    }
#undef N1_LOAD
#undef N1_K
}

__device__ __forceinline__ void phase_final(const Params& p, const Frame& F) {
    const float* mod = (const float*)(p.ws + OFF_MOD);
    const unsigned char* Y8 = p.ws + OFF_Y; const float* Ysc = (const float*)(p.ws + OFF_YSC);
    const int* pos = (const int*)(p.ws + OFF_POS);
    const int lane = F.lane, row0 = F.blk * 128 + F.wave * 16;
    int mypos = 0; if (lane < 32) mypos = pos[2 * row0 + lane];
    f32x4 ch[4], m2[4], fg[4]; unsigned ca[4], cb[4]; float csa[4], csb[4]; int cmi = -1;
#pragma unroll
    for (int j = 0; j < 4; ++j) fg[j] = *(const f32x4*)(p.in[I_FNG] + 4 * lane + 256 * j);
#define FN_LOAD(rr, H, A, B, SA, SB) do { const int r_ = (rr); const bf16_t* hp_ = hrow_ptr(p, r_); const int q_ = 2 * (r_ - row0); \
        const size_t p0_ = (size_t)__builtin_amdgcn_readlane(mypos, q_), p1_ = (size_t)__builtin_amdgcn_readlane(mypos, q_ + 1); \
        _Pragma("unroll") for (int j = 0; j < 4; ++j) { const int k_ = 4 * lane + 256 * j; H[j] = bf4(*(const u32x2*)(hp_ + k_)); A[j] = *(const unsigned*)(Y8 + p0_ * 1024 + k_); B[j] = *(const unsigned*)(Y8 + p1_ * 1024 + k_); \
            SA[j] = Ysc[p0_ * 32 + YSC_IDX((lane >> 3) + 8 * j)]; SB[j] = Ysc[p1_ * 32 + YSC_IDX((lane >> 3) + 8 * j)]; } } while (0)
    FN_LOAD(row0, ch, ca, cb, csa, csb);
    for (int i = 0; i < 16; ++i) {
        const int r = row0 + i, mi = r >> 11;
        f32x4 nh[4]; unsigned na[4], nb[4]; float nsa[4], nsb[4];
        if (i + 1 < 16) FN_LOAD(r + 1, nh, na, nb, nsa, nsb);
        float* hp = p.out + (size_t)r * D;
        if (mi != cmi) { cmi = mi; const float* g2 = mod + ((size_t)1 * 17 + mi) * 6144 + 5120;
#pragma unroll
            for (int j = 0; j < 4; ++j) m2[j] = *(const f32x4*)(g2 + 4 * lane + 256 * j); }
        f32x4 v[4]; float ss = 0.f;
#pragma unroll
        for (int j = 0; j < 4; ++j) {
            const f32x4 gg = m2[j];
            const f32x4 sm = ysum4(ca[j], cb[j], csa[j], csb[j]);
            v[j] = ch[j] + gg * sm;
            ss += (v[j][0] * v[j][0] + v[j][1] * v[j][1]) + (v[j][2] * v[j][2] + v[j][3] * v[j][3]);
        }
        const float rs = __builtin_amdgcn_rsqf(wave_sum(ss) * (1.0f / D) + EPS);
#pragma unroll
        for (int j = 0; j < 4; ++j) { const int k = 4 * lane + 256 * j; *(f32x4*)(hp + k) = v[j] * rs * fg[j]; }
#pragma unroll
        for (int j = 0; j < 4; ++j) { ch[j] = nh[j]; ca[j] = na[j]; cb[j] = nb[j]; csa[j] = nsa[j]; csb[j] = nsb[j]; }
    }
#undef FN_LOAD
}

#define EPI_FENCE() asm volatile("" ::: "memory")
#define OPAQUE_S(x) asm volatile("" : "+s"(x))
struct SchedB {
    static constexpr unsigned ABLK = 0u;
    static constexpr bool POLLS = false;
    const char* Xn; const char* W; int l, c, stride, md;
    __device__ __forceinline__ bool next(int i, gs::Unit& u) const {
        const int L = i * stride + c, M = l == 0 ? 144 : 128, nA = M * 23;
        int pm, pn;
        if (md == 0) {
            if (L >= nA + (l == 0 ? 16 : 128)) return false;
            if (L < nA) gs::tile_order(gs::xcd_remap(L, nA), M, 23, pm, pn);
            else { int x = L - nA; if (l == 0) { pm = 128 + x; pn = 23; } else if (x < 96) { pm = 32 + x; pn = 23; } else { x -= 96; pm = 128 + (x >> 1); pn = 10 + (x & 1); } }
        } else { if (L >= (l == 0 ? 128 : 32)) return false; pm = L; pn = 23; }
        u.pm = pm; u.pn = pn; u.kind = 0; u.aux = 0;
        return true;
    }
    __device__ __forceinline__ void ops(const gs::Unit& u, gs::Ops& o) const { o.A = Xn + (size_t)u.pm * 256 * 1024; o.B = W + (size_t)u.pn * 256 * 1024; o.lda = 1024; o.ldb = 1024; o.nt = 8; o.rows = nullptr; }
};
struct EpiB {
    static constexpr bool KEEPS = false, I8 = true;
    bf16_t *U, *V, *Bb, *P, *Ux; unsigned char* G8; const float* sxa; const float* swin;
    __device__ __forceinline__ void operator()(const f32x4 (&acc)[2][2][4][2], const gs::Unit& u, int wr, int wc, int fr, int fq) const {
        const int pn = u.pn, r0 = u.pm * 256 + wr * 64 + fr, c0 = wc * 32 + 8 * fq;
        f32x4 sw[2][2]; float sx[2][4];
#pragma unroll
        for (int bj = 0; bj < 2; ++bj) { sw[bj][0] = *(const f32x4*)(swin + pn * 256 + bj * 128 + c0); sw[bj][1] = *(const f32x4*)(swin + pn * 256 + bj * 128 + c0 + 4); }
#pragma unroll
        for (int ai = 0; ai < 2; ++ai)
#pragma unroll
            for (int m = 0; m < 4; ++m) sx[ai][m] = sxa[r0 + ai * 128 + m * 16];
#define DQ(ai, bj, m, n) (__builtin_convertvector(__builtin_bit_cast(i32x4, acc[ai][bj][m][n]), f32x4) * (sw[bj][n] * sx[ai][m]))
        if (pn < 6) {
            size_t z1 = 0, z2 = 0, z3 = 0; OPAQUE_S(z1); OPAQUE_S(z2); OPAQUE_S(z3); bf16_t *u_ = U + z1, *v_ = V + z2, *b_ = Bb + z3;
            bf16_t* O = pn < 2 ? u_ : (pn < 4 ? v_ : b_); const bool act = pn < 4;
            unsigned char* ob = (unsigned char*)O + ((size_t)(u.pm * 16 + wr * 4) * 16 + (pn & 1) * 8 + wc) * 1024 + fr * 64 + fq * 16;
#pragma unroll
            for (int ai = 0; ai < 2; ++ai)
#pragma unroll
                for (int m = 0; m < 4; ++m) { unsigned char* rowp = ob + (size_t)((ai * 8 + m) * 16) * 1024;
#pragma unroll
                    for (int bj = 0; bj < 2; ++bj) { f32x4 v0 = DQ(ai, bj, m, 0), v1 = DQ(ai, bj, m, 1);
                        if (act) { v0 = gelu4(v0); v1 = gelu4(v1); }
                        *(u32x4*)(rowp + bj * 4096) = pack8(v0, v1); }
                    EPI_FENCE(); }
        } else if (pn < 10) {
            unsigned char* pb_ = (unsigned char*)P + ((size_t)(u.pm * 16 + wr * 4) * 16 + (pn - 6) * 4 + wc) * 1024 + fr * 64 + fq * 16;
#pragma unroll
            for (int ai = 0; ai < 2; ++ai)
#pragma unroll
                for (int m = 0; m < 4; ++m) {
                    *(u32x4*)(pb_ + (size_t)((ai * 8 + m) * 16) * 1024) = pack8(DQ(ai, 0, m, 0) * DQ(ai, 1, m, 0), DQ(ai, 0, m, 1) * DQ(ai, 1, m, 1));
                    EPI_FENCE(); }
        } else if (pn >= 12) {
            unsigned char* gt = G8 + ((size_t)(u.pm * 4 + ((pn - 12) & 3)) * 3 + ((pn - 12) >> 2)) * 65536 + (wr * 16 + wc) * 1024 + (fr * 4 + fq) * 16;
#pragma unroll
            for (int ai = 0; ai < 2; ++ai)
#pragma unroll
                for (int m = 0; m < 4; ++m) { unsigned char* rowp = gt + (ai * 32 + m * 4) * 1024; unsigned wq[2][2];
#pragma unroll
                    for (int bj = 0; bj < 2; ++bj)
#pragma unroll
                        for (int n = 0; n < 2; ++n) wq[bj][n] = gate4_f8_t(__builtin_convertvector(__builtin_bit_cast(i32x4, acc[ai][bj][m][n]), f32x4) * (sw[bj][n] * (sx[ai][m] * -1.44269504089f)));
                    *(u32x4*)rowp = (u32x4){wq[0][0], wq[0][1], wq[1][0], wq[1][1]};
                    EPI_FENCE(); }
        } else {
#pragma unroll
            for (int ai = 0; ai < 2; ++ai)
#pragma unroll
                for (int m = 0; m < 4; ++m) { const int r = r0 + ai * 128 + m * 16, ch = r >> 5, ii = r & 31;
#pragma unroll
                    for (int bj = 0; bj < 2; ++bj) { const int cch = (pn - 10) * 256 + bj * 128 + c0, g = cch >> 4, h0 = cch & 15;
                        *(u32x4*)(Ux + ((size_t)g * NCHP + ch) * 768 + ii * 16 + h0) = pack8(DQ(ai, bj, m, 0), DQ(ai, bj, m, 1)); }
                    EPI_FENCE(); }
        }
#undef DQ
    }
};
struct SchedE {
    static constexpr unsigned ABLK = 0u;
    static constexpr bool POLLS = false;
    const char* Ux; const char* WE; int c;
    __device__ __forceinline__ bool next(int i, gs::Unit& u) const {
        const int L = i * NBLK + c; if (L >= 160) return false;
        u.pm = L % 5; u.pn = 0; u.kind = 0; u.aux = L / 5;
        return true;
    }
    __device__ __forceinline__ void ops(const gs::Unit& u, gs::Ops& o) const { o.A = Ux + ((size_t)u.aux * NCHP + u.pm * 256) * 1536; o.B = WE + (size_t)u.aux * 256 * 1024; o.lda = 1536; o.ldb = 1024; o.nt = 8; o.rows = nullptr; }
};
struct EpiE {
    static constexpr bool KEEPS = false, I8 = false;
    float* E;
    __device__ __forceinline__ void operator()(const f32x4 (&acc)[2][2][4][2], const gs::Unit& u, int wr, int wc, int fr, int fq) const {
        const int g = u.aux, m0 = u.pm * 256 + wr * 64 + fr, c0 = wc * 32 + 8 * fq;
#pragma unroll
        for (int ai = 0; ai < 2; ++ai)
#pragma unroll
            for (int m = 0; m < 4; ++m) { const int mm = m0 + ai * 128 + m * 16;
                if (mm < NCH) { float* rowp = E + ((size_t)g * NCH + mm) * 256 + c0;
#pragma unroll
                    for (int bj = 0; bj < 2; ++bj) { *(f32x4*)(rowp + bj * 128) = acc[ai][bj][m][0]; *(f32x4*)(rowp + bj * 128 + 4) = acc[ai][bj][m][1]; } }
                EPI_FENCE(); }
    }
};
struct SchedY {
    static constexpr unsigned ABLK = 0u;
    static constexpr bool POLLS = false;
    const char* Ux; const char* TW; int l, c, lo, hi;
    __device__ __forceinline__ bool next(int i, gs::Unit& u) const {
        const int L = lo + i * NBLK + c; if (L >= hi) return false;
        if (L < 256) { u.pm = (L & 7) >> 1; u.pn = L & 1; u.aux = L >> 3; } else { const int j = L - 256; u.pm = 4; u.pn = j & 1; u.aux = j >> 1; }
        u.kind = 0;
        return true;
    }
    __device__ __forceinline__ void ops(const gs::Unit& u, gs::Ops& o) const { o.A = Ux + ((size_t)u.aux * NCHP + u.pm * 256) * 1536; o.B = TW + ((size_t)u.aux * 512 + u.pn * 256) * 1536; o.lda = 1536; o.ldb = 1536; o.nt = 12; o.rows = nullptr; }
};
template <bool WT> struct EpiY {
    static constexpr bool KEEPS = false, I8 = false;
    bf16_t* Z;
    __device__ __forceinline__ void operator()(const f32x4 (&acc)[2][2][4][2], const gs::Unit& u, int wr, int wc, int fr, int fq) const {
        const int g = u.aux, m0 = u.pm * 256 + wr * 64 + fr, c0 = u.pn * 256 + wc * 32 + 8 * fq;
#pragma unroll
        for (int ai = 0; ai < 2; ++ai)
#pragma unroll
            for (int m = 0; m < 4; ++m) { const int mm = m0 + ai * 128 + m * 16;
                if (mm < NCH) {
#pragma unroll
                    for (int bj = 0; bj < 2; ++bj) { const int cn = c0 + bj * 128, ii = cn >> 4, h0 = cn & 15; const f32x4 v0 = gelu4(acc[ai][bj][m][0]), v1 = gelu4(acc[ai][bj][m][1]);
                        if constexpr (WT) store16_wt(Z + ((size_t)mm * 32 + ii) * 512 + g * 16 + h0, pack8(v0, v1)); else *(u32x4*)(Z + ((size_t)mm * 32 + ii) * 512 + g * 16 + h0) = pack8(v0, v1); } }
                EPI_FENCE(); }
    }
};
struct SchedF {
    static constexpr unsigned ABLK = 0u;
    static constexpr bool POLLS = true;
    const char* Z; const char* W; int l, c, lo, hi; unsigned* ydone; int wave;
    __device__ __forceinline__ bool next(int i, gs::Unit& u) const {
        const int L = lo + i * NBLK + c; if (L >= hi) return false;
        int pm, pn;
        if (L < 256) gs::tile_order(gs::xcd_remap(L, 256), 128, 2, pm, pn);
        else { pm = 128 + ((L - 256) >> 1); pn = (L - 256) & 1; if (wave == 0) { spin_count_ge(ydone, 512u); acquire_agent(); } }
        u.pm = pm; u.pn = pn; u.kind = 0; u.aux = 0;
        return true;
    }
    __device__ __forceinline__ void ops(const gs::Unit& u, gs::Ops& o) const { o.A = Z + (size_t)u.pm * 256 * 1024; o.B = W + (size_t)u.pn * 256 * 1024; o.lda = 1024; o.ldb = 1024; o.nt = 8; o.rows = nullptr; }
};
template <bool WT> struct EpiF {
    static constexpr bool KEEPS = false, I8 = false;
    const bf16_t* Z; bf16_t* Yc; const float* gb;
    __device__ __forceinline__ void operator()(const f32x4 (&acc)[2][2][4][2], const gs::Unit& u, int wr, int wc, int fr, int fq) const {
        const int r0 = u.pm * 256 + wr * 64 + fr, c0 = u.pn * 256 + wc * 32 + 8 * fq;
        f32x4 gbv[2][2];
#pragma unroll
        for (int bj = 0; bj < 2; ++bj) { gbv[bj][0] = *(const f32x4*)(gb + c0 + bj * 128) * -1.44269504089f; gbv[bj][1] = *(const f32x4*)(gb + c0 + bj * 128 + 4) * -1.44269504089f; }
        u32x4 zall[2][2][4];
#pragma unroll
        for (int ai = 0; ai < 2; ++ai)
#pragma unroll
            for (int mh = 0; mh < 2; ++mh)
#pragma unroll
                for (int x = 0; x < 4; ++x) zall[ai][mh][x] = *(const u32x4*)(Z + (size_t)(r0 + ai * 128 + (mh * 2 + (x >> 1)) * 16) * 512 + c0 + (x & 1) * 128);
#pragma unroll
        for (int ai = 0; ai < 2; ++ai)
#pragma unroll
            for (int mh = 0; mh < 2; ++mh) {
                const u32x4 (&zw)[4] = zall[ai][mh];
#pragma unroll
                for (int x = 0; x < 4; ++x) { const int m = mh * 2 + (x >> 1), bj = x & 1; const size_t ro = (size_t)(r0 + ai * 128 + m * 16) * 512 + c0;
                    f32x4 z0, z1; unpack8(zw[x], z0, z1);
                    const f32x4 v0 = z0 * sig4_t(acc[ai][bj][m][0] * -1.44269504089f + gbv[bj][0]), v1 = z1 * sig4_t(acc[ai][bj][m][1] * -1.44269504089f + gbv[bj][1]);
                    unsigned char* yp = (unsigned char*)Yc + ((size_t)(u.pm * 16 + ai * 8 + wr * 4 + m) * 16 + u.pn * 8 + bj * 4 + wc) * 1024 + fr * 64 + fq * 16;
                    if constexpr (WT) store16_wt(yp, pack8(v0, v1)); else *(u32x4*)yp = pack8(v0, v1); }
                EPI_FENCE(); }
    }
};
struct SchedG {
    static constexpr unsigned ABLK = 16384u;
    static constexpr bool POLLS = true;
    const char* Y0; const char* Y1; const char* Y2; const char* Wbr; int l, c; unsigned* fdone; int wave;
    __device__ __forceinline__ bool next(int i, gs::Unit& u) const {
        const int ntile = l == 0 ? 576 : 512, tl = i / 3, s = i % 3, L = tl * NBLK + c; if (L >= ntile) return false;
        int pm, pn;
        if (L < 512) gs::tile_order(gs::xcd_remap(L, 512), 128, 4, pm, pn); else { pm = 128 + ((L - 512) >> 2); pn = (L - 512) & 3; }
        u.pm = pm; u.pn = pn; u.kind = s; u.aux = 0;
        if (s == 2 && pm >= 128 && wave == 0) { spin_count_ge(fdone + (pm - 128) * 16, 16u); acquire_agent(); }
        return true;
    }
    __device__ __forceinline__ void ops(const gs::Unit& u, gs::Ops& o) const {
        const int br = u.kind;
        size_t z1 = 0, z2 = 0, z3 = 0; OPAQUE_S(z1); OPAQUE_S(z2); OPAQUE_S(z3); const char *y0_ = Y0 + z1, *y1_ = Y1 + z2, *y2_ = Y2 + z3; const char* y = br == 0 ? y0_ : (br == 1 ? y1_ : y2_);
        o.A = y + (size_t)u.pm * 256 * 1024; o.B = Wbr + ((size_t)br * 1024 + u.pn * 256) * 1024; o.lda = 1024; o.ldb = 1024; o.nt = 8; o.rows = nullptr;
    }
};
__device__ __forceinline__ void f8x8_to_f32(const u32x2 w, f32x4& a, f32x4& b) {
    const f32x2 a0 = __builtin_amdgcn_cvt_pk_f32_fp8((int)w.x, false), a1 = __builtin_amdgcn_cvt_pk_f32_fp8((int)w.x, true);
    const f32x2 b0 = __builtin_amdgcn_cvt_pk_f32_fp8((int)w.y, false), b1 = __builtin_amdgcn_cvt_pk_f32_fp8((int)w.y, true);
    a = (f32x4){a0[0], a0[1], a1[0], a1[1]}; b = (f32x4){b0[0], b0[1], b1[0], b1[1]};
}
struct EpiG {
    static constexpr bool KEEPS = true, I8 = false;
    const unsigned char* G8; bf16_t* merged;
    __device__ __forceinline__ bool scale(f32x4 (&acc)[2][2][4][2], const gs::Unit& u, int wr, int wc, int fr, int fq) const {
        const int s = u.kind, r0 = u.pm * 256 + wr * 64 + fr, c0 = u.pn * 256 + wc * 32 + 8 * fq;
        const unsigned char* gp = G8 + ((size_t)(u.pm * 4 + u.pn) * 3 + s) * 65536 + (wr * 16 + wc) * 1024 + (fr * 4 + fq) * 16;
        u32x4 ga8[2][4], gb8[2][4];
#pragma unroll
        for (int ai = 0; ai < 2; ++ai)
#pragma unroll
            for (int m = 0; m < 4; ++m) { const size_t o = (size_t)(ai * 32 + m * 4) * 1024; ga8[ai][m] = *(const u32x4*)(gp + o); if (s < 2) gb8[ai][m] = *(const u32x4*)(gp + o + 65536); }
#pragma unroll
        for (int ai = 0; ai < 2; ++ai) {
            const u32x4 (&ga4)[4] = ga8[ai]; const u32x4 (&gb4)[4] = gb8[ai];
#pragma unroll
            for (int x = 0; x < 8; ++x) { const int m = x >> 1, bj = x & 1;
                const u32x2 gax = bj == 0 ? (u32x2){ga4[m].x, ga4[m].y} : (u32x2){ga4[m].z, ga4[m].w};
                f32x4 e0, e1, n0, n1; f8x8_to_f32(gax, e0, e1);
#pragma unroll
                for (int j = 0; j < 4; ++j) { n0[j] = __builtin_amdgcn_rcpf(e0[j]); n1[j] = __builtin_amdgcn_rcpf(e1[j]); }
                if (s < 2) { const u32x2 gbx = bj == 0 ? (u32x2){gb4[m].x, gb4[m].y} : (u32x2){gb4[m].z, gb4[m].w}; f32x4 d0, d1; f8x8_to_f32(gbx, d0, d1); n0 = n0 * d0; n1 = n1 * d1; }
                acc[ai][bj][m][0] *= n0; acc[ai][bj][m][1] *= n1;
                if (s == 2) *(u32x4*)((unsigned char*)merged + ((size_t)(u.pm * 16 + ai * 8 + wr * 4 + m) * 32 + u.pn * 8 + bj * 4 + wc) * 1024 + fr * 64 + fq * 16) = pack8(acc[ai][bj][m][0], acc[ai][bj][m][1]); }
            EPI_FENCE(); }
        return s < 2;
    }
};
struct SchedH {
    static constexpr unsigned ABLK = 32768u;
    static constexpr bool POLLS = false;
    const char* A; const char* W; int l, c;
    __device__ __forceinline__ bool next(int i, gs::Unit& u) const {
        const int nM = l == 0 ? 144 : 128, ntot = nM * 4, L = i * NBLK + c; if (L >= ntot) return false;
        int pm, pn; gs::tile_order(gs::xcd_remap(L, ntot), nM, 4, pm, pn);
        u.pm = pm; u.pn = pn; u.kind = 0; u.aux = 0;
        return true;
    }
    __device__ __forceinline__ void ops(const gs::Unit& u, gs::Ops& o) const { o.A = A + (size_t)u.pm * 256 * 2048; o.B = W + (size_t)u.pn * 256 * 2048; o.lda = 2048; o.ldb = 2048; o.nt = 16; o.rows = nullptr; }
};
template <int LZ> struct EpiH {
    static constexpr bool KEEPS = false, I8 = false;
    const float* xin; const float* cin; bf16_t* Hb; const float* mod;
    LAS unsigned char* tb; int tid;
    __device__ __forceinline__ void operator()(const f32x4 (&acc)[2][2][4][2], const gs::Unit& u, int wr, int wc, int fr, int fq) const {
        constexpr int PT = 528;
        const int rt = u.pm * 256, c0 = u.pn * 256 + wc * 32 + 8 * fq;
        const bool lat = rt < TLAT; const int mi = lat ? (rt >> 11) : 16;
        size_t z1 = 0, z2 = 0; OPAQUE_S(z1); OPAQUE_S(z2);
        const float* base = lat ? (xin + z1 + (size_t)rt * D) : (cin + z2 + (size_t)(rt - TLAT) * D);
        bf16_t* hb = Hb + (size_t)rt * D;
        const float* g1 = mod + (size_t)mi * 6144 + 2048 + c0;
        f32x4 g1v[2][2];
#pragma unroll
        for (int bj = 0; bj < 2; ++bj) { g1v[bj][0] = *(const f32x4*)(g1 + bj * 128); g1v[bj][1] = *(const f32x4*)(g1 + bj * 128 + 4); }
        const int trow = tid >> 5, tp = tid & 31;
        LAS unsigned char* wp = tb + (wr * 16 + fr) * PT + (wc * 32 + 8 * fq) * 2;
        const LAS unsigned char* rp = tb + trow * PT + tp * 16;
        const size_t tro = (size_t)trow * D + u.pn * 256 + tp * 8;
        u32x4 raw[4][2][LZ == 1 ? 2 : 1];
#define EH_LOAD(st_) do { _Pragma("unroll") for (int ps = 0; ps < 2; ++ps) { const size_t ro_ = tro + (size_t)(128 * ((st_) >> 2) + 64 * ps + 16 * ((st_) & 3)) * D; \
            if constexpr (LZ == 1) { raw[(st_) & 3][ps][0] = *(const u32x4*)(base + ro_); raw[(st_) & 3][ps][LZ == 1 ? 1 : 0] = *(const u32x4*)(base + ro_ + 4); } \
            else raw[(st_) & 3][ps][0] = *(const u32x4*)(hb + ro_); } } while (0)
        EH_LOAD(0); EH_LOAD(1); EH_LOAD(2); EH_LOAD(3);
#pragma unroll
        for (int st = 0; st < 8; ++st) { const int ai = st >> 2, m = st & 3;
#pragma unroll
            for (int bj = 0; bj < 2; ++bj) *(LAS u32x4*)(wp + bj * 256) = pack8(g1v[bj][0] * acc[ai][bj][m][0], g1v[bj][1] * acc[ai][bj][m][1]);
            asm volatile("s_waitcnt lgkmcnt(0)" ::: "memory"); __builtin_amdgcn_s_barrier();
            u32x4 dv[2];
#pragma unroll
            for (int ps = 0; ps < 2; ++ps) dv[ps] = *(const LAS u32x4*)(rp + ps * 16 * PT);
#pragma unroll
            for (int ps = 0; ps < 2; ++ps) { f32x4 d0, d1, h0, h1; unpack8(dv[ps], d0, d1);
                if constexpr (LZ == 1) { h0 = __builtin_bit_cast(f32x4, raw[st & 3][ps][0]); h1 = __builtin_bit_cast(f32x4, raw[st & 3][ps][LZ == 1 ? 1 : 0]); } else unpack8(raw[st & 3][ps][0], h0, h1);
                *(u32x4*)(hb + tro + (size_t)(128 * ai + 64 * ps + 16 * m) * D) = pack8(h0 + d0, h1 + d1); }
            if (st + 4 < 8) EH_LOAD(st + 4);
            asm volatile("s_waitcnt lgkmcnt(0)" ::: "memory"); __builtin_amdgcn_s_barrier();
        }
#undef EH_LOAD
    }
};
struct SchedK {
    static constexpr unsigned ABLK = 0u;
    static constexpr bool POLLS = false;
    const char* Xn2; const char* Wgu; const int* rowl; const LAS int* toff; int c;
    __device__ __forceinline__ bool next(int i, gs::Unit& u) const {
        const int nt_ = __builtin_amdgcn_readfirstlane(toff[16]), ntot = nt_ * 4, L = i * NBLK + c; if (L >= ntot) return false;
        const int w = gs::xcd_remap(L, ntot), mt = w >> 2; int e = 0;
        { unsigned z_ = 0u; asm volatile("" : "+v"(z_));
          const int ln = (int)__builtin_amdgcn_mbcnt_hi(~0u, __builtin_amdgcn_mbcnt_lo(~0u, z_)), tv = toff[ln < 16 ? ln : 16];
          e = __builtin_popcountll(__ballot(ln >= 1 && ln < 16 && tv <= mt)); }
        u.pm = mt; u.pn = w & 3; u.kind = 0; u.aux = e;
        return true;
    }
    __device__ __forceinline__ void ops(const gs::Unit& u, gs::Ops& o) const { o.A = Xn2; o.B = Wgu + ((size_t)u.aux * 1024 + u.pn * 256) * 1024; o.lda = 1024; o.ldb = 1024; o.nt = 8; o.rows = rowl + u.pm * 256; }
};
struct EpiK {
    static constexpr bool KEEPS = false, I8 = true;
    bf16_t* He; const float* sxs; const float* swgu;
    __device__ __forceinline__ void operator()(const f32x4 (&acc)[2][2][4][2], const gs::Unit& u, int wr, int wc, int fr, int fq) const {
        const int r0 = u.pm * 256 + wr * 64 + fr, c0 = u.pn * 128 + wc * 32 + 8 * fq, t0 = u.aux * 1024 + u.pn * 256 + wc * 32 + 8 * fq;
        f32x4 sw[2][2]; float sx[2][4];
#pragma unroll
        for (int bj = 0; bj < 2; ++bj) { const float k = bj == 0 ? -1.44269504089f : -0.69314718056f;
            sw[bj][0] = *(const f32x4*)(swgu + t0 + bj * 128) * k; sw[bj][1] = *(const f32x4*)(swgu + t0 + bj * 128 + 4) * k; }
#pragma unroll
        for (int ai = 0; ai < 2; ++ai)
#pragma unroll
            for (int m = 0; m < 4; ++m) sx[ai][m] = sxs[r0 + ai * 128 + m * 16];
#define DQ(ai, bj, m, n) (__builtin_convertvector(__builtin_bit_cast(i32x4, acc[ai][bj][m][n]), f32x4) * (sw[bj][n] * sx[ai][m]))
#pragma unroll
        for (int ai = 0; ai < 2; ++ai)
#pragma unroll
            for (int m = 0; m < 4; ++m) { const f32x4 t0_ = DQ(ai, 0, m, 0), t1_ = DQ(ai, 0, m, 1), u0 = DQ(ai, 1, m, 0), u1 = DQ(ai, 1, m, 1);
                const f32x4 v0 = t0_ * sig4_t(t0_) * u0, v1 = t1_ * sig4_t(t1_) * u1;
                *(u32x4*)((unsigned char*)He + ((size_t)(u.pm * 16 + ai * 8 + wr * 4 + m) * 16 + u.pn * 4 + wc) * 1024 + fr * 64 + fq * 16) = pack8(v0, v1);
                EPI_FENCE(); }
#undef DQ
    }
};
struct SchedL {
    static constexpr unsigned ABLK = 16384u;
    static constexpr bool POLLS = false;
    const char* He; const char* Wd; const LAS int* toff; int c;
    __device__ __forceinline__ bool next(int i, gs::Unit& u) const {
        const int nt_ = __builtin_amdgcn_readfirstlane(toff[16]), ntot = nt_ * 4, L = i * NBLK + c; if (L >= ntot) return false;
        const int w = gs::xcd_remap(L, ntot), mt = w >> 2; int e = 0;
        { unsigned z_ = 0u; asm volatile("" : "+v"(z_));
          const int ln = (int)__builtin_amdgcn_mbcnt_hi(~0u, __builtin_amdgcn_mbcnt_lo(~0u, z_)), tv = toff[ln < 16 ? ln : 16];
          e = __builtin_popcountll(__ballot(ln >= 1 && ln < 16 && tv <= mt)); }
        u.pm = mt; u.pn = w & 3; u.kind = 0; u.aux = e;
        return true;
    }
    __device__ __forceinline__ void ops(const gs::Unit& u, gs::Ops& o) const { o.A = He + (size_t)u.pm * 256 * 1024; o.B = Wd + ((size_t)u.aux * 1024 + u.pn * 256) * 1024; o.lda = 1024; o.ldb = 1024; o.nt = 8; o.rows = nullptr; }
};
struct EpiL {
    static constexpr bool KEEPS = false, I8 = false;
    unsigned char* Y8; float* Ysc; const float* wl;
    LAS unsigned char* tb; int tid;
    __device__ __forceinline__ void operator()(const f32x4 (&acc)[2][2][4][2], const gs::Unit& u, int wr, int wc, int fr, int fq) const {
        constexpr int PT = 272;
        const int r0 = u.pm * 256 + wr * 64 + fr;
        float wv[2][4];
#pragma unroll
        for (int ai = 0; ai < 2; ++ai)
#pragma unroll
            for (int m = 0; m < 4; ++m) wv[ai][m] = wl[r0 + ai * 128 + m * 16];
        LAS unsigned char* wp = tb + (wr * 16 + fr) * PT + wc * 32 + 8 * fq;
        const int trow = tid >> 4, tp = tid & 15;
#pragma unroll
        for (int ai = 0; ai < 2; ++ai)
#pragma unroll
            for (int mh = 0; mh < 2; ++mh) {
#pragma unroll
                for (int mm = 0; mm < 2; ++mm) { const int m = 2 * mh + mm, r = r0 + ai * 128 + m * 16; const float w = wv[ai][m]; float sc2[2];
#pragma unroll
                    for (int bj = 0; bj < 2; ++bj) { const f32x4 v0 = acc[ai][bj][m][0], v1 = acc[ai][bj][m][1];
                        float am = fmaxf(fmaxf(fmaxf(fabsf(v0[0]), fabsf(v0[1])), fmaxf(fabsf(v0[2]), fabsf(v0[3]))), fmaxf(fmaxf(fabsf(v1[0]), fabsf(v1[1])), fmaxf(fabsf(v1[2]), fabsf(v1[3]))));
                        { const unsigned ab = __float_as_uint(am); const auto s16 = __builtin_amdgcn_permlane16_swap(ab, ab, false, false); am = fmaxf(__uint_as_float(s16[0]), __uint_as_float(s16[1])); }
                        { const unsigned ab = __float_as_uint(am); const auto s32 = __builtin_amdgcn_permlane32_swap(ab, ab, false, false); am = fmaxf(__uint_as_float(s32[0]), __uint_as_float(s32[1])); }
                        am = fmaxf(am * fabsf(w), 1e-30f);
                        const float inv = w * (127.0f * __builtin_amdgcn_rcpf(am));
                        *(LAS u32x2*)(wp + mm * 32 * PT + bj * 128) = (u32x2){q8x4u(v0, inv), q8x4u(v1, inv)};
                        sc2[bj] = am * (1.0f / 127.0f); }
                    if (fq == 0) *(f32x2*)(Ysc + (size_t)r * 32 + YSC_IDX(u.pn * 8 + wc)) = (f32x2){sc2[0], sc2[1]};
                    EPI_FENCE(); }
                asm volatile("s_waitcnt lgkmcnt(0)" ::: "memory"); __builtin_amdgcn_s_barrier();
#pragma unroll
                for (int ps = 0; ps < 2; ++ps) {
                    const u32x4 dv = *(const LAS u32x4*)(tb + (trow + 32 * ps) * PT + tp * 16);
                    *(u32x4*)(Y8 + (size_t)(u.pm * 256 + 128 * ai + 64 * ((trow >> 4) & 1) + 16 * (2 * mh + ps) + (trow & 15)) * 1024 + u.pn * 256 + tp * 16) = dv; }
                asm volatile("s_waitcnt lgkmcnt(0)" ::: "memory"); __builtin_amdgcn_s_barrier();
            }
    }
};

__device__ __forceinline__ void phase_sgu(const Params& p, const Frame& F, int l) {
    bf16_t* U = (bf16_t*)(p.ws + OFF_U); const bf16_t* V = (const bf16_t*)(p.ws + OFF_V);
    const bf16_t* W16 = (const bf16_t*)(p.ws + OFF_SGUW16) + (size_t)l * 4 * 128 * 128;
    LAS float* mu = (LAS float*)F.lds; LAS float* rsd = mu + 128;
    LAS unsigned char* Vn = F.lds + 1024;
    LAS unsigned char* Wl = F.lds + 1024 + 128 * 264;
    const int nchunk = l == 0 ? 288 : 256, tid = F.tid, lane = F.lane, wave = F.wave;
    const float* gam = p.in[I_SGUNG] + l * 512;
    const int vk = tid >> 2, vpart = tid & 3;
    for (int un = 0; un < 2; ++un) {
        int cu, hd0, hd1;
        if (un == 0) { cu = F.blk; hd0 = 0; hd1 = 4; if (cu >= nchunk) continue; }
        else { const int x = F.blk - 128; if (x < 0 || 256 + (x >> 2) >= nchunk) continue; cu = 256 + (x >> 2); hd0 = x & 3; hd1 = hd0 + 1; }
        const int r0 = cu * 128;
        __syncthreads();
        {
            u32x4 w16[16];
            const unsigned char* vg = (const unsigned char*)V + ((size_t)((r0 >> 4) + wave) * 16) * 1024 + (lane & 15) * 64 + (lane >> 4) * 16;
#pragma unroll
            for (int x = 0; x < 16; ++x) w16[x] = *(const u32x4*)(vg + x * 1024);
            float sm = 0.f;
#pragma unroll
            for (int x = 0; x < 16; ++x) { f32x4 a, b; unpack8(w16[x], a, b); sm += ((a[0] + a[1]) + (a[2] + a[3])) + ((b[0] + b[1]) + (b[2] + b[3])); }
#define SGU_ROWSUM(v) do { { const unsigned ab_ = __float_as_uint(v); const auto s16_ = __builtin_amdgcn_permlane16_swap(ab_, ab_, false, false); v = __uint_as_float(s16_[0]) + __uint_as_float(s16_[1]); } \
                           { const unsigned ab_ = __float_as_uint(v); const auto s32_ = __builtin_amdgcn_permlane32_swap(ab_, ab_, false, false); v = __uint_as_float(s32_[0]) + __uint_as_float(s32_[1]); } } while (0)
            SGU_ROWSUM(sm);
            const float mean = sm * (1.0f / 512.0f);
            float q = 0.f;
#pragma unroll
            for (int x = 0; x < 16; ++x) { f32x4 a, b; unpack8(w16[x], a, b); a = a - mean; b = b - mean;
                q += ((a[0] * a[0] + a[1] * a[1]) + (a[2] * a[2] + a[3] * a[3])) + ((b[0] * b[0] + b[1] * b[1]) + (b[2] * b[2] + b[3] * b[3])); }
            SGU_ROWSUM(q);
#undef SGU_ROWSUM
            if (lane < 16) { const int k = wave * 16 + lane; mu[k] = mean; rsd[k] = 1.0f / sqrtf(q * (1.0f / 512.0f) + EPS); }
        }
        u32x4 pv[4], pw[4]; f32x4 pg[4][2];
#define SGU_PREFETCH(hd_) do { _Pragma("unroll") for (int x = 0; x < 4; ++x) { pv[x] = *(const u32x4*)((const unsigned char*)V + ((size_t)((r0 + vk) >> 4) * 16 + (hd_) * 4 + vpart) * 1024 + (vk & 15) * 64 + x * 16); \
            pw[x] = *(const u32x4*)(W16 + (size_t)(hd_) * 16384 + (tid + x * 512) * 8); \
            pg[x][0] = *(const f32x4*)(gam + (hd_) * 128 + vpart * 32 + x * 8); pg[x][1] = *(const f32x4*)(gam + (hd_) * 128 + vpart * 32 + x * 8 + 4); } } while (0)
        SGU_PREFETCH(hd0);
        for (int hd = hd0; hd < hd1; ++hd) {
            __syncthreads();
            { const float m_ = mu[vk], r_ = rsd[vk];
#pragma unroll
              for (int x = 0; x < 4; ++x) { const int c = vpart * 32 + x * 8;
                  f32x4 a, b; unpack8(pv[x], a, b); const f32x4 ga = pg[x][0], gb = pg[x][1];
                  a = (a - m_) * r_ * ga; b = (b - m_) * r_ * gb;
                  u32x2 o0, o1; o0.x = cvt_pk_bf16(a[0], a[1]); o0.y = cvt_pk_bf16(a[2], a[3]); o1.x = cvt_pk_bf16(b[0], b[1]); o1.y = cvt_pk_bf16(b[2], b[3]);
                  *(LAS u32x2*)(Vn + vk * 264 + c * 2) = o0; *(LAS u32x2*)(Vn + vk * 264 + c * 2 + 8) = o1;
                  const int e8 = (tid + x * 512) * 8, qq = e8 >> 7, kk = e8 & 127; *(LAS u32x4*)(Wl + qq * 272 + kk * 2) = pw[x]; } }
            if (hd + 1 < hd1) SGU_PREFETCH(hd + 1);
            const int kg = lane >> 4, cl = wave * 16 + (lane & 15);
            u32x4 uw4[4];
            unsigned char* uptr = (unsigned char*)U + ((size_t)((r0 >> 4) + (kg & 1)) * 16 + hd * 4 + (wave >> 1)) * 1024 + (lane & 15) * 64 + ((wave & 1) * 2 + (kg >> 1)) * 16;
#pragma unroll
            for (int qp = 0; qp < 4; ++qp) uw4[qp] = *(const u32x4*)(uptr + (size_t)qp * 32768);
            const float* bs = p.in[I_SGUB] + ((size_t)l * 4 + hd) * 128;
            float bqv[8];
#pragma unroll
            for (int qt = 0; qt < 8; ++qt) bqv[qt] = bs[qt * 16 + (lane & 15)];
            __syncthreads();
            f32x4 o[8];
#pragma unroll
            for (int qt = 0; qt < 8; ++qt) o[qt] = (f32x4){0.f, 0.f, 0.f, 0.f};
#pragma unroll
            for (int ks = 0; ks < 4; ++ks) {
                bf16x8 af, bfv[8];
#pragma unroll
                for (int j = 0; j < 8; ++j) af[j] = (short)*(const LAS bf16_t*)(Vn + (ks * 32 + kg * 8 + j) * 264 + cl * 2);
#pragma unroll
                for (int qt = 0; qt < 8; ++qt) bfv[qt] = *(const LAS bf16x8*)(Wl + (qt * 16 + (lane & 15)) * 272 + (ks * 32 + kg * 8) * 2);
                __builtin_amdgcn_sched_barrier(0);
#pragma unroll
                for (int qt = 0; qt < 8; ++qt) o[qt] = __builtin_amdgcn_mfma_f32_16x16x32_bf16(af, bfv[qt], o[qt], 0, 0, 0);
                __builtin_amdgcn_sched_barrier(0);
            }
#pragma unroll
            for (int qp = 0; qp < 4; ++qp) {
                u32x2 ua = (u32x2){uw4[qp].x, uw4[qp].y}, ub = (u32x2){uw4[qp].z, uw4[qp].w};
                { const auto r0_ = __builtin_amdgcn_permlane16_swap(ua.x, ub.x, false, false); ua.x = r0_[0]; ub.x = r0_[1];
                  const auto r1_ = __builtin_amdgcn_permlane16_swap(ua.y, ub.y, false, false); ua.y = r1_[0]; ub.y = r1_[1]; }
                u32x2 oa, ob; { const int qt = 2 * qp; const float bq = bqv[qt];
                    oa.x = cvt_pk_bf16(bf_lo(ua.x) * (o[qt][0] + bq), bf_hi(ua.x) * (o[qt][1] + bq)); oa.y = cvt_pk_bf16(bf_lo(ua.y) * (o[qt][2] + bq), bf_hi(ua.y) * (o[qt][3] + bq)); }
                { const int qt = 2 * qp + 1; const float bq = bqv[qt];
                    ob.x = cvt_pk_bf16(bf_lo(ub.x) * (o[qt][0] + bq), bf_hi(ub.x) * (o[qt][1] + bq)); ob.y = cvt_pk_bf16(bf_lo(ub.y) * (o[qt][2] + bq), bf_hi(ub.y) * (o[qt][3] + bq)); }
                { const auto r0_ = __builtin_amdgcn_permlane16_swap(oa.x, ob.x, false, false); oa.x = r0_[0]; ob.x = r0_[1];
                  const auto r1_ = __builtin_amdgcn_permlane16_swap(oa.y, ob.y, false, false); oa.y = r1_[0]; ob.y = r1_[1]; }
                *(u32x4*)(uptr + (size_t)qp * 32768) = (u32x4){oa.x, oa.y, ob.x, ob.y}; }
        }
#undef SGU_PREFETCH
    }
    __syncthreads();
}
__device__ __forceinline__ void phase_conv(const Params& p, const Frame& F, int l) {
    unsigned char* Bb = p.ws + OFF_BB; const unsigned char* P = p.ws + OFF_P;
    const float* cw = p.in[I_CONVW] + l * 3 * 512;
    const int nrows = l == 0 ? TALL : TLAT, ngrp = nrows >> 4;
    const int rl = F.lane & 15, pc = F.lane >> 4;
    f32x4 wt[2][6];
#pragma unroll
    for (int h = 0; h < 2; ++h) { const int c = (F.wave + 8 * h) * 32 + pc * 8;
        wt[h][0] = *(const f32x4*)(cw + c); wt[h][1] = *(const f32x4*)(cw + c + 4); wt[h][2] = *(const f32x4*)(cw + 512 + c); wt[h][3] = *(const f32x4*)(cw + 512 + c + 4); wt[h][4] = *(const f32x4*)(cw + 1024 + c); wt[h][5] = *(const f32x4*)(cw + 1024 + c + 4); }
    const int wA = 14, wB = l == 0 ? 2 : 12, wC = l == 0 ? 13 : 30, wtot = 160 * wA + 32 * wB + 64 * wC;
    const int kb0 = F.blk, kb1 = F.blk + 1;
    const int p0 = kb0 < 160 ? kb0 * wA : (kb0 < 192 ? 160 * wA + (kb0 - 160) * wB : 160 * wA + 32 * wB + (kb0 - 192) * wC), p1 = kb1 < 160 ? kb1 * wA : (kb1 < 192 ? 160 * wA + (kb1 - 160) * wB : 160 * wA + 32 * wB + (kb1 - 192) * wC);
    const int glo = (int)((long long)ngrp * p0 / wtot), ghi = kb1 == NBLK ? ngrp : (int)((long long)ngrp * p1 / wtot);
    for (int g = glo; g < ghi; ++g) {
        const int r = g * 16 + rl, sq = r < TLAT ? (r & 63) : ((r - TLAT) & 255), smax = r < TLAT ? 63 : 255;
        const long long dprev = rl > 0 ? -64 : -16384 + 960, dnext = rl < 15 ? 64 : 16384 - 960;
        const u32x4 zero = (u32x4){0u, 0u, 0u, 0u};
        u32x4 xc[2], xp[2], xn[2], xb[2];
#pragma unroll
        for (int h = 0; h < 2; ++h) { const size_t o = ((size_t)g * 16 + F.wave + 8 * h) * 1024 + rl * 64 + pc * 16;
            xc[h] = *(const u32x4*)(P + o); xp[h] = sq > 0 ? *(const u32x4*)(P + o + dprev) : zero; xn[h] = sq < smax ? *(const u32x4*)(P + o + dnext) : zero; xb[h] = *(const u32x4*)(Bb + o); }
#pragma unroll
        for (int h = 0; h < 2; ++h) { const size_t o = ((size_t)g * 16 + F.wave + 8 * h) * 1024 + rl * 64 + pc * 16;
            f32x4 x0, x1, pa, pb, na, nb, b0, b1; unpack8(xc[h], x0, x1); unpack8(xp[h], pa, pb); unpack8(xn[h], na, nb); unpack8(xb[h], b0, b1);
            *(u32x4*)(Bb + o) = pack8(b0 * (wt[h][0] * pa + wt[h][2] * x0 + wt[h][4] * na), b1 * (wt[h][1] * pb + wt[h][3] * x1 + wt[h][5] * nb)); }
    }
}
__device__ __forceinline__ void phase_scan(const Params& p, const Frame& F, int l) {
    if (F.blk >= 128) return;
    const int T = F.blk * NTHR + F.tid, pp = T & 63, g = (T >> 6) & 31, b = (T >> 11) & 15, dir = T >> 15;
    const float* E = (const float*)(p.ws + OFF_E) + (size_t)g * NCH * 256 + dir * 128 + pp;
    bf16_t* Ux = (bf16_t*)(p.ws + OFF_UX) + (size_t)g * NCHP * 768 + 512 + dir * 128 + pp;
    const float* aq = (const float*)(p.ws + OFF_AQ) + ((((size_t)l * 2 + dir) * 32 + g) * 64 + pp) * 2;
    const float ar = aq[0], ai = aq[1];
    float sr = 0.f, si = 0.f;
#define SCAN_M(st) (dir == 0 ? ((st) < 8 ? (1024 + b * 8 + (st)) : (b * 64 + ((st) - 8))) : ((st) < 8 ? (1024 + b * 8 + (7 - (st))) : (b * 64 + (71 - (st)))))
    for (int sb = 0; sb < 72; sb += 24) {
        float er[24], ei[24];
#pragma unroll
        for (int x = 0; x < 24; ++x) { const int m = SCAN_M(sb + x); er[x] = E[(size_t)m * 256]; ei[x] = E[(size_t)m * 256 + 64]; }
#pragma unroll
        for (int x = 0; x < 24; ++x) { const int m = SCAN_M(sb + x);
            Ux[(size_t)m * 768] = (bf16_t)(cvt_pk_bf16_f(sr, 0.f) & 0xffffu); Ux[(size_t)m * 768 + 64] = (bf16_t)(cvt_pk_bf16_f(si, 0.f) & 0xffffu);
            const float nr = ar * sr - ai * si + er[x], ni = ar * si + ai * sr + ei[x]; sr = nr; si = ni; }
    }
#undef SCAN_M
}
__device__ __forceinline__ void phase_router(const Params& p, const Frame& F, int l) {
    const float* mod = (const float*)(p.ws + OFF_MOD);
    signed char* Xq2 = (signed char*)(p.ws + OFF_XN); float* sx2 = (float*)(p.ws + OFF_SX2);
    LAS float* rw = (LAS float*)F.lds;
    LAS int* lsel = (LAS int*)(F.lds + 133632);
    LAS int* lrk = lsel + 288;
    LAS float* lgs = (LAS float*)(lrk + 288);
    int* sel = (int*)(p.ws + OFF_SEL); float* wsel = (float*)(p.ws + OFF_WSEL); int* lrank = (int*)(p.ws + OFF_LRANK); int* cnt = (int*)(p.ws + OFF_CNT);
    const int NR = l == 0 ? 144 : 128, RW = NR / 8, lane = F.lane;
    __syncthreads();
    { f32x4 wt[8];
#pragma unroll
      for (int x = 0; x < 8; ++x) wt[x] = *(const f32x4*)(p.in[I_RW] + (F.tid + x * NTHR) * 4);
#pragma unroll
      for (int x = 0; x < 8; ++x) { const int i = (F.tid + x * NTHR) * 4, kk = i >> 4, e = i & 15;
          const int k = 4 * ((kk & 511) >> 3) + 256 * (2 * (kk >> 9) + ((kk >> 2) & 1)) + (kk & 3);
          rw[e * 1024 + k] = wt[x][0]; rw[(e + 1) * 1024 + k] = wt[x][1]; rw[(e + 2) * 1024 + k] = wt[x][2]; rw[(e + 3) * 1024 + k] = wt[x][3]; } }
    __syncthreads();
    float rb[16];
#pragma unroll
    for (int e = 0; e < 16; ++e) rb[e] = p.in[I_RB][e];
    const int row0 = F.blk * NR + F.wave * RW;
    f32x4 chA[4], chB[4], mg[4], ms[4]; int cmi = -1;
#define RT_K(j) (8 * lane + 512 * ((j) >> 1) + 4 * ((j) & 1))
#define RT_LOAD(rr, H) do { const bf16_t* hp_ = hrow_ptr(p, (rr)); _Pragma("unroll") for (int jj = 0; jj < 2; ++jj) { const u32x4 w_ = *(const u32x4*)(hp_ + 8 * lane + 512 * jj); \
            H[2 * jj] = bf4((u32x2){w_.x, w_.y}); H[2 * jj + 1] = bf4((u32x2){w_.z, w_.w}); } } while (0)
#define RT_NORM(rr, V) do { const int r_ = (rr), mi_ = mod_index(r_); float ss_ = 0.f; \
        _Pragma("unroll") for (int j = 0; j < 4; ++j) ss_ += (V[j][0] * V[j][0] + V[j][1] * V[j][1]) + (V[j][2] * V[j][2] + V[j][3] * V[j][3]); \
        const float rs_ = __builtin_amdgcn_rsqf(wave_sum(ss_) * (1.0f / D) + EPS); \
        if (mi_ != cmi) { cmi = mi_; const float* gn_ = p.in[I_N2G] + l * D; const float* sh_ = mod + ((size_t)l * 17 + mi_) * 6144 + 3072; const float* sc_ = sh_ + 1024; \
            _Pragma("unroll") for (int j = 0; j < 4; ++j) { const int k_ = RT_K(j); mg[j] = *(const f32x4*)(gn_ + k_) * (1.0f + *(const f32x4*)(sc_ + k_)); ms[j] = *(const f32x4*)(sh_ + k_); } } \
        float am_ = 0.f; \
        _Pragma("unroll") for (int j = 0; j < 4; ++j) { V[j] = V[j] * rs_ * mg[j] + ms[j]; am_ = fmaxf(am_, fmaxf(fmaxf(fabsf(V[j][0]), fabsf(V[j][1])), fmaxf(fabsf(V[j][2]), fabsf(V[j][3])))); } \
        am_ = fmaxf(wave_max(am_), 1e-30f); const float inv_ = 127.0f * __builtin_amdgcn_rcpf(am_); \
        _Pragma("unroll") for (int jj = 0; jj < 2; ++jj) *(u32x2*)(Xq2 + (size_t)r_ * D + 8 * lane + 512 * jj) = (u32x2){q8x4(V[2 * jj], inv_), q8x4(V[2 * jj + 1], inv_)}; \
        if (lane == 0) sx2[r_] = am_ * (1.0f / 127.0f); } while (0)
#define RT_REDUCE(SX, LX) do { float k8_[8], k4_[4], k2_[2]; \
        _Pragma("unroll") for (int q = 0; q < 8; ++q) { const float keep = b3 ? SX[q + 8] : SX[q], send = b3 ? SX[q] : SX[q + 8]; k8_[q] = keep + dpp_f<0x128>(send); } \
        _Pragma("unroll") for (int q = 0; q < 4; ++q) { const float keep = b2 ? k8_[q + 4] : k8_[q], send = b2 ? k8_[q] : k8_[q + 4]; k4_[q] = keep + dpp_f<0x141>(send); } \
        _Pragma("unroll") for (int q = 0; q < 2; ++q) { const float keep = b1 ? k4_[q + 2] : k4_[q], send = b1 ? k4_[q] : k4_[q + 2]; k2_[q] = keep + dpp_f<0x4E>(send); } \
        { const float keep = b0 ? k2_[1] : k2_[0], send = b0 ? k2_[0] : k2_[1]; LX = keep + dpp_f<0xB1>(send); } } while (0)
    const bool b3 = (lane & 8) != 0, b2 = (lane & 4) != 0, b1 = (lane & 2) != 0, b0 = (lane & 1) != 0;
    RT_LOAD(row0, chA); RT_LOAD(row0 + 1, chB);
    for (int i = 0; i < RW; i += 2) {
        const int lr_ = F.wave * RW + i, r = row0 + i;
        f32x4 nA[4], nB[4];
        if (i + 2 < RW) { RT_LOAD(r + 2, nA); RT_LOAD(r + 3, nB); }
        RT_NORM(r, chA); RT_NORM(r + 1, chB);
        float sxA[16], sxB[16]; f32x4 wq[2][4];
#pragma unroll
        for (int j = 0; j < 4; ++j) wq[0][j] = *(const LAS f32x4*)(rw + 4 * lane + 256 * j);
#pragma unroll
        for (int e = 0; e < 16; ++e) { f32x4 a4 = (f32x4){0.f, 0.f, 0.f, 0.f}, c4 = (f32x4){0.f, 0.f, 0.f, 0.f};
            if (e < 15) {
#pragma unroll
                for (int j = 0; j < 4; ++j) wq[(e + 1) & 1][j] = *(const LAS f32x4*)(rw + (e + 1) * 1024 + 4 * lane + 256 * j); }
            __builtin_amdgcn_sched_barrier(0);
#pragma unroll
            for (int j = 0; j < 4; ++j) { a4 += chA[j] * wq[e & 1][j]; c4 += chB[j] * wq[e & 1][j]; }
            sxA[e] = (a4[0] + a4[1]) + (a4[2] + a4[3]); sxB[e] = (c4[0] + c4[1]) + (c4[2] + c4[3]);
            __builtin_amdgcn_sched_barrier(0); }
        float lxA, lxB; RT_REDUCE(sxA, lxA); RT_REDUCE(sxB, lxB);
        { const auto a_ = __builtin_amdgcn_permlane16_swap(__float_as_uint(lxA), __float_as_uint(lxA), false, false); lxA = __uint_as_float(a_[0]) + __uint_as_float(a_[1]);
          const auto b_ = __builtin_amdgcn_permlane16_swap(__float_as_uint(lxB), __float_as_uint(lxB), false, false); lxB = __uint_as_float(b_[0]) + __uint_as_float(b_[1]); }
        { const auto a_ = __builtin_amdgcn_permlane32_swap(__float_as_uint(lxA), __float_as_uint(lxA), false, false); lxA = __uint_as_float(a_[0]) + __uint_as_float(a_[1]);
          const auto b_ = __builtin_amdgcn_permlane32_swap(__float_as_uint(lxB), __float_as_uint(lxB), false, false); lxB = __uint_as_float(b_[0]) + __uint_as_float(b_[1]); }
        if (lane < 16) { lgs[lr_ * 16 + lane] = lxA; lgs[(lr_ + 1) * 16 + lane] = lxB; }
#pragma unroll
        for (int j = 0; j < 4; ++j) { chA[j] = nA[j]; chB[j] = nB[j]; }
    }
#undef RT_LOAD
#undef RT_K
#undef RT_NORM
#undef RT_REDUCE
    asm volatile("s_waitcnt lgkmcnt(0)" ::: "memory");
    if (lane < RW) {
        const int lr_ = F.wave * RW + lane, r = row0 + lane;
        float sc_[16], bi[16];
#pragma unroll
        for (int e = 0; e < 16; ++e) { sc_[e] = 1.0f / (1.0f + expf(-lgs[lr_ * 16 + e])); bi[e] = sc_[e] + rb[e]; }
        int bg = 0; float bgs = -1e30f;
#pragma unroll
        for (int gq = 0; gq < 4; ++gq) { float m1 = -1e30f, m2 = -1e30f;
#pragma unroll
            for (int j = 0; j < 4; ++j) { const float x = bi[gq * 4 + j]; if (x > m1) { m2 = m1; m1 = x; } else if (x > m2) m2 = x; }
            const float gsum = m1 + m2; if (gsum > bgs) { bgs = gsum; bg = gq; } }
        float c4[4], s4[4];
#pragma unroll
        for (int j = 0; j < 4; ++j) { c4[j] = bg == 0 ? bi[j] : (bg == 1 ? bi[4 + j] : (bg == 2 ? bi[8 + j] : bi[12 + j])); s4[j] = bg == 0 ? sc_[j] : (bg == 1 ? sc_[4 + j] : (bg == 2 ? sc_[8 + j] : sc_[12 + j])); }
        int i1 = 0; float b1v = c4[0], w1 = s4[0];
#pragma unroll
        for (int j = 1; j < 4; ++j) if (c4[j] > b1v) { i1 = j; b1v = c4[j]; w1 = s4[j]; }
        int i2 = -1; float b2v = -1e30f, w2 = 0.f;
#pragma unroll
        for (int j = 0; j < 4; ++j) if (j != i1 && (i2 < 0 || c4[j] > b2v)) { i2 = j; b2v = c4[j]; w2 = s4[j]; }
        const float inv = 1.0f / (w1 + w2);
        const int e0 = bg * 4 + i1, e1 = bg * 4 + i2; sel[2 * r] = e0; sel[2 * r + 1] = e1; wsel[2 * r] = w1 * inv; wsel[2 * r + 1] = w2 * inv; lsel[2 * lr_] = e0; lsel[2 * lr_ + 1] = e1;
    }
    __syncthreads();
    int me = -1, myrank = 0;
    if (F.tid < 320) {
        me = F.tid < 2 * NR ? lsel[F.tid] : -1; int wc = 0;
        const unsigned long long below = (1ull << lane) - 1ull;
#pragma unroll
        for (int e = 0; e < 16; ++e) { const unsigned long long m = __ballot(me == e); if (me == e) myrank = __builtin_popcountll(m & below); if (lane == e) wc = __builtin_popcountll(m); }
        if (lane < 16) lrk[F.wave * 16 + lane] = wc;
    }
    __syncthreads();
    if (F.tid < 2 * NR) { int c = myrank;
#pragma unroll
        for (int w = 0; w < 4; ++w) c += (w < F.wave) ? lrk[w * 16 + me] : 0;
        lrank[2 * (F.blk * NR) + F.tid] = c; }
    if (F.tid >= 496) { const int e = F.tid - 496; cnt[F.blk * 16 + e] = (lrk[e] + lrk[16 + e]) + (lrk[32 + e] + lrk[48 + e]) + lrk[64 + e]; }
}
__device__ __forceinline__ void phase_lists(const Params& p, const Frame& F, int l) {
    LAS int* part = (LAS int*)F.lds;
    LAS int* tot = part + 512;
    LAS int* base = tot + 16;
    LAS int* toff = base + 16;
    const int* cnt = (const int*)(p.ws + OFF_CNT); const int* sel = (const int*)(p.ws + OFF_SEL); const float* wsel = (const float*)(p.ws + OFF_WSEL); const int* lrank = (const int*)(p.ws + OFF_LRANK);
    int* pos = (int*)(p.ws + OFF_POS); int* rowl = (int*)(p.ws + OFF_ROWL); float* wl = (float*)(p.ws + OFF_WL); int* seg = (int*)(p.ws + OFF_SEG);
    float* sxs = (float*)(p.ws + OFF_SXS); const float* sx2 = (const float*)(p.ws + OFF_SX2);
    const int NR = l == 0 ? 144 : 128;
    __syncthreads();
    { const int e = F.tid & 15, pt = F.tid >> 4; int s = 0, sb = 0;
      int cv[8];
#pragma unroll
      for (int j = 0; j < 8; ++j) cv[j] = cnt[(pt * 8 + j) * 16 + e];
#pragma unroll
      for (int j = 0; j < 8; ++j) { s += cv[j]; if (pt * 8 + j < F.blk) sb += cv[j]; }
      part[pt * 16 + e] = s; part[512 + 64 + pt * 16 + e] = sb; }
    __syncthreads();
    if (F.tid < 16) { int s = 0, sb = 0;
#pragma unroll
        for (int pt = 0; pt < 32; ++pt) { s += part[pt * 16 + F.tid]; sb += part[576 + pt * 16 + F.tid]; }
        tot[F.tid] = s; base[F.tid] = sb; }
    __syncthreads();
    if (F.tid == 0) { int o = 0, tv[16];
#pragma unroll
        for (int e = 0; e < 16; ++e) tv[e] = tot[e];
#pragma unroll
        for (int e = 0; e < 16; ++e) { toff[e] = o; o += (tv[e] + 255) >> 8; }
        toff[16] = o; }
    __syncthreads();
    if (F.blk == 0 && F.tid < 17) seg[F.tid] = toff[F.tid];
    for (int i = F.tid; i < 2 * NR; i += NTHR) { const int idx = 2 * (F.blk * NR) + i, e = sel[idx], ps = toff[e] * 256 + base[e] + lrank[idx]; pos[idx] = ps; rowl[ps] = idx >> 1; wl[ps] = wsel[idx]; sxs[ps] = sx2[idx >> 1]; }
    if (F.blk < 16) { const int e = F.blk, lo = toff[e] * 256 + tot[e], hi = toff[e + 1] * 256; for (int i = lo + F.tid; i < hi; i += NTHR) { rowl[i] = 0; wl[i] = 0.f; sxs[i] = 0.f; } }
    __syncthreads();
}
__device__ __forceinline__ void load_toff(const Params& p, const Frame& F) {
    LAS int* toff = (LAS int*)(F.lds + LDS_CTL_OFF + 64);
    __syncthreads();
    if (F.tid < 17) toff[F.tid] = ((const int*)(p.ws + OFF_SEG))[F.tid];
    __syncthreads();
}

#define OPAQUE_V(x) asm volatile("" : "+v"(x))
#define PHASE_ENTER() Frame F; { int t_ = threadIdx.x; OPAQUE_V(t_); F.tid = t_; F.lane = t_ & 63; F.wave = __builtin_amdgcn_readfirstlane(t_ >> 6); int b_ = blockIdx.x; OPAQUE_S(b_); F.blk = b_; F.lds = (LAS unsigned char*)lds_raw; } \
    size_t wz_ = 0; OPAQUE_S(wz_); unsigned char* ws = p.ws + wz_; int l = l0; OPAQUE_S(l); (void)l; (void)ws
__global__ void __launch_bounds__(NTHR, 2) fwd_kernel(Params p) {
    extern __shared__ __attribute__((aligned(16))) unsigned char lds_raw[];
    for (int u = threadIdx.x; u < (LDS_BYTES - LDS_CTL_OFF) / 4; u += NTHR) ((LAS unsigned*)((LAS unsigned char*)lds_raw + LDS_CTL_OFF))[u] = 0u;
    __syncthreads();
#if !MK_LAUNCH_PER_PHASE
    XcdBarrier bar = xcd_barrier_post((unsigned*)(p.ws + OFF_CTL), (volatile LAS unsigned*)((LAS unsigned char*)lds_raw + LDS_CTL_OFF));
#define GRID_BAR() xcd_barrier(bar)
#else
#define GRID_BAR() do { } while (0)
#endif
    const int lo = (int)p.ph_lo, hi = (int)p.ph_hi;
#define IN(k) (lo <= (k) && (k) < hi)
#define SEAM(k) do { if (IN(k) && IN((k) + 1)) { GRID_BAR(); if ((REPEAT_MASK >> 16) & 1) GRID_BAR(); } } while (0)
#ifndef NPASS
#define NPASS 1
#endif
    for (int pass_ = 0; pass_ < NPASS; ++pass_) {
    if (pass_ > 0) GRID_BAR();
    if (PH_ON(0) && IN(0)) {
        const int l0 = 0;
        REP(0) { PHASE_ENTER();
        { bf16_t* w16 = (bf16_t*)(ws + OFF_SGUW16); const int i8 = (F.blk * NTHR + F.tid) * 8;
          for (int i = i8; i < 262144; i += NBLK * NTHR * 8) { const f32x4 a = *(const f32x4*)(p.in[I_SGUW] + i), b = *(const f32x4*)(p.in[I_SGUW] + i + 4); *(u32x4*)(w16 + i) = pack8(a, b); } }
        mod_items(p, F);
        if (F.blk >= 128) s5_build_job(p, F, 0, 255 - F.blk);
        __syncthreads();
        if (F.blk < 128) { colmax_win(p, F); convert_mix(p, F, 0, 1, F.blk * NWAVE + F.wave, 128 * NWAVE); } }
    }
    SEAM(0);
    for (int l0 = 0; l0 < DEPTH; ++l0) {
        const int pb = 1 + 12 * l0;
        if (PH_ON(1) && IN(pb + 0)) {
            for (int rep_ = 0; rep_ < 1 + (((REPEAT_MASK >> 1) & 1) && l0 == 0 ? 1 : 0); ++rep_) { PHASE_ENTER();
            if (l == 1) convert_mix(p, F, 1, 1, F.blk * NWAVE + F.wave, NBLK * NWAVE);
            else convert_mix(p, F, 0, 0, F.blk * NWAVE + F.wave, NBLK * NWAVE);
            if (((REPEAT_MASK >> 18) & 1) && l == 1) phase_norm1(p, F, l, true);
            phase_norm1(p, F, l); }
        }
        SEAM(pb + 0);
        for (int md = 0; md < 2; ++md) {
            if (md == 1) SEAM(pb + 1);
            if (PH_ON(2) && IN(pb + 1 + md)) { PHASE_ENTER();
                if (md == 0 || F.blk >= 160) {
                    SchedB S{(const char*)(ws + OFF_XN), (const char*)(ws + OFF_WIN), l, md == 0 ? F.blk : F.blk - 160, md == 0 ? NBLK : 96, md};
                    EpiB E{(bf16_t*)(ws + OFF_U), (bf16_t*)(ws + OFF_V), (bf16_t*)(ws + OFF_BB), (bf16_t*)(ws + OFF_P), (bf16_t*)(ws + OFF_UX), ws + OFF_G8, (const float*)(ws + OFF_SXA), (const float*)(ws + OFF_SWIN) + (size_t)l * 6144};
                    gs::gemm_stream<EpiB, SchedB, false>(F.lds, F.tid, S, E); } }
        }
        if (PH_ON(3) && IN(pb + 2)) {
            REP(3) { PHASE_ENTER(); SchedE S{(const char*)(ws + OFF_UX), (const char*)(ws + OFF_WE), F.blk}; EpiE E{(float*)(ws + OFF_E)}; gs::gemm_stream<EpiE, SchedE, false>(F.lds, F.tid, S, E); }
            { PHASE_ENTER(); phase_conv(p, F, l); }
        }
        SEAM(pb + 2);
        if (PH_ON(4) && IN(pb + 3)) { REP(4) { PHASE_ENTER(); phase_scan(p, F, l); } { PHASE_ENTER(); phase_sgu(p, F, l); } }
        SEAM(pb + 3);
        if (PH_ON(5) && IN(pb + 4)) REP(5) { PHASE_ENTER(); SchedY S{(const char*)(ws + OFF_UX), (const char*)(ws + OFF_TW), l, F.blk, 0, 256}; EpiY<false> E{(bf16_t*)(ws + OFF_V)}; gs::gemm_stream<EpiY<false>, SchedY, false>(F.lds, F.tid, S, E); }
        SEAM(pb + 4);
        if (PH_ON(6) && IN(pb + 5)) REP(6) { PHASE_ENTER(); SchedF S{(const char*)(ws + OFF_V), (const char*)(ws + OFF_GLU), l, F.blk, 0, 256, (unsigned*)(ws + OFF_YCCNT), F.wave}; EpiF<false> E{(const bf16_t*)(ws + OFF_V), (bf16_t*)(ws + OFF_P), p.in[I_GLUB] + l * 512}; gs::gemm_stream<EpiF<false>, SchedF, false>(F.lds, F.tid, S, E); }
        SEAM(pb + 5);
        if (PH_ON(7) && IN(pb + 6)) {
            { PHASE_ENTER(); if (l == 0 && F.blk >= 192) {
                SchedY S{(const char*)(ws + OFF_UX), (const char*)(ws + OFF_TW), l, F.blk - 192, 256, 320}; EpiY<true> E{(bf16_t*)(ws + OFF_V)};
                gs::gemm_stream<EpiY<true>, SchedY, false>(F.lds, F.tid, S, E);
                if (F.lane == 0) (void)xb_add((unsigned*)(ws + OFF_YCCNT), 1u); } }
            { PHASE_ENTER(); if (l == 0 && F.blk >= 192 && F.blk < 224) {
                SchedF S{(const char*)(ws + OFF_V), (const char*)(ws + OFF_GLU), l, F.blk - 192, 256, 288, (unsigned*)(ws + OFF_YCCNT), F.wave}; EpiF<true> E{(const bf16_t*)(ws + OFF_V), (bf16_t*)(ws + OFF_P), p.in[I_GLUB] + l * 512};
                gs::gemm_stream<EpiF<true>, SchedF, false>(F.lds, F.tid, S, E);
                if (F.lane == 0) (void)xb_add((unsigned*)(ws + OFF_FGCNT) + ((F.blk - 192) >> 1) * 16, 1u); } }
            REP(7) { PHASE_ENTER();
            SchedG S{(const char*)(ws + OFF_U), (const char*)(ws + OFF_BB), (const char*)(ws + OFF_P), (const char*)(ws + OFF_WBR), l, F.blk, (unsigned*)(ws + OFF_FGCNT), F.wave};
            EpiG E{ws + OFF_G8, (bf16_t*)(ws + OFF_MERGED)};
            gs::gemm_stream<EpiG, SchedG, false>(F.lds, F.tid, S, E); }
            if (l0 == 0) {
                PHASE_ENTER();
                if (F.blk >= 64) {
                    if (F.wave == 0) { unsigned* cp = (unsigned*)(ws + OFF_FGCNT) + (F.lane < 17 ? F.lane : 16) * 16; const unsigned tgt = F.lane < 16 ? 16u : 512u; unsigned sp = 0u;
                        while (__ballot(xb_ld(cp) < tgt) != 0ull) { __builtin_amdgcn_s_sleep(1); if (++sp > (1u << 22)) break; } }
                    __syncthreads(); }
                if (F.blk >= 64 && F.blk < 192) s5_build_job(p, F, 1, F.blk - 64);
                __syncthreads();
                if (F.blk >= 64) convert_mix(p, F, 1, 0, (F.blk - 64) * NWAVE + F.wave, 192 * NWAVE);
            }
        }
        SEAM(pb + 6);
        if (PH_ON(8) && IN(pb + 7)) {
            for (int rep_ = 0; rep_ < 1 + (((REPEAT_MASK >> 8) & 1) && l0 == 0 ? 1 : 0); ++rep_) { PHASE_ENTER();
            SchedH S{(const char*)(ws + OFF_MERGED), (const char*)(ws + OFF_WOUT), l, F.blk};
            if (l == 0) { EpiH<1> E{p.in[I_X], p.in[I_CTX], (bf16_t*)(ws + OFF_HB), (const float*)(ws + OFF_MOD) + (size_t)l * 17 * 6144, F.lds + RING_BYTES, F.tid}; gs::gemm_stream<EpiH<1>, SchedH, false>(F.lds, F.tid, S, E); }
            else { EpiH<0> E{p.in[I_X], p.in[I_CTX], (bf16_t*)(ws + OFF_HB), (const float*)(ws + OFF_MOD) + (size_t)l * 17 * 6144, F.lds + RING_BYTES, F.tid}; gs::gemm_stream<EpiH<0>, SchedH, false>(F.lds, F.tid, S, E); } }
            { PHASE_ENTER(); if (l == 0 && F.blk >= 64) convert_experts(p, F, 0, F.blk - 64, NBLK - 64, 3); }
        }
        SEAM(pb + 7);
        if (PH_ON(9) && IN(pb + 8)) { REP(9) { PHASE_ENTER(); phase_router(p, F, l); } REP(10) { PHASE_ENTER(); if (l == 1) convert_experts(p, F, l, F.blk, NBLK, 1); } }
        SEAM(pb + 8);
        if (PH_ON(10) && IN(pb + 9)) REP(13) { PHASE_ENTER(); phase_lists(p, F, l); }
        SEAM(pb + 9);
        if (PH_ON(11) && IN(pb + 10)) {
            REP(11) { PHASE_ENTER();
            load_toff(p, F);
            SchedK S{(const char*)(ws + OFF_XN), (const char*)(ws + OFF_WGU), (const int*)(ws + OFF_ROWL), (const LAS int*)(F.lds + LDS_CTL_OFF + 64), F.blk};
            EpiK E{(bf16_t*)(ws + OFF_HE), (const float*)(ws + OFF_SXS), (const float*)(ws + OFF_SWGU)};
            gs::gemm_stream<EpiK, SchedK, true>(F.lds, F.tid, S, E); }
            { PHASE_ENTER(); if (l == 1) { const int r = (__builtin_amdgcn_readfirstlane(((const LAS int*)(F.lds + LDS_CTL_OFF + 64))[16]) * 4) & 255;
                if (r == 0 || r > 128) convert_experts(p, F, 1, F.blk, NBLK, 2); else if (F.blk >= r) convert_experts(p, F, 1, F.blk - r, NBLK - r, 2); } }
        }
        SEAM(pb + 10);
        if (PH_ON(12) && IN(pb + 11)) {
            REP(12) { PHASE_ENTER();
            load_toff(p, F);
            SchedL S{(const char*)(ws + OFF_HE), (const char*)(ws + OFF_WD), (const LAS int*)(F.lds + LDS_CTL_OFF + 64), F.blk};
            EpiL E{ws + OFF_Y, (float*)(ws + OFF_YSC), (const float*)(ws + OFF_WL), F.lds + RING_BYTES, F.tid};
            gs::gemm_stream<EpiL, SchedL, false>(F.lds, F.tid, S, E); }
        }
        SEAM(pb + 11);
    }
    if (PH_ON(13) && IN(25)) { const int l0 = 1; REP(17) { PHASE_ENTER(); phase_final(p, F); } }
    }
#undef IN
#undef SEAM
}


extern "C" void kernel_launch(void* const* d_in, const int* in_sizes, int n_in, void* d_out, int out_size, void* d_ws, size_t ws_size, hipStream_t stream) {
    static int ready = 0;
    if (ready == 0) {
        if (n_in != 31 || out_size != TLAT * D || ws_size < WS_END) { fprintf(stderr, "kernel_launch: unexpected shapes (n_in %d out %d ws %zu)\n", n_in, out_size, ws_size); ready = -1; return; }
        if (hipFuncSetAttribute((const void*)fwd_kernel, hipFuncAttributeMaxDynamicSharedMemorySize, LDS_BYTES) != hipSuccess) { fprintf(stderr, "kernel_launch: hipFuncSetAttribute failed\n"); ready = -1; return; }
        int per_cu = 0;
        if (hipOccupancyMaxActiveBlocksPerMultiprocessor(&per_cu, (const void*)fwd_kernel, NTHR, LDS_BYTES) != hipSuccess || per_cu < 1) fprintf(stderr, "kernel_launch: occupancy query says %d\n", per_cu);
        (void)hipGetLastError();
        ready = 1;
    }
    if (ready < 0) return;
    (void)hipMemsetAsync((char*)d_ws + OFF_CTL, 0, CTL_ZERO_BYTES, stream);
    Params p{};
    for (int i = 0; i < 31; ++i) p.in[i] = (const float*)d_in[i];
    p.out = (float*)d_out; p.ws = (unsigned char*)d_ws;
#if MK_LAUNCH_PER_PHASE
    for (int ph = 0; ph < 26; ++ph) { p.ph_lo = ph; p.ph_hi = ph + 1; hipLaunchKernelGGL(fwd_kernel, dim3(NBLK), dim3(NTHR), LDS_BYTES, stream, p); }
#else
    p.ph_lo = 0; p.ph_hi = 26;
    hipLaunchKernelGGL(fwd_kernel, dim3(NBLK), dim3(NTHR), LDS_BYTES, stream, p);
#endif
}
```
